# Optimizing an MI355X kernel written in HIP

```python
import math
import jax, jax.numpy as jnp
from jax import lax
import numpy as np

D_MODEL = 1024
BATCH = 16
SEQ = 2048
DEPTH = 1

HEAD_DIM = 64
ATTN_HEADS = 8
ATTN_KV_HEADS = 2
ATTN_WIDTH = ATTN_HEADS * HEAD_DIM
KV_WIDTH = ATTN_KV_HEADS * HEAD_DIM
WINDOW = 128
BLOCK = 128
RWKV_HEADS = 8
RWKV_WIDTH = RWKV_HEADS * HEAD_DIM
MIX_WIDTH = ATTN_WIDTH + RWKV_WIDTH
DECAY_LORA = 64
ICLR_LORA = 64
GATE_LORA = 128
ATTN_COLS = ATTN_WIDTH + 2 * KV_WIDTH
RWKV_COLS = 3 * RWKV_WIDTH + DECAY_LORA + ICLR_LORA + GATE_LORA
IN_COLS = ATTN_COLS + RWKV_COLS
PEER_HEADS = 8
PEER_NKEYS = 128
PEER_EXPERTS = PEER_NKEYS * PEER_NKEYS
PEER_QDIM = 256
PEER_HALF = PEER_QDIM // 2
PEER_TOPK = 16
PEER_CHUNK = 128
LN_EPS = 1e-5
GN_EPS = 64e-5

kernel_name = 'hymba_swa_sink_rwkv7_peer_deepnorm_adaln'


def _layer_norm(x, g, b):
    xf = x.astype(jnp.float32)
    mu = jnp.mean(xf, axis=-1, keepdims=True)
    var = jnp.mean(jnp.square(xf - mu), axis=-1, keepdims=True)
    return ((xf - mu) * lax.rsqrt(var + LN_EPS)).astype(x.dtype) * g + b


def _sliding_window_sink_attention(q, k, v, sink):
    B, S, H, Dh = q.shape
    KV = k.shape[2]
    G = H // KV
    NB = S // BLOCK
    qb = q.reshape(B, NB, BLOCK, KV, G, Dh)
    kb = k.reshape(B, NB, BLOCK, KV, Dh)
    vb = v.reshape(B, NB, BLOCK, KV, Dh)
    prev = lambda t: jnp.concatenate([jnp.zeros_like(t[:, :1]), t[:, :-1]], axis=1)
    kw = jnp.concatenate([prev(kb), kb], axis=2)
    vw = jnp.concatenate([prev(vb), vb], axis=2)
    s = jnp.einsum('bnqkgd,bnjkd->bnkgqj', qb, kw).astype(jnp.float32) * (Dh ** -0.5)
    qpos = jnp.arange(BLOCK)[:, None] + BLOCK
    kpos = jnp.arange(2 * BLOCK)[None, :]
    dist = qpos - kpos
    allowed = (dist >= 0) & (dist < WINDOW)
    valid = (jnp.arange(NB)[:, None] * BLOCK - BLOCK + kpos) >= 0
    mask = allowed[None, :, :] & valid[:, None, :]
    s = jnp.where(mask[None, :, None, None, :, :], s, -jnp.inf)
    sink_l = sink.astype(jnp.float32).reshape(KV, G)[None, None, :, :, None, None]
    m = jnp.maximum(jnp.max(s, axis=-1, keepdims=True), sink_l)
    p = jnp.exp(s - m)
    p = p / (jnp.sum(p, axis=-1, keepdims=True) + jnp.exp(sink_l - m))
    o = jnp.einsum('bnkgqj,bnjkd->bnqkgd', p.astype(v.dtype), vw)
    return o.reshape(B, S, H * Dh)


def _rwkv7_time_mix(p, mu, w0, w2, a0, a2, g2, k_k, k_a, r_k, lnx_g, lnx_b):
    B, S, _ = p.shape
    p_prev = jnp.pad(p, ((0, 0), (1, 0), (0, 0)))[:, :-1]
    p = p + (p_prev - p) * mu
    o0 = RWKV_WIDTH
    r = p[..., 0:o0]
    k = p[..., o0:2 * o0]
    v = p[..., 2 * o0:3 * o0]
    wd = p[..., 3 * o0:3 * o0 + DECAY_LORA]
    ad = p[..., 3 * o0 + DECAY_LORA:3 * o0 + DECAY_LORA + ICLR_LORA]
    gd = p[..., 3 * o0 + DECAY_LORA + ICLR_LORA:]
    w_log = -jax.nn.softplus(-(w0 + jnp.tanh(wd) @ w2)) - 0.5
    decay = jnp.exp(-jnp.exp(w_log.astype(jnp.float32)))
    a = jax.nn.sigmoid(a0 + ad @ a2)
    g = jax.nn.sigmoid(gd) @ g2
    hs = lambda t: t.reshape(B, S, RWKV_HEADS, HEAD_DIM)
    r, k, v, a, decay = hs(r), hs(k), hs(v), hs(a), hs(decay)
    kk = hs(k.reshape(B, S, RWKV_WIDTH) * k_k).astype(jnp.float32)
    kk = kk * lax.rsqrt(jnp.maximum(jnp.sum(kk * kk, axis=-1, keepdims=True), 1e-24))
    k = k * (1.0 + (a - 1.0) * hs(jnp.broadcast_to(k_a, (B, S, RWKV_WIDTH))))
    f32 = jnp.float32
    tm = lambda t: jnp.moveaxis(t.astype(f32), 1, 0)
    xs = (tm(r), tm(decay), tm(k), tm(v), tm(-kk), tm(kk * a.astype(f32)))

    def step(state, inp):
        r_t, w_t, k_t, v_t, na_t, b_t = inp
        sa = jnp.einsum('bhvk,bhk->bhv', state, na_t)
        state = state * w_t[:, :, None, :] + sa[..., None] * b_t[:, :, None, :] + v_t[..., None] * k_t[:, :, None, :]
        return state, jnp.einsum('bhvk,bhk->bhv', state, r_t)

    state0 = jnp.zeros((B, RWKV_HEADS, HEAD_DIM, HEAD_DIM), f32)
    _, ys = lax.scan(step, state0, xs)
    y = jnp.moveaxis(ys, 0, 1)
    mean = jnp.mean(y, axis=-1, keepdims=True)
    var = jnp.mean(jnp.square(y - mean), axis=-1, keepdims=True)
    y = ((y - mean) * lax.rsqrt(var + GN_EPS)).reshape(B, S, RWKV_WIDTH).astype(p.dtype) * lnx_g + lnx_b
    bonus = jnp.sum(r * k * r_k, axis=-1, keepdims=True) * v
    return (y + bonus.reshape(B, S, RWKV_WIDTH)) * g


def _peer(h, wq, subkeys, U, V):
    B, S, D = h.shape
    T = B * S
    hf = h.reshape(T, D)
    q = (hf @ wq).reshape(T, PEER_HEADS, 2, PEER_HALF)
    s = jnp.einsum('thcd,hcnd->thcn', q, subkeys).astype(jnp.float32)
    sv, si = lax.top_k(s, PEER_TOPK)
    cand = sv[:, :, 0, :, None] + sv[:, :, 1, None, :]
    cidx = si[:, :, 0, :, None] * PEER_NKEYS + si[:, :, 1, None, :]
    fv, fpos = lax.top_k(cand.reshape(T, PEER_HEADS, PEER_TOPK * PEER_TOPK), PEER_TOPK)
    fidx = jnp.take_along_axis(cidx.reshape(T, PEER_HEADS, PEER_TOPK * PEER_TOPK), fpos, axis=-1)
    gates = jax.nn.softmax(fv, axis=-1).astype(h.dtype)

    def chunk(args):
        xc, ic, gc = args
        u = jnp.take(U, ic, axis=0)
        act = jax.nn.gelu(jnp.einsum('chkd,cd->chk', u, xc), approximate=False)
        vv = jnp.take(V, ic, axis=0)
        return jnp.einsum('chk,chkd->cd', gc * act, vv)

    nc = T // PEER_CHUNK
    y = lax.map(chunk, (hf.reshape(nc, PEER_CHUNK, D),
                        fidx.reshape(nc, PEER_CHUNK, PEER_HEADS, PEER_TOPK),
                        gates.reshape(nc, PEER_CHUNK, PEER_HEADS, PEER_TOPK)))
    return y.reshape(B, S, D)


def setup_inputs(seed: int = 0) -> dict:
    key = jax.random.key(seed)
    ks = jax.random.split(key, 32)
    L, D = DEPTH, D_MODEL
    beta = (8.0 * DEPTH) ** -0.25
    nrm = lambda i, shape, sc: jax.random.normal(ks[i], shape, jnp.float32) * sc
    uni = lambda i, shape, lo, hi: jax.random.uniform(ks[i], shape, jnp.float32, lo, hi)
    return {
        'x': nrm(0, (BATCH, SEQ, D), 1.0),
        'c': nrm(1, (BATCH, D), 1.0),
        'ada_w': nrm(2, (L, D, 6 * D), 0.5 * D ** -0.5),
        'ada_b': nrm(3, (L, 6 * D), 0.02),
        'w_in': nrm(4, (L, D, IN_COLS), D ** -0.5),
        'attn_sink': nrm(5, (L, ATTN_HEADS), 1.0),
        'shift_mu': uni(6, (L, RWKV_COLS), 0.0, 1.0),
        'decay_w0': uni(7, (L, RWKV_WIDTH), -6.0, 1.0),
        'decay_w2': nrm(8, (L, DECAY_LORA, RWKV_WIDTH), 0.5 * DECAY_LORA ** -0.5),
        'iclr_a0': nrm(9, (L, RWKV_WIDTH), 0.5),
        'iclr_a2': nrm(10, (L, ICLR_LORA, RWKV_WIDTH), 0.5 * ICLR_LORA ** -0.5),
        'gate_g2': nrm(11, (L, GATE_LORA, RWKV_WIDTH), GATE_LORA ** -0.5),
        'k_k': 0.85 + nrm(12, (L, RWKV_WIDTH), 0.05),
        'k_a': 1.0 + nrm(13, (L, RWKV_WIDTH), 0.05),
        'r_k': nrm(14, (L, RWKV_HEADS, HEAD_DIM), 0.1),
        'lnx_g': 1.0 + nrm(15, (L, RWKV_WIDTH), 0.05),
        'lnx_b': nrm(16, (L, RWKV_WIDTH), 0.02),
        'w_out': nrm(17, (L, MIX_WIDTH, D), beta * MIX_WIDTH ** -0.5),
        'ln1_g': 1.0 + nrm(18, (L, D), 0.05),
        'ln1_b': nrm(19, (L, D), 0.02),
        'peer_wq': nrm(20, (L, D, PEER_HEADS * PEER_QDIM), D ** -0.5),
        'peer_subkeys': nrm(21, (L, PEER_HEADS, 2, PEER_NKEYS, PEER_HALF), PEER_HALF ** -0.5),
        'peer_u': nrm(22, (L, PEER_EXPERTS, D), D ** -0.5),
        'peer_v': nrm(23, (L, PEER_EXPERTS, D), beta),
        'ln2_g': 1.0 + nrm(24, (L, D), 0.05),
        'ln2_b': nrm(25, (L, D), 0.02),
    }


def reference(x, c, ada_w, ada_b, w_in, attn_sink, shift_mu, decay_w0, decay_w2, iclr_a0, iclr_a2,
              gate_g2, k_k, k_a, r_k, lnx_g, lnx_b, w_out, ln1_g, ln1_b, peer_wq, peer_subkeys,
              peer_u, peer_v, ln2_g, ln2_b):
    B, S, D = x.shape
    alpha = (2.0 * DEPTH) ** 0.25
    cs = jax.nn.silu(c)
    for l in range(DEPTH):
        mod = cs @ ada_w[l] + ada_b[l]
        sh1, sc1, gt1, sh2, sc2, gt2 = [m[:, None, :] for m in jnp.split(mod, 6, axis=-1)]
        h = x * (1.0 + sc1) + sh1
        proj = h @ w_in[l]
        q = proj[..., :ATTN_WIDTH].reshape(B, S, ATTN_HEADS, HEAD_DIM)
        k = proj[..., ATTN_WIDTH:ATTN_WIDTH + KV_WIDTH].reshape(B, S, ATTN_KV_HEADS, HEAD_DIM)
        v = proj[..., ATTN_WIDTH + KV_WIDTH:ATTN_COLS].reshape(B, S, ATTN_KV_HEADS, HEAD_DIM)
        y_attn = _sliding_window_sink_attention(q, k, v, attn_sink[l])
        y_rwkv = _rwkv7_time_mix(proj[..., ATTN_COLS:], shift_mu[l], decay_w0[l], decay_w2[l], iclr_a0[l],
                                 iclr_a2[l], gate_g2[l], k_k[l], k_a[l], r_k[l], lnx_g[l], lnx_b[l])
        y = jnp.concatenate([y_attn, y_rwkv], axis=-1) @ w_out[l]
        x = _layer_norm(alpha * x + gt1 * y, ln1_g[l], ln1_b[l])
        h = x * (1.0 + sc2) + sh2
        y = _peer(h, peer_wq[l], peer_subkeys[l], peer_u[l], peer_v[l])
        x = _layer_norm(alpha * x + gt2 * y, ln2_g[l], ln2_b[l])
    return x
```

```cpp
#include <hip/hip_runtime.h>
#include <cstdio>
#include <cstdint>
#include <cmath>
namespace pg8 {
#define PG8_LAS __attribute__((address_space(3)))
typedef unsigned short bf16_t;
typedef short bf16x8 __attribute__((ext_vector_type(8)));
typedef float f32x4 __attribute__((ext_vector_type(4)));
typedef unsigned u32x4 __attribute__((ext_vector_type(4)));
constexpr int BM = 256, BK = 64, HALF = 128, HTB = HALF * BK * 2  , STAGE_BYTES = 8 * HTB, NXCD = 8, WGM = 8;

__host__ __device__ __forceinline__ int lds_byte(int r, int c) { const int st = (r >> 4) * 2 + (c >> 5), rr = r & 15, cc = c & 31, ob = rr * 64 + cc * 2; return st * 1024 + (ob ^ (((ob >> 9) & 1) << 5)); }
__host__ __device__ __forceinline__ void stage_rc(int b, int& R, int& C) { const int st = b / 1024, sb = b % 1024, swz = sb ^ (((sb >> 9) & 1) << 5); R = (st >> 1) * 16 + swz / 64; C = (st & 1) * 32 + (swz % 64) / 2; }
__host__ __device__ __forceinline__ int perm32(int rho) { const int n = rho >> 4, i = rho & 15; return 8 * (i >> 2) + 4 * n + (i & 3); }

struct Unit { int pm, pn; };
struct Gemm { const bf16_t* A; const bf16_t* Bt; int M, N, K; };

struct StaticOrder {
    int nM, nN, nwg, G, c;
    __host__ __device__ void init(int M, int N, int G_, int c_) { nM = M / BM; nN = N / BM; nwg = nM * nN; G = G_; c = c_; }
    __host__ __device__ bool next(int i, Unit& u) const {
        const long L = (long)i * G + c; if (L >= nwg) return false;
        int wgid = (int)L; { const int q = nwg / NXCD, r = nwg % NXCD, xcd = wgid % NXCD, off = wgid / NXCD; wgid = (xcd < r ? xcd * (q + 1) : r * (q + 1) + (xcd - r) * q) + off; }
        const int nig = WGM * nN, gid = wgid / nig, fm = gid * WGM, gsz = (nM - fm) < WGM ? (nM - fm) : WGM;
        u.pm = fm + ((wgid % nig) % gsz); u.pn = (wgid % nig) / gsz; return true;
    }
    __device__ __forceinline__ void a_ready(const Unit&) const {}
    __device__ __forceinline__ void done(const Unit&) const {}
};

__device__ __forceinline__ unsigned cvt_pk_bf16(float lo, float hi) { unsigned r; asm volatile("v_cvt_pk_bf16_f32 %0, %1, %2" : "=v"(r) : "v"(lo), "v"(hi)); return r; }
typedef float f32x2 __attribute__((ext_vector_type(2)));
__device__ __forceinline__ f32x2 gelu_pk(f32x2 v) {
    const f32x2 av = __builtin_elementwise_abs(v), d = av * 0.2316418882f + 1.0f;
    f32x2 t; t.x = __builtin_amdgcn_rcpf(d.x); t.y = __builtin_amdgcn_rcpf(d.y);
    f32x2 q = t * 0.5307027145f + (-0.7265760135f); q = q * t + 0.7107068705f; q = q * t + (-0.142248368f); q = q * t + 0.127414796f; q = q * t;
    const f32x2 s = (v * v) * (-0.72134752044f);
    f32x2 e; e.x = __builtin_amdgcn_exp2f(s.x); e.y = __builtin_amdgcn_exp2f(s.y);
    const f32x2 m = v * (q * e), r = v - m;
    f32x2 o; o.x = v.x < 0.f ? m.x : r.x; o.y = v.y < 0.f ? m.y : r.y; return o;
}

template <int ACT  > struct EpiBf16 {
    static constexpr bool PERM = true, AFTER_DRAIN = false; static_assert(ACT == 0 || ACT == 1, "EpiBf16: ACT is 0 (none) or 1 (gelu_pk)");
    bf16_t* O; int ldc; const float* bias; int split_cols; size_t split_stride; float scale0;
    __device__ __forceinline__ void operator()(const f32x4 (&acc)[2][2][4][2], const Unit& u, int wr, int wc, int fr, int fq) const {
        const int row0 = u.pm * BM + wr * 64 + fr; int colt = u.pn * BM; bf16_t* base = O;
        float sc = 1.f; if (split_cols) { const int t = colt / split_cols; base += (size_t)t * split_stride; colt -= t * split_cols; if (t == 0) sc = scale0; }
        const int col0 = colt + wc * 32 + 8 * fq, bcol0 = u.pn * BM + wc * 32 + 8 * fq;
        f32x4 bv[2][2];
#pragma unroll
        for (int bj = 0; bj < 2; ++bj)
#pragma unroll
            for (int n = 0; n < 2; ++n) bv[bj][n] = bias ? *(const f32x4*)(bias + bcol0 + bj * HALF + 4 * n) : (f32x4){0.f, 0.f, 0.f, 0.f};
#pragma unroll
        for (int ai = 0; ai < 2; ++ai)
#pragma unroll
            for (int m = 0; m < 4; ++m) { bf16_t* rowp = base + (size_t)(row0 + ai * HALF + m * 16) * ldc + col0;
#pragma unroll
                for (int bj = 0; bj < 2; ++bj) { f32x4 v0 = acc[ai][bj][m][0] + bv[bj][0], v1 = acc[ai][bj][m][1] + bv[bj][1];
                    if (ACT == 1) { f32x2 a = gelu_pk((f32x2){v0[0], v0[1]}), b = gelu_pk((f32x2){v0[2], v0[3]}), c = gelu_pk((f32x2){v1[0], v1[1]}), d = gelu_pk((f32x2){v1[2], v1[3]});
                        v0 = (f32x4){a.x, a.y, b.x, b.y}; v1 = (f32x4){c.x, c.y, d.x, d.y}; }
                    v0 = v0 * sc; v1 = v1 * sc; u32x4 w; w.x = cvt_pk_bf16(v0[0], v0[1]); w.y = cvt_pk_bf16(v0[2], v0[3]); w.z = cvt_pk_bf16(v1[0], v1[1]); w.w = cvt_pk_bf16(v1[2], v1[3]);
                    *(u32x4*)(rowp + bj * HALF) = w; } }
    }
};
struct EpiF32 {
    static constexpr bool PERM = false, AFTER_DRAIN = false;
    float* C; int ldc; const float* bias;
    __device__ __forceinline__ void operator()(const f32x4 (&acc)[2][2][4][2], const Unit& u, int wr, int wc, int fr, int fq) const {
        const int row0 = u.pm * BM + wr * 64 + fr, col0 = u.pn * BM + wc * 32 + 4 * fq;
        f32x4 bv[2][2];
#pragma unroll
        for (int bj = 0; bj < 2; ++bj)
#pragma unroll
            for (int n = 0; n < 2; ++n) bv[bj][n] = bias ? *(const f32x4*)(bias + col0 + bj * HALF + n * 16) : (f32x4){0.f, 0.f, 0.f, 0.f};
#pragma unroll
        for (int ai = 0; ai < 2; ++ai)
#pragma unroll
            for (int m = 0; m < 4; ++m) { float* rowp = C + (size_t)(row0 + ai * HALF + m * 16) * ldc + col0;
#pragma unroll
                for (int bj = 0; bj < 2; ++bj)
#pragma unroll
                    for (int n = 0; n < 2; ++n) *(f32x4*)(rowp + bj * HALF + n * 16) = acc[ai][bj][m][n] + bv[bj][n]; }
    }
};
template <class Epi, class Sched, bool ALIGN_EPI = false, bool SP2 = false>
__device__ __forceinline__ void gemm_phase(PG8_LAS unsigned char* lds, const Gemm g, const Sched& S, const Epi& E) {
    const int tid = threadIdx.x, wid = __builtin_amdgcn_readfirstlane(tid >> 6), lane = tid & 63, wr = wid >> 2, wc = wid & 3, fr = lane & 15, fq = lane >> 4;
    const int K = g.K, nt = K / BK;
    unsigned voffA[2], voffB[2];
#pragma unroll
    for (int i = 0; i < 2; ++i) { int R, C; stage_rc(tid * 16 + i * 8192, R, C); const int Rb = Epi::PERM ? ((R & ~31) + perm32(R & 31)) : R;
        voffA[i] = (unsigned)(R * K + C) * 2u; voffB[i] = (unsigned)(Rb * K + C) * 2u; }
    const size_t kstep = (size_t)(BK * 2);
    const size_t hstep = (size_t)HALF * K * 2;
    const size_t tstep = 2 * hstep;
    const unsigned ldsw = (unsigned)wid * 1024u;
    const int aoff = lds_byte(wr * 64 + fr, fq * 8), boff = lds_byte(wc * 32 + fr, fq * 8);
#define PG8_SA(b, h) (((b) * 2 + (h)) * HTB)
#define PG8_SB(b, h) ((4 + (b) * 2 + (h)) * HTB)
#define PG8_STAGE(bufoff, gbase, voff) do { _Pragma("unroll") for (int _i = 0; _i < 2; ++_i) \
        __builtin_amdgcn_global_load_lds((const unsigned*)((const char*)(gbase) + (voff)[_i]), (PG8_LAS unsigned*)(lds + (bufoff) + ldsw + _i * 8192), 16, 0, 0); } while (0)
#define PG8_LDA(dst, b, h) do { _Pragma("unroll") for (int m = 0; m < 4; ++m) _Pragma("unroll") for (int k = 0; k < 2; ++k) dst[m][k] = *(const PG8_LAS bf16x8*)(lds + PG8_SA(b, h) + aoff + m * 2048 + k * 1024); } while (0)
#define PG8_LDB(dst, b, h) do { _Pragma("unroll") for (int n = 0; n < 2; ++n) _Pragma("unroll") for (int k = 0; k < 2; ++k) dst[n][k] = *(const PG8_LAS bf16x8*)(lds + PG8_SB(b, h) + boff + n * 2048 + k * 1024); } while (0)
#define PG8_MMA(ai, bj, At, Bt) do { __builtin_amdgcn_s_setprio(1); _Pragma("unroll") for (int m = 0; m < 4; ++m) _Pragma("unroll") for (int n = 0; n < 2; ++n) _Pragma("unroll") for (int k = 0; k < 2; ++k) \
        acc[ai][bj][m][n] = __builtin_amdgcn_mfma_f32_16x16x32_bf16(Bt[n][k], At[m][k], acc[ai][bj][m][n], 0, 0, 0); __builtin_amdgcn_s_setprio(0); } while (0)
#define PG8_WAIT_V(n) asm volatile("s_waitcnt vmcnt(" #n ")" ::: "memory")
#define PG8_WAIT_L(n) asm volatile("s_waitcnt lgkmcnt(" #n ")" ::: "memory")
#define PG8_BAR __builtin_amdgcn_s_barrier()
#define PG8_SCHED __builtin_amdgcn_sched_barrier(0)
    Unit cur, nxt; int ui = 0;
    if (!S.next(0, cur)) return;
    f32x4 acc[2][2][4][2];
#pragma unroll
    for (int a = 0; a < 2; ++a)
#pragma unroll
        for (int b = 0; b < 2; ++b)
#pragma unroll
            for (int m = 0; m < 4; ++m)
#pragma unroll
                for (int n = 0; n < 2; ++n) acc[a][b][m][n] = (f32x4){0.f, 0.f, 0.f, 0.f};
    bf16x8 At[4][2], B0[2][2], B1[2][2];
    const char* cA = (const char*)g.A + (size_t)cur.pm * tstep; const char* cB = (const char*)g.Bt + (size_t)cur.pn * tstep;
    S.a_ready(cur);
    if constexpr (SP2) {
        PG8_STAGE(PG8_SB(0, 0), cB, voffB); PG8_STAGE(PG8_SB(0, 1), cB + hstep, voffB); PG8_STAGE(PG8_SA(0, 0), cA, voffA); PG8_STAGE(PG8_SA(0, 1), cA + hstep, voffA);
        if (wr == 1) PG8_BAR;
        PG8_WAIT_V(2); PG8_BAR;
        PG8_STAGE(PG8_SB(1, 0), cB + kstep, voffB); PG8_STAGE(PG8_SA(1, 0), cA + kstep, voffA); PG8_STAGE(PG8_SB(1, 1), cB + hstep + kstep, voffB);
        PG8_WAIT_V(6); PG8_BAR;
    } else {
        PG8_STAGE(PG8_SB(0, 0), cB, voffB); PG8_STAGE(PG8_SA(0, 0), cA, voffA); PG8_STAGE(PG8_SB(0, 1), cB + hstep, voffB); PG8_STAGE(PG8_SA(0, 1), cA + hstep, voffA);
        if (wr == 1) PG8_BAR;
        PG8_WAIT_V(4); PG8_BAR;
        PG8_STAGE(PG8_SB(1, 0), cB + kstep, voffB); PG8_STAGE(PG8_SA(1, 0), cA + kstep, voffA); PG8_STAGE(PG8_SB(1, 1), cB + hstep + kstep, voffB);
        PG8_WAIT_V(6); PG8_BAR;
    }
    for (;;) {
        const bool has_next = S.next(ui + 1, nxt);
        const char* nA = has_next ? (const char*)g.A + (size_t)nxt.pm * tstep : cA; const char* nB = has_next ? (const char*)g.Bt + (size_t)nxt.pn * tstep : cB;
        for (int t = 0; t < nt; t += 2) {
            const bool last = (t == nt - 2);
            const char* a1 = cA + (size_t)(t + 1) * kstep;
            const char* a2 = last ? nA : cA + (size_t)(t + 2) * kstep; const char* b2 = last ? nB : cB + (size_t)(t + 2) * kstep;
            const char* a3 = a2 + kstep; const char* b3 = b2 + kstep;
            if (last && has_next) S.a_ready(nxt);
            if constexpr (SP2) {
            PG8_LDB(B0, 0, 0); PG8_LDB(B1, 0, 1); PG8_SCHED; PG8_LDA(At, 0, 0); PG8_STAGE(PG8_SA(1, 1), a1 + hstep, voffA);
            PG8_WAIT_V(8); PG8_WAIT_L(0); PG8_BAR; PG8_MMA(0, 0, At, B0); PG8_MMA(0, 1, At, B1); PG8_BAR; PG8_SCHED;
            PG8_LDA(At, 0, 1); PG8_STAGE(PG8_SB(0, 0), b2, voffB); PG8_STAGE(PG8_SB(0, 1), b2 + hstep, voffB); PG8_STAGE(PG8_SA(0, 0), a2, voffA);
            PG8_WAIT_V(8); PG8_WAIT_L(0); PG8_BAR; PG8_MMA(1, 0, At, B0); PG8_MMA(1, 1, At, B1); PG8_BAR; PG8_SCHED;
            PG8_LDB(B0, 1, 0); PG8_LDB(B1, 1, 1); PG8_SCHED; PG8_LDA(At, 1, 0); PG8_STAGE(PG8_SA(0, 1), a2 + hstep, voffA);
            PG8_WAIT_V(8); PG8_WAIT_L(0); PG8_BAR; PG8_MMA(0, 0, At, B0); PG8_MMA(0, 1, At, B1); PG8_BAR; PG8_SCHED;
            PG8_LDA(At, 1, 1); PG8_STAGE(PG8_SB(1, 0), b3, voffB); PG8_STAGE(PG8_SB(1, 1), b3 + hstep, voffB); PG8_STAGE(PG8_SA(1, 0), a3, voffA);
            PG8_WAIT_V(8); PG8_WAIT_L(0); PG8_BAR; PG8_MMA(1, 0, At, B0); PG8_MMA(1, 1, At, B1); PG8_BAR; PG8_SCHED;
            } else {
            PG8_LDB(B0, 0, 0); PG8_SCHED; PG8_LDA(At, 0, 0); PG8_STAGE(PG8_SA(1, 1), a1 + hstep, voffA);
            PG8_WAIT_L(8); PG8_BAR; PG8_WAIT_L(0); PG8_MMA(0, 0, At, B0); PG8_BAR; PG8_SCHED;
            PG8_LDB(B1, 0, 1); PG8_STAGE(PG8_SB(0, 0), b2, voffB);
            PG8_BAR; PG8_WAIT_L(0); PG8_MMA(0, 1, At, B1); PG8_BAR;
            PG8_LDA(At, 0, 1); PG8_STAGE(PG8_SA(0, 0), a2, voffA);
            PG8_BAR; PG8_WAIT_L(0); PG8_MMA(1, 0, At, B0); PG8_BAR; PG8_SCHED;
            PG8_STAGE(PG8_SB(0, 1), b2 + hstep, voffB);
            PG8_WAIT_V(6); PG8_BAR; PG8_MMA(1, 1, At, B1); PG8_BAR;
            PG8_LDB(B0, 1, 0); PG8_SCHED; PG8_LDA(At, 1, 0); PG8_STAGE(PG8_SA(0, 1), a2 + hstep, voffA);
            PG8_WAIT_L(8); PG8_BAR; PG8_WAIT_L(0); PG8_MMA(0, 0, At, B0); PG8_BAR; PG8_SCHED;
            PG8_LDB(B1, 1, 1); PG8_STAGE(PG8_SB(1, 0), b3, voffB);
            PG8_BAR; PG8_WAIT_L(0); PG8_MMA(0, 1, At, B1); PG8_BAR;
            PG8_LDA(At, 1, 1); PG8_STAGE(PG8_SA(1, 0), a3, voffA);
            PG8_BAR; PG8_WAIT_L(0); PG8_MMA(1, 0, At, B0); PG8_BAR; PG8_SCHED;
            PG8_STAGE(PG8_SB(1, 1), b3 + hstep, voffB);
            PG8_WAIT_V(6); PG8_BAR; PG8_MMA(1, 1, At, B1); PG8_BAR;
            }
        }
        if constexpr (ALIGN_EPI) { if (wr == 0) PG8_BAR; }
        if constexpr (!Epi::AFTER_DRAIN) { E(acc, cur, wr, wc, fr, fq); S.done(cur); }
        if (!has_next) break;
#pragma unroll
        for (int a = 0; a < 2; ++a)
#pragma unroll
            for (int b = 0; b < 2; ++b)
#pragma unroll
                for (int m = 0; m < 4; ++m)
#pragma unroll
                    for (int n = 0; n < 2; ++n) acc[a][b][m][n] = (f32x4){0.f, 0.f, 0.f, 0.f};
        cur = nxt; cA = nA; cB = nB; ++ui;
        if constexpr (ALIGN_EPI) { if (wr == 1) PG8_BAR; }
    }
    PG8_WAIT_V(0);
    if constexpr (!ALIGN_EPI) { if (wr == 0) PG8_BAR; }
    PG8_BAR;
    if constexpr (Epi::AFTER_DRAIN) { E.fused(acc, cur, wr, wc, fr, fq, lds, wid, lane); S.done(cur); }
#undef PG8_SA
#undef PG8_SB
#undef PG8_STAGE
#undef PG8_LDA
#undef PG8_LDB
#undef PG8_MMA
#undef PG8_WAIT_V
#undef PG8_WAIT_L
#undef PG8_BAR
#undef PG8_SCHED
}
}

#ifndef PG8_SP2
#define PG8_SP2 true
#endif

constexpr int NWAVES = 8;
#ifndef MK_N_LAUNCHES
#define MK_N_LAUNCHES 11
#endif
constexpr int N_PHASES = 11;
constexpr int N_LAUNCHES = MK_N_LAUNCHES;

constexpr int BATCH = 16, SEQ = 2048, D = 1024, M = BATCH * SEQ;
constexpr int IN_COLS = 2560;
constexpr int C_Q = 0, C_K = 512, C_V = 640, C_RW = 768;
constexpr int RW_R = 0, RW_K = 512, RW_V = 1024, RW_WD = 1536, RW_AD = 1600, RW_GD = 1664;
constexpr int NSC = 2048;
constexpr float LN_EPS = 1e-5f, GN_EPS = 64e-5f;
constexpr float ALPHA = 1.189207115002721f;

constexpr size_t MiB = 1u << 20;
constexpr size_t WS_CTL = 0, CTL_ZERO_BYTES = 1 * MiB;
constexpr size_t WS_WIN = 1 * MiB;
constexpr size_t WS_WOUT = 6 * MiB;
constexpr size_t WS_WP = 8 * MiB;
constexpr size_t WS_MOD = 12 * MiB;
constexpr size_t WS_FRAG = 13 * MiB;
constexpr size_t WS_H = 16 * MiB;
constexpr size_t WS_PROJ = 80 * MiB;
constexpr size_t WS_RW_W = 240 * MiB;
constexpr size_t WS_RW_B = 304 * MiB;
constexpr size_t WS_RW_KK = 336 * MiB;
constexpr size_t WS_RW_K = 368 * MiB;
constexpr size_t WS_RW_G = 400 * MiB;
constexpr size_t WS_MIX = 432 * MiB;
constexpr size_t WS_Y1 = 336 * MiB;
constexpr size_t WS_UB = 400 * MiB;
constexpr size_t WS_VB = 432 * MiB;
constexpr size_t WS_SC = 80 * MiB;
constexpr size_t WS_PIDX = 464 * MiB;
constexpr size_t WS_PGATE = 480 * MiB;
constexpr size_t WS_END = 496 * MiB;

constexpr int CW_TMO = 0, CW_CODE = 1;
constexpr int CW_BAR = 4096;

constexpr int RING_OFF = 0, RING_BYTES = 131072;
constexpr int LDSCTL_OFF = RING_BYTES, MISC_OFF = LDSCTL_OFF + 320;
constexpr int LDS_BYTES = 147456;
#define GAS __attribute__((address_space(1)))
#define LAS __attribute__((address_space(3)))
typedef unsigned short bf16;
typedef unsigned v4u __attribute__((ext_vector_type(4)));
typedef float f32x4 __attribute__((ext_vector_type(4)));
typedef short bf16x8 __attribute__((ext_vector_type(8)));
typedef GAS unsigned gu32;
typedef GAS unsigned long long gu64;
#define RLX_AGENT __ATOMIC_RELAXED, __HIP_MEMORY_SCOPE_AGENT
#define LDS_WAIT() asm volatile("s_waitcnt lgkmcnt(0)" ::: "memory")
#define VM_WAIT() asm volatile("s_waitcnt vmcnt(0)" ::: "memory")
__device__ __forceinline__ unsigned long long rt() { return __builtin_amdgcn_s_memrealtime(); }
__device__ __forceinline__ unsigned f2bf(float f) { unsigned u = __builtin_bit_cast(unsigned, f); return (u + 0x7fffu + ((u >> 16) & 1u)) >> 16; }
__device__ __forceinline__ unsigned pk2(float lo, float hi) { return f2bf(lo) | (f2bf(hi) << 16); }

#define XB_TMO      128
#define XB_XCNT(j)  (256  + 64 * (j))
#define XB_XSUB(j)  (1280 + 64 * (j))
#define XB_XGEN(j)  (2304 + 64 * (j))
#define XB_TOP      3328
#define XB_TOPGEN   3392
#define XCD_BAR_WORDS 3456
#define XB_SPIN_CAP (1u << 18)

__device__ __forceinline__ unsigned xb_ld(unsigned* p)              { return __hip_atomic_load(p, __ATOMIC_RELAXED, __HIP_MEMORY_SCOPE_AGENT); }
__device__ __forceinline__ unsigned xb_add(unsigned* p, unsigned v) { return __hip_atomic_fetch_add(p, v, __ATOMIC_RELAXED, __HIP_MEMORY_SCOPE_AGENT); }
__device__ __forceinline__ unsigned xb_xcc_id() { return (unsigned)__builtin_amdgcn_s_getreg((3 << 11) | 20) & 0xFu; }
#define XB_SPIN(cond, bar) do { unsigned _sp = 0; while (cond) { __builtin_amdgcn_s_sleep(1); \
    if ((++_sp & 255u) == 0u) { if (xb_ld(&(bar)[XB_TMO])) break; if (_sp > XB_SPIN_CAP) { atomicAdd(&(bar)[XB_TMO], 1u); break; } } } } while (0)

struct XcdBarrier {
    unsigned* bar; unsigned x;
    volatile LAS unsigned* st;
};

__device__ __forceinline__ XcdBarrier xcd_barrier_post(unsigned* bar, volatile LAS unsigned* st) {
    XcdBarrier b; b.bar = bar; b.x = xb_xcc_id(); b.st = st;
    if (threadIdx.x == 0) (void)xb_add(&bar[XB_XCNT(b.x)], 1u);
    return b;
}
__device__ __forceinline__ void xcd_barrier_complete(unsigned* bar, unsigned x, unsigned& nloc, unsigned& nx) {
    const unsigned G = gridDim.x * gridDim.y * gridDim.z;
    unsigned sum, cnt, mine, sp = 0u;
    for (;;) {
        sum = 0u; cnt = 0u; mine = 0u;
#pragma unroll
        for (unsigned j = 0; j < 16; ++j) { const unsigned c = xb_ld(&bar[XB_XCNT(j)]); sum += c; cnt += (c > 0u) ? 1u : 0u; mine = (j == x) ? c : mine; }
        if (sum == G) break;
        __builtin_amdgcn_s_sleep(1);
        if ((++sp & 255u) == 0u) { if (xb_ld(&bar[XB_TMO])) break; if (sp > XB_SPIN_CAP) { atomicAdd(&bar[XB_TMO], 1u); break; } }
    }
    nloc = mine > 0u ? mine : 1u; nx = cnt > 0u ? cnt : 1u;
}

__device__ __forceinline__ void xcd_barrier(const XcdBarrier& b) {
    asm volatile("s_waitcnt vmcnt(0)" ::: "memory");
    __syncthreads();
    if (threadIdx.x == 0) {
        unsigned* bar = b.bar;
        __builtin_amdgcn_s_waitcnt(0);
        unsigned nloc = b.st[0], nx = b.st[1];
        if (nloc == 0u) { xcd_barrier_complete(bar, b.x, nloc, nx); b.st[0] = nloc; b.st[1] = nx; }
        const unsigned old = xb_add(&bar[XB_XSUB(b.x)], 1u);
        const unsigned gen = old / nloc;
        if (old + 1u == (gen + 1u) * nloc) {
            __builtin_amdgcn_fence(__ATOMIC_RELEASE, "agent");
            asm volatile("s_waitcnt vmcnt(0)" ::: "memory");
            const unsigned og = xb_add(&bar[XB_TOP], 1u);
            const unsigned tg = og / nx;
            if (og + 1u == (tg + 1u) * nx) xb_add(&bar[XB_TOPGEN], 1u);
            else XB_SPIN(xb_ld(&bar[XB_TOPGEN]) == tg, bar);
            __builtin_amdgcn_fence(__ATOMIC_ACQUIRE, "agent");
            xb_add(&bar[XB_XGEN(b.x)], 1u);
            asm volatile("s_waitcnt vmcnt(0)" ::: "memory");
        } else {
            XB_SPIN(xb_ld(&bar[XB_XGEN(b.x)]) == gen, bar);
            __builtin_amdgcn_fence(__ATOMIC_ACQUIRE, "agent");
            asm volatile("s_waitcnt vmcnt(0)" ::: "memory");
        }
    }
    __syncthreads();
}

typedef unsigned v2u __attribute__((ext_vector_type(2)));
typedef short s16x4 __attribute__((ext_vector_type(4)));
typedef __bf16 bf16x2_t __attribute__((ext_vector_type(2)));
struct Frame {
    LAS unsigned char* lds;
    volatile LAS unsigned* MISC;
    gu32* ctl;
    int tid, lane, wave;
    int vcu, G;
    const float* in[26]; float* out; unsigned char* ws;
};
__device__ __forceinline__ float bflo(unsigned u) { return __uint_as_float(u << 16); }
__device__ __forceinline__ float bfhi(unsigned u) { return __uint_as_float(u & 0xffff0000u); }
__device__ __forceinline__ float wave_sum(float v) {
#pragma unroll
    for (int o = 1; o < 64; o <<= 1) v += __shfl_xor(v, o);
    return v;
}
__device__ __forceinline__ float dpp_f(float x, const int ctrl_sel) {
    const int xi = __float_as_int(x); int r;
    if (ctrl_sel == 0) r = __builtin_amdgcn_update_dpp(xi, xi, 0xB1, 0xf, 0xf, false);
    else if (ctrl_sel == 1) r = __builtin_amdgcn_update_dpp(xi, xi, 0x4E, 0xf, 0xf, false);
    else if (ctrl_sel == 2) r = __builtin_amdgcn_update_dpp(xi, xi, 0x141, 0xf, 0xf, false);
    else r = __builtin_amdgcn_update_dpp(xi, xi, 0x140, 0xf, 0xf, false);
    return __int_as_float(r);
}
__device__ __forceinline__ float red8(float x) { x += dpp_f(x, 0); x += dpp_f(x, 1); x += dpp_f(x, 2); return x; }
__device__ __forceinline__ float red16(float x) { x += dpp_f(x, 0); x += dpp_f(x, 1); x += dpp_f(x, 2); x += dpp_f(x, 3); return x; }

__device__ __forceinline__ void ph_mod(Frame& F) {
    const float* c = F.in[1]; const float* W = F.in[2]; const float* bias = F.in[3];
    float* mod = (float*)(F.ws + WS_MOD);
    LAS float* scr = (LAS float*)(F.lds + F.wave * 16384);
    for (int it = blockIdx.x; it < 96; it += F.G) {
        const int col = it * 64 + F.lane, k0 = F.wave * 128;
        for (int i = F.lane; i < 2048; i += 64) { const int b = i >> 7, k = i & 127; const float v = c[b * 1024 + k0 + k]; scr[i] = v / (1.f + __expf(-v)); }
        LDS_WAIT();
        float acc[16];
#pragma unroll
        for (int b = 0; b < 16; ++b) acc[b] = 0.f;
        for (int k = 0; k < 128; k += 4) {
            const float* wp = W + (size_t)(k0 + k) * 6144 + col;
            const float w0 = wp[0], w1 = wp[6144], w2 = wp[2 * 6144], w3 = wp[3 * 6144];
#pragma unroll
            for (int b = 0; b < 16; ++b) { const f32x4 cs = *(const LAS f32x4*)(scr + b * 128 + k); acc[b] += (cs.x * w0 + cs.y * w1) + (cs.z * w2 + cs.w * w3); }
        }
#pragma unroll
        for (int b = 0; b < 16; ++b) scr[2048 + b * 64 + F.lane] = acc[b];
        __syncthreads();
        for (int o = F.tid; o < 1024; o += 512) {
            const int b = o >> 6, cc = o & 63; float s = bias[it * 64 + cc];
#pragma unroll
            for (int w = 0; w < 8; ++w) s += ((const LAS float*)(F.lds + w * 16384))[2048 + b * 64 + cc];
            mod[b * 6144 + it * 64 + cc] = s;
        }
        __syncthreads();
    }
}

__device__ __forceinline__ void p0_transpose_item(const float* W, int K, int N, bf16* WT, int row_off, LAS float* scr, int item, int lane) {
    const int nblk = N / 32, kb = item / nblk, nb = item % nblk, k0 = 64 * kb, n0 = 32 * nb;
#pragma unroll 8
    for (int i = 0; i < 32; ++i) { const int kk = 2 * i + (lane >> 5); scr[kk * 33 + (lane & 31)] = W[(size_t)(k0 + kk) * N + n0 + (lane & 31)]; }
    LDS_WAIT(); asm volatile("" ::: "memory");
    const int c = lane & 7;
#pragma unroll
    for (int j = 0; j < 4; ++j) { const int n = (lane >> 3) + 8 * j; const LAS float* s = scr + (8 * c) * 33 + n;
        v4u o; o.x = pk2(s[0 * 33], s[1 * 33]); o.y = pk2(s[2 * 33], s[3 * 33]); o.z = pk2(s[4 * 33], s[5 * 33]); o.w = pk2(s[6 * 33], s[7 * 33]);
        *(GAS v4u*)(WT + (size_t)(row_off + n0 + n) * K + k0 + 8 * c) = o; }
    LDS_WAIT(); asm volatile("" ::: "memory");
}
__device__ __forceinline__ void p0_wp_item(const float* wq, const float* sk, bf16* WpT, LAS float* scr, int item, int lane) {
    const int nq = item & 3, kb = (item >> 2) & 15, hc = item >> 6;
    const int k = kb * 64 + lane, n0 = nq * 32;
    const float* skb = sk + (size_t)(hc * 128 + n0) * 128;
    for (int i = lane; i < 1024; i += 64) ((LAS f32x4*)scr)[i] = ((const f32x4*)skb)[i];
    LDS_WAIT(); asm volatile("" ::: "memory");
    float acc[32];
#pragma unroll
    for (int n = 0; n < 32; ++n) acc[n] = 0.f;
    const float* wrow = wq + (size_t)k * 2048 + hc * 128;
    for (int d4 = 0; d4 < 32; ++d4) {
        const f32x4 w = *(const f32x4*)(wrow + 4 * d4);
#pragma unroll
        for (int n = 0; n < 32; ++n) { const f32x4 s = *(const LAS f32x4*)(scr + n * 128 + 4 * d4); acc[n] += (w.x * s.x + w.y * s.y) + (w.z * s.z + w.w * s.w); }
    }
#pragma unroll
    for (int n = 0; n < 32; ++n) WpT[(size_t)(hc * 128 + n0 + n) * 1024 + k] = (bf16)f2bf(acc[n]);
    LDS_WAIT(); asm volatile("" ::: "memory");
}
__device__ __forceinline__ void ph_prologue(Frame& F) {
    LAS float* scr = (LAS float*)(F.lds + F.wave * 16384);
    const int gw = F.vcu * NWAVES + F.wave, NGW = F.G * NWAVES;
    constexpr int I_WP = 16 * 16 * 4, I_IN = (D / 64) * (IN_COLS / 32), I_OUT = (D / 64) * (D / 32);
    constexpr int NITEMS = I_WP + I_IN + I_OUT;
    bf16* WinT = (bf16*)(F.ws + WS_WIN); bf16* WoutT = (bf16*)(F.ws + WS_WOUT); bf16* WpT = (bf16*)(F.ws + WS_WP);
    for (int it = gw; it < NITEMS; it += NGW) {
        int r = it;
        if (r < I_WP) { p0_wp_item(F.in[20], F.in[21], WpT, scr, r, F.lane); continue; } r -= I_WP;
        if (r < I_IN) { p0_transpose_item(F.in[4], D, IN_COLS, WinT, 0, scr, r, F.lane); continue; } r -= I_IN;
        p0_transpose_item(F.in[17], D, D, WoutT, 0, scr, r, F.lane);
    }
    for (int it = gw; it < 256; it += NGW) {
        const float* W; int rel, KS;
        if (it < 64) { W = F.in[8]; rel = it; KS = 2; } else if (it < 128) { W = F.in[10]; rel = it - 64; KS = 2; } else { W = F.in[11]; rel = it - 128; KS = 4; }
        const int nb = rel & 3, ks = (rel >> 2) % KS, head = (rel >> 2) / KS, tq = F.lane & 15, g = F.lane >> 4;
        float wv[8];
#pragma unroll
        for (int j = 0; j < 8; ++j) wv[j] = W[(size_t)(32 * ks + 8 * g + j) * 512 + head * 64 + nb * 16 + tq];
        v4u o; o.x = pk2(wv[0], wv[1]); o.y = pk2(wv[2], wv[3]); o.z = pk2(wv[4], wv[5]); o.w = pk2(wv[6], wv[7]);
        *(v4u*)(F.ws + WS_FRAG + ((size_t)it * 64 + F.lane) * 16) = o;
    }
    const float* modp = (const float*)(F.ws + WS_MOD);
    for (int m = gw; m < M; m += NGW) {
        const float* x = F.in[0] + (size_t)m * D; const float* md = modp + (m >> 11) * 6144;
        bf16* h = (bf16*)(F.ws + WS_H) + (size_t)m * D;
#pragma unroll
        for (int j = 0; j < 4; ++j) { const int col = 4 * F.lane + 256 * j;
            const f32x4 xv = *(const f32x4*)(x + col), sh = *(const f32x4*)(md + col), sc = *(const f32x4*)(md + 1024 + col);
            const f32x4 v = xv * (sc + 1.0f) + sh; v2u o; o.x = pk2(v.x, v.y); o.y = pk2(v.z, v.w); *(v2u*)(h + col) = o; }
    }
}

constexpr int ACT_PITCH = 264;
__device__ __forceinline__ void ph_prep(Frame& F) {
    const bf16* PROJ = (const bf16*)(F.ws + WS_PROJ);
    const float* mu = F.in[6]; const float* w0 = F.in[7]; const float* a0 = F.in[9];
    const float* k_k = F.in[12]; const float* k_a = F.in[13];
    float* RWW = (float*)(F.ws + WS_RW_W); bf16* RWB = (bf16*)(F.ws + WS_RW_B); bf16* RWKK = (bf16*)(F.ws + WS_RW_KK); bf16* RWK = (bf16*)(F.ws + WS_RW_K); bf16* RWG = (bf16*)(F.ws + WS_RW_G);
    LAS bf16* act = (LAS bf16*)(F.lds);
    const int tq = F.lane & 15, g = F.lane >> 4, head = F.wave;
    const bf16x8* FR = (const bf16x8*)(F.ws + WS_FRAG);
    bf16x8 Bw[2][4], Ba[2][4];
#pragma unroll
    for (int ks = 0; ks < 2; ++ks)
#pragma unroll
        for (int nb = 0; nb < 4; ++nb) { Bw[ks][nb] = FR[(size_t)(((head * 2 + ks) * 4 + nb)) * 64 + F.lane]; Ba[ks][nb] = FR[(size_t)(64 + ((head * 2 + ks) * 4 + nb)) * 64 + F.lane]; }
    for (int tile = F.vcu; tile < M / 16; tile += F.G) {
        const int t0 = tile * 16;
        {
            const int token = F.tid >> 5, cg = F.tid & 31; const int row = t0 + token; const bool has_prev = (row & (SEQ - 1)) != 0;
            const bf16* p = PROJ + (size_t)row * IN_COLS + C_RW + RW_WD + 8 * cg;
            const v4u cur = *(const v4u*)p; v4u prv = (v4u){0u, 0u, 0u, 0u}; if (has_prev) prv = *(const v4u*)(p - IN_COLS);
            const f32x4 m0 = *(const f32x4*)(mu + RW_WD + 8 * cg), m1 = *(const f32x4*)(mu + RW_WD + 8 * cg + 4);
            float v[8];
            { const unsigned cu[4] = {cur.x, cur.y, cur.z, cur.w}, pu[4] = {prv.x, prv.y, prv.z, prv.w}; const float mm[8] = {m0.x, m0.y, m0.z, m0.w, m1.x, m1.y, m1.z, m1.w};
#pragma unroll
              for (int e = 0; e < 4; ++e) { const float c0 = bflo(cu[e]), c1 = bfhi(cu[e]), p0 = bflo(pu[e]), p1 = bfhi(pu[e]);
                  v[2 * e] = c0 + (p0 - c0) * mm[2 * e]; v[2 * e + 1] = c1 + (p1 - c1) * mm[2 * e + 1]; } }
            if (cg < 8) {
#pragma unroll
                for (int e = 0; e < 8; ++e) v[e] = tanhf(v[e]);
            } else if (cg >= 16) {
#pragma unroll
                for (int e = 0; e < 8; ++e) v[e] = 1.f / (1.f + __expf(-v[e]));
            }
            v4u o; o.x = pk2(v[0], v[1]); o.y = pk2(v[2], v[3]); o.z = pk2(v[4], v[5]); o.w = pk2(v[6], v[7]);
            *(LAS v4u*)(act + token * ACT_PITCH + 8 * cg) = o;
        }
        __syncthreads();
        const int row = t0 + tq; const bool has_prev = (row & (SEQ - 1)) != 0;
        {
            f32x4 accg[4];
#pragma unroll
            for (int nb = 0; nb < 4; ++nb) accg[nb] = (f32x4){0.f, 0.f, 0.f, 0.f};
#pragma unroll
            for (int ks = 0; ks < 4; ++ks) {
                const bf16x8 Ag = *(const LAS bf16x8*)(act + tq * ACT_PITCH + 128 + 32 * ks + 8 * g);
#pragma unroll
                for (int nb = 0; nb < 4; ++nb) { const bf16x8 Bg = FR[(size_t)(128 + ((head * 4 + ks) * 4 + nb)) * 64 + F.lane]; accg[nb] = __builtin_amdgcn_mfma_f32_16x16x32_bf16(Bg, Ag, accg[nb], 0, 0, 0); }
            }
#pragma unroll
            for (int nb = 0; nb < 4; ++nb) { const int col = head * 64 + nb * 16 + 4 * g; v2u o; o.x = pk2(accg[nb][0], accg[nb][1]); o.y = pk2(accg[nb][2], accg[nb][3]); *(v2u*)(RWG + (size_t)row * 512 + col) = o; }
        }
        f32x4 accw[4], acca[4];
#pragma unroll
        for (int nb = 0; nb < 4; ++nb) { accw[nb] = (f32x4){0.f, 0.f, 0.f, 0.f}; acca[nb] = accw[nb]; }
#pragma unroll
        for (int ks = 0; ks < 2; ++ks) {
            const bf16x8 Aw = *(const LAS bf16x8*)(act + tq * ACT_PITCH + 32 * ks + 8 * g);
            const bf16x8 Aa = *(const LAS bf16x8*)(act + tq * ACT_PITCH + 64 + 32 * ks + 8 * g);
#pragma unroll
            for (int nb = 0; nb < 4; ++nb) { accw[nb] = __builtin_amdgcn_mfma_f32_16x16x32_bf16(Bw[ks][nb], Aw, accw[nb], 0, 0, 0);
                                             acca[nb] = __builtin_amdgcn_mfma_f32_16x16x32_bf16(Ba[ks][nb], Aa, acca[nb], 0, 0, 0); }
        }
        float kv[4][4], kkraw[4][4], av[4][4]; float ss = 0.f;
#pragma unroll
        for (int nb = 0; nb < 4; ++nb) {
            const int col = head * 64 + nb * 16 + 4 * g;
            const bf16* p = PROJ + (size_t)row * IN_COLS + C_RW + RW_K + col;
            const v2u cur = *(const v2u*)p; v2u prv = (v2u){0u, 0u}; if (has_prev) prv = *(const v2u*)(p - IN_COLS);
            const f32x4 mk = *(const f32x4*)(mu + RW_K + col), kk4 = *(const f32x4*)(k_k + col), w04 = *(const f32x4*)(w0 + col), a04 = *(const f32x4*)(a0 + col);
            const float cc[4] = {bflo(cur.x), bfhi(cur.x), bflo(cur.y), bfhi(cur.y)}, pp[4] = {bflo(prv.x), bfhi(prv.x), bflo(prv.y), bfhi(prv.y)};
            f32x4 dec;
#pragma unroll
            for (int i = 0; i < 4; ++i) {
                const float k = cc[i] + (pp[i] - cc[i]) * mk[i]; kv[nb][i] = k;
                const float kr = k * kk4[i]; kkraw[nb][i] = kr; ss += kr * kr;
                const float lw = accw[nb][i] + w04[i], z = -lw;
                const float sp = fmaxf(z, 0.f) + __logf(1.f + __expf(-fabsf(z)));
                dec[i] = __expf(-__expf(-sp - 0.5f));
                av[nb][i] = 1.f / (1.f + __expf(-(acca[nb][i] + a04[i])));
            }
            *(f32x4*)(RWW + (size_t)row * 512 + col) = dec;
        }
        ss += __shfl_xor(ss, 16); ss += __shfl_xor(ss, 32);
        const float rn = rsqrtf(fmaxf(ss, 1e-24f));
#pragma unroll
        for (int nb = 0; nb < 4; ++nb) {
            const int col = head * 64 + nb * 16 + 4 * g;
            const f32x4 ka4 = *(const f32x4*)(k_a + col);
            float kkn[4], bb[4], kp[4];
#pragma unroll
            for (int i = 0; i < 4; ++i) { kkn[i] = kkraw[nb][i] * rn; bb[i] = kkn[i] * av[nb][i]; kp[i] = kv[nb][i] * (1.f + (av[nb][i] - 1.f) * ka4[i]); }
            v2u o;
            o.x = pk2(kkn[0], kkn[1]); o.y = pk2(kkn[2], kkn[3]); *(v2u*)(RWKK + (size_t)row * 512 + col) = o;
            o.x = pk2(bb[0], bb[1]); o.y = pk2(bb[2], bb[3]); *(v2u*)(RWB + (size_t)row * 512 + col) = o;
            o.x = pk2(kp[0], kp[1]); o.y = pk2(kp[2], kp[3]); *(v2u*)(RWK + (size_t)row * 512 + col) = o;
        }
        __syncthreads();
    }
}

constexpr int KV_PITCH = 72;
__device__ __forceinline__ s16x4 tr_read(const LAS bf16* p) { typedef short v4i16_t __attribute__((ext_vector_type(4))); return __builtin_bit_cast(s16x4, __builtin_amdgcn_ds_read_tr16_b64_v4i16((LAS v4i16_t*)p)); }
__device__ __forceinline__ void ph_attn(Frame& F) {
    const bf16* PROJ = (const bf16*)(F.ws + WS_PROJ); bf16* MIX = (bf16*)(F.ws + WS_MIX); const float* sink = F.in[5];
    LAS bf16* Ks = (LAS bf16*)(F.lds); LAS bf16* Vs = Ks + 256 * KV_PITCH;
    for (int i = F.tid; i < 16 * KV_PITCH / 2; i += 512) ((LAS unsigned*)(Vs + 256 * KV_PITCH))[i] = 0u;
    const int tq = F.lane & 15, g = F.lane >> 4;
    for (int u = F.vcu; u < 512; u += F.G) {
        const int b = u >> 5, kvh = (u >> 4) & 1, n = u & 15;
        const size_t row0 = (size_t)b * SEQ + (size_t)n * 128;
#pragma unroll
        for (int i = 0; i < 4; ++i) {
            const int c = F.tid + 512 * i, krow = c >> 3, part = c & 7;
            v4u kx = (v4u){0u, 0u, 0u, 0u}, vx = kx;
            if (n > 0 || krow >= 128) { const bf16* src = PROJ + (row0 - 128 + krow) * IN_COLS + kvh * 64 + part * 8; kx = *(const v4u*)(src + C_K); vx = *(const v4u*)(src + C_V); }
            *(LAS v4u*)(Ks + krow * KV_PITCH + part * 8) = kx; *(LAS v4u*)(Vs + krow * KV_PITCH + part * 8) = vx;
        }
        __syncthreads();
        const int gq = F.wave >> 1, qh = F.wave & 1, hq = kvh * 4 + gq; const float sinkv = sink[hq];
        for (int qb = 0; qb < 4; ++qb) {
            const int i0 = 64 * qh + 16 * qb, kb0 = 4 * qh + qb, iq = i0 + tq;
            const bf16* qp = PROJ + (row0 + iq) * IN_COLS + C_Q + hq * 64 + 8 * g;
            const bf16x8 Q0 = *(const bf16x8*)qp, Q1 = *(const bf16x8*)(qp + 32);
            float s[9][4]; float mx = -INFINITY;
#pragma unroll
            for (int kbi = 0; kbi < 9; ++kbi) {
                const LAS bf16* kp = Ks + ((kb0 + kbi) * 16 + tq) * KV_PITCH + 8 * g;
                f32x4 a = (f32x4){0.f, 0.f, 0.f, 0.f};
                a = __builtin_amdgcn_mfma_f32_16x16x32_bf16(*(const LAS bf16x8*)kp, Q0, a, 0, 0, 0);
                a = __builtin_amdgcn_mfma_f32_16x16x32_bf16(*(const LAS bf16x8*)(kp + 32), Q1, a, 0, 0, 0);
#pragma unroll
                for (int i = 0; i < 4; ++i) { const int j = (kb0 + kbi) * 16 + 4 * g + i; const bool ok = (j > iq) && (j <= iq + 128) && (n > 0 || j >= 128);
                    const float sv = ok ? a[i] * 0.125f : -INFINITY; s[kbi][i] = sv; mx = fmaxf(mx, sv); }
            }
            mx = fmaxf(mx, __shfl_xor(mx, 16)); mx = fmaxf(mx, __shfl_xor(mx, 32)); mx = fmaxf(mx, sinkv);
            float l = 0.f;
#pragma unroll
            for (int kbi = 0; kbi < 9; ++kbi)
#pragma unroll
                for (int i = 0; i < 4; ++i) { const float p = __expf(s[kbi][i] - mx); s[kbi][i] = p; l += p; }
            l += __shfl_xor(l, 16); l += __shfl_xor(l, 32); l += __expf(sinkv - mx);
            const float rl = 1.f / l;
            bf16x8 P[5];
#pragma unroll
            for (int pr = 0; pr < 5; ++pr) {
#pragma unroll
                for (int i = 0; i < 4; ++i) { P[pr][i] = (short)f2bf(s[2 * pr][i]); P[pr][4 + i] = (pr < 4) ? (short)f2bf(s[(pr < 4) ? 2 * pr + 1 : 0][i]) : (short)0; }
            }
            bf16* op = MIX + (row0 + iq) * D + hq * 64 + 4 * g;
#pragma unroll
            for (int db = 0; db < 4; ++db) {
                f32x4 o = (f32x4){0.f, 0.f, 0.f, 0.f};
#pragma unroll
                for (int pr = 0; pr < 5; ++pr) {
                    const LAS bf16* vp = Vs + ((kb0 + 2 * pr) * 16 + 4 * g + (tq >> 2)) * KV_PITCH + db * 16 + 4 * (tq & 3);
                    const s16x4 lo = tr_read(vp), hi = tr_read(vp + 16 * KV_PITCH);
                    const bf16x8 Vf = (bf16x8){lo[0], lo[1], lo[2], lo[3], hi[0], hi[1], hi[2], hi[3]};
                    o = __builtin_amdgcn_mfma_f32_16x16x32_bf16(Vf, P[pr], o, 0, 0, 0);
                }
                v2u w; w.x = pk2(o[0] * rl, o[1] * rl); w.y = pk2(o[2] * rl, o[3] * rl);
                *(v2u*)(op + db * 16) = w;
            }
        }
        __syncthreads();
    }
}

constexpr int SC_CH = 64;
constexpr int SCB_W = 0, SCB_NK = 16384, SCB_B = 24576, SCB_K = 32768, SCB_R = 40960, SCB_V = 49152, SCB_BYTES = 53248, SC_YB = 2 * SCB_BYTES;
struct ScanRegs { f32x4 w[2]; v4u kk, bb, kp, rc, rp, vc, vp; };
__device__ __forceinline__ v4u shift8(const v4u cur, const v4u prv, const f32x4 m0, const f32x4 m1) {
    const unsigned cu[4] = {cur.x, cur.y, cur.z, cur.w}, pu[4] = {prv.x, prv.y, prv.z, prv.w}; const float mm[8] = {m0.x, m0.y, m0.z, m0.w, m1.x, m1.y, m1.z, m1.w};
    unsigned o[4];
#pragma unroll
    for (int e = 0; e < 4; ++e) { const float c0 = bflo(cu[e]), c1 = bfhi(cu[e]), p0 = bflo(pu[e]), p1 = bfhi(pu[e]);
        o[e] = pk2(c0 + (p0 - c0) * mm[2 * e], c1 + (p1 - c1) * mm[2 * e + 1]); }
    return (v4u){o[0], o[1], o[2], o[3]};
}
__device__ __forceinline__ void ph_scan(Frame& F) {
    const bf16* PROJ = (const bf16*)(F.ws + WS_PROJ); const float* mu = F.in[6];
    const float* RWW = (const float*)(F.ws + WS_RW_W); const bf16* RWB = (const bf16*)(F.ws + WS_RW_B); const bf16* RWKK = (const bf16*)(F.ws + WS_RW_KK); const bf16* RWK = (const bf16*)(F.ws + WS_RW_K);
    float* Y = (float*)(F.ws + WS_H);
    const int tid = F.tid, vl = tid >> 4, kq = tid & 15;
    for (int item = F.vcu; item < 256; item += F.G) {
        const int bh = item >> 1, vh = item & 1, b = bh >> 3, h = bh & 7;
        const size_t rowb = (size_t)b * SEQ;
        const int st8 = tid >> 3, c8 = tid & 7;
        const f32x4 mr0 = *(const f32x4*)(mu + RW_R + h * 64 + 8 * c8), mr1 = *(const f32x4*)(mu + RW_R + h * 64 + 8 * c8 + 4);
        const int stv = tid >> 2, c8v = tid & 3;
        const f32x4 mv0 = *(const f32x4*)(mu + RW_V + h * 64 + vh * 32 + 8 * c8v), mv1 = *(const f32x4*)(mu + RW_V + h * 64 + vh * 32 + 8 * c8v + 4);
        ScanRegs R;
#define SCAN_LOAD(ch) do { const size_t r0_ = rowb + (size_t)(ch) * SC_CH; \
        _Pragma("unroll") for (int i_ = 0; i_ < 2; ++i_) { const int ii_ = tid + 512 * i_; R.w[i_] = *(const f32x4*)(RWW + (r0_ + (ii_ >> 4)) * 512 + h * 64 + 4 * (ii_ & 15)); } \
        const size_t o_ = (r0_ + st8) * 512 + h * 64 + 8 * c8; R.kk = *(const v4u*)(RWKK + o_); R.bb = *(const v4u*)(RWB + o_); R.kp = *(const v4u*)(RWK + o_); \
        const bf16* pr_ = PROJ + (r0_ + st8) * IN_COLS + C_RW + RW_R + h * 64 + 8 * c8; R.rc = *(const v4u*)pr_; R.rp = (v4u){0u, 0u, 0u, 0u}; if ((ch) > 0 || st8 > 0) R.rp = *(const v4u*)(pr_ - IN_COLS); \
        if (tid < 256) { const bf16* pv_ = PROJ + (r0_ + stv) * IN_COLS + C_RW + RW_V + h * 64 + vh * 32 + 8 * c8v; R.vc = *(const v4u*)pv_; R.vp = (v4u){0u, 0u, 0u, 0u}; if ((ch) > 0 || stv > 0) R.vp = *(const v4u*)(pv_ - IN_COLS); } } while (0)
#define SCAN_WRITE(buf) do { LAS unsigned char* bb_ = F.lds + (buf) * SCB_BYTES; \
        _Pragma("unroll") for (int i_ = 0; i_ < 2; ++i_) { const int ii_ = tid + 512 * i_; *(LAS f32x4*)(bb_ + SCB_W + ii_ * 16) = R.w[i_]; } \
        *(LAS v4u*)(bb_ + SCB_NK + tid * 16) = (v4u){R.kk.x ^ 0x80008000u, R.kk.y ^ 0x80008000u, R.kk.z ^ 0x80008000u, R.kk.w ^ 0x80008000u}; \
        *(LAS v4u*)(bb_ + SCB_B + tid * 16) = R.bb; *(LAS v4u*)(bb_ + SCB_K + tid * 16) = R.kp; \
        *(LAS v4u*)(bb_ + SCB_R + tid * 16) = shift8(R.rc, R.rp, mr0, mr1); \
        if (tid < 256) *(LAS v4u*)(bb_ + SCB_V + tid * 16) = shift8(R.vc, R.vp, mv0, mv1); } while (0)
        SCAN_LOAD(0); SCAN_WRITE(0);
        __syncthreads();
        float s0 = 0.f, s1 = 0.f, s2 = 0.f, s3 = 0.f;
        for (int ch = 0; ch < SEQ / SC_CH; ++ch) {
            if (ch + 1 < SEQ / SC_CH) SCAN_LOAD(ch + 1);
            const LAS unsigned char* bb = F.lds + (ch & 1) * SCB_BYTES;
            LAS float* yb = (LAS float*)(F.lds + SC_YB);
#pragma unroll 4
            for (int st = 0; st < SC_CH; ++st) {
                const f32x4 w = *(const LAS f32x4*)(bb + SCB_W + (st * 64 + 4 * kq) * 4);
                const v2u nk = *(const LAS v2u*)(bb + SCB_NK + (st * 64 + 4 * kq) * 2), bv = *(const LAS v2u*)(bb + SCB_B + (st * 64 + 4 * kq) * 2);
                const v2u kk = *(const LAS v2u*)(bb + SCB_K + (st * 64 + 4 * kq) * 2), rr = *(const LAS v2u*)(bb + SCB_R + (st * 64 + 4 * kq) * 2);
                const float v = __uint_as_float((unsigned)(*(const LAS unsigned short*)(bb + SCB_V + (st * 32 + vl) * 2)) << 16);
                float sa = (s0 * bflo(nk.x) + s1 * bfhi(nk.x)) + (s2 * bflo(nk.y) + s3 * bfhi(nk.y));
                sa = red16(sa);
                s0 = s0 * w.x + (sa * bflo(bv.x) + v * bflo(kk.x));
                s1 = s1 * w.y + (sa * bfhi(bv.x) + v * bfhi(kk.x));
                s2 = s2 * w.z + (sa * bflo(bv.y) + v * bflo(kk.y));
                s3 = s3 * w.w + (sa * bfhi(bv.y) + v * bfhi(kk.y));
                float y = (s0 * bflo(rr.x) + s1 * bfhi(rr.x)) + (s2 * bflo(rr.y) + s3 * bfhi(rr.y));
                y = red16(y);
                if (kq == 0) yb[st * 32 + vl] = y;
            }
            __syncthreads();
            { const int stp = tid >> 3, v4 = (tid & 7) * 4; const f32x4 yv = *(const LAS f32x4*)(yb + stp * 32 + v4);
              *(f32x4*)(Y + (rowb + (size_t)ch * SC_CH + stp) * 512 + h * 64 + vh * 32 + v4) = yv; }
            if (ch + 1 < SEQ / SC_CH) SCAN_WRITE((ch + 1) & 1);
            __syncthreads();
        }
#undef SCAN_LOAD
#undef SCAN_WRITE
    }
}

__device__ __forceinline__ void unpack8(const v4u u, float (&o)[8]) { o[0] = bflo(u.x); o[1] = bfhi(u.x); o[2] = bflo(u.y); o[3] = bfhi(u.y); o[4] = bflo(u.z); o[5] = bfhi(u.z); o[6] = bflo(u.w); o[7] = bfhi(u.w); }
__device__ __forceinline__ void ph_post(Frame& F) {
    const bf16* PROJ = (const bf16*)(F.ws + WS_PROJ); const float* mu = F.in[6]; const float* r_k = F.in[14]; const float* lnx_g = F.in[15]; const float* lnx_b = F.in[16];
    const float* Y = (const float*)(F.ws + WS_H); const bf16* RWK = (const bf16*)(F.ws + WS_RW_K); const bf16* RWG = (const bf16*)(F.ws + WS_RW_G); bf16* MIX = (bf16*)(F.ws + WS_MIX);
    const int gw = F.vcu * NWAVES + F.wave, NGW = F.G * NWAVES, j = F.lane * 8;
    float mr[8], mv[8], rk[8], lg[8], lb[8];
    { const f32x4 a = *(const f32x4*)(mu + RW_R + j), b = *(const f32x4*)(mu + RW_R + j + 4); mr[0] = a.x; mr[1] = a.y; mr[2] = a.z; mr[3] = a.w; mr[4] = b.x; mr[5] = b.y; mr[6] = b.z; mr[7] = b.w; }
    { const f32x4 a = *(const f32x4*)(mu + RW_V + j), b = *(const f32x4*)(mu + RW_V + j + 4); mv[0] = a.x; mv[1] = a.y; mv[2] = a.z; mv[3] = a.w; mv[4] = b.x; mv[5] = b.y; mv[6] = b.z; mv[7] = b.w; }
    { const f32x4 a = *(const f32x4*)(r_k + j), b = *(const f32x4*)(r_k + j + 4); rk[0] = a.x; rk[1] = a.y; rk[2] = a.z; rk[3] = a.w; rk[4] = b.x; rk[5] = b.y; rk[6] = b.z; rk[7] = b.w; }
    { const f32x4 a = *(const f32x4*)(lnx_g + j), b = *(const f32x4*)(lnx_g + j + 4); lg[0] = a.x; lg[1] = a.y; lg[2] = a.z; lg[3] = a.w; lg[4] = b.x; lg[5] = b.y; lg[6] = b.z; lg[7] = b.w; }
    { const f32x4 a = *(const f32x4*)(lnx_b + j), b = *(const f32x4*)(lnx_b + j + 4); lb[0] = a.x; lb[1] = a.y; lb[2] = a.z; lb[3] = a.w; lb[4] = b.x; lb[5] = b.y; lb[6] = b.z; lb[7] = b.w; }
    for (int m = gw; m < M; m += NGW) {
        const bool has_prev = (m & (SEQ - 1)) != 0;
        const f32x4 y0 = *(const f32x4*)(Y + (size_t)m * 512 + j), y1 = *(const f32x4*)(Y + (size_t)m * 512 + j + 4);
        const bf16* pr = PROJ + (size_t)m * IN_COLS + C_RW + RW_R + j; const bf16* pv = PROJ + (size_t)m * IN_COLS + C_RW + RW_V + j;
        const v4u rc = *(const v4u*)pr, vc = *(const v4u*)pv; v4u rp = (v4u){0u, 0u, 0u, 0u}, vp = rp; if (has_prev) { rp = *(const v4u*)(pr - IN_COLS); vp = *(const v4u*)(pv - IN_COLS); }
        const v4u kpu = *(const v4u*)(RWK + (size_t)m * 512 + j), gu = *(const v4u*)(RWG + (size_t)m * 512 + j);
        float y[8] = {y0.x, y0.y, y0.z, y0.w, y1.x, y1.y, y1.z, y1.w}, rc8[8], rp8[8], vc8[8], vp8[8], kp8[8], g8[8];
        unpack8(rc, rc8); unpack8(rp, rp8); unpack8(vc, vc8); unpack8(vp, vp8); unpack8(kpu, kp8); unpack8(gu, g8);
        float sum = 0.f, dot = 0.f; float vv[8];
#pragma unroll
        for (int e = 0; e < 8; ++e) { const float r = rc8[e] + (rp8[e] - rc8[e]) * mr[e]; vv[e] = vc8[e] + (vp8[e] - vc8[e]) * mv[e]; sum += y[e]; dot += r * kp8[e] * rk[e]; }
        sum = red8(sum); dot = red8(dot);
        const float mean = sum * (1.f / 64.f); float q = 0.f;
#pragma unroll
        for (int e = 0; e < 8; ++e) { y[e] -= mean; q += y[e] * y[e]; }
        q = red8(q);
        const float rstd = rsqrtf(q * (1.f / 64.f) + GN_EPS);
        float o[8];
#pragma unroll
        for (int e = 0; e < 8; ++e) o[e] = ((y[e] * rstd) * lg[e] + lb[e] + dot * vv[e]) * g8[e];
        v4u w; w.x = pk2(o[0], o[1]); w.y = pk2(o[2], o[3]); w.z = pk2(o[4], o[5]); w.w = pk2(o[6], o[7]);
        *(v4u*)(MIX + (size_t)m * D + 512 + j) = w;
    }
}

__device__ __forceinline__ void ph_ln1(Frame& F) {
    const int gw = F.vcu * NWAVES + F.wave, NGW = F.G * NWAVES;
    const float* modp = (const float*)(F.ws + WS_MOD); const bf16* Y1 = (const bf16*)(F.ws + WS_Y1); bf16* H2 = (bf16*)(F.ws + WS_H);
    const float* lng = F.in[18]; const float* lnb = F.in[19];
    for (int m = gw; m < M; m += NGW) {
        const float* x = F.in[0] + (size_t)m * D; const float* md = modp + (m >> 11) * 6144; const bf16* y1 = Y1 + (size_t)m * D;
        f32x4 v[4]; float s = 0.f;
#pragma unroll
        for (int j = 0; j < 4; ++j) { const int col = 4 * F.lane + 256 * j; const f32x4 xv = *(const f32x4*)(x + col), gt = *(const f32x4*)(md + 2048 + col); const v2u yu = *(const v2u*)(y1 + col);
            const f32x4 yv = (f32x4){bflo(yu.x), bfhi(yu.x), bflo(yu.y), bfhi(yu.y)}; v[j] = xv * ALPHA + gt * yv; s += (v[j].x + v[j].y) + (v[j].z + v[j].w); }
        const float mean = wave_sum(s) * (1.f / D); float s2 = 0.f;
#pragma unroll
        for (int j = 0; j < 4; ++j) { v[j] = v[j] - mean; s2 += (v[j].x * v[j].x + v[j].y * v[j].y) + (v[j].z * v[j].z + v[j].w * v[j].w); }
        const float rstd = rsqrtf(wave_sum(s2) * (1.f / D) + LN_EPS);
#pragma unroll
        for (int j = 0; j < 4; ++j) { const int col = 4 * F.lane + 256 * j; const f32x4 gg = *(const f32x4*)(lng + col), bb = *(const f32x4*)(lnb + col);
            const f32x4 x1 = (v[j] * rstd) * gg + bb; *(f32x4*)(F.out + (size_t)m * D + col) = x1;
            const f32x4 sh = *(const f32x4*)(md + 3072 + col), sc = *(const f32x4*)(md + 4096 + col); const f32x4 h = x1 * (sc + 1.0f) + sh;
            v2u o; o.x = pk2(h.x, h.y); o.y = pk2(h.z, h.w); *(v2u*)(H2 + (size_t)m * D + col) = o; }
    }
    bf16* UB = (bf16*)(F.ws + WS_UB); bf16* VB = (bf16*)(F.ws + WS_VB);
    for (int r = gw; r < 32768; r += NGW) {
        const float* src = (r < 16384) ? F.in[22] + (size_t)r * D : F.in[23] + (size_t)(r - 16384) * D; bf16* dst = (r < 16384) ? UB + (size_t)r * D : VB + (size_t)(r - 16384) * D;
#pragma unroll
        for (int j = 0; j < 4; ++j) { const int col = 4 * F.lane + 256 * j; const f32x4 xv = *(const f32x4*)(src + col); v2u o; o.x = pk2(xv.x, xv.y); o.y = pk2(xv.z, xv.w); *(v2u*)(dst + col) = o; }
    }
}

__device__ __forceinline__ unsigned f2key(float f) { const unsigned u = __float_as_uint(f); return u ^ ((u >> 31) ? 0xffffffffu : 0x80000000u); }
__device__ __forceinline__ float key2f(unsigned k) { const unsigned u = (k >> 31) ? (k ^ 0x80000000u) : ~k; return __uint_as_float(u); }
#define TOPK_INSERT(L, key) do { unsigned k_ = (key); _Pragma("unroll") for (int q_ = 0; q_ < 16; ++q_) { const unsigned hi_ = L[q_] > k_ ? L[q_] : k_; k_ = L[q_] > k_ ? k_ : L[q_]; L[q_] = hi_; } } while (0)
__device__ __forceinline__ unsigned pick_byte(const unsigned (&P)[4], unsigned i) {
    const unsigned long long lo = (unsigned long long)P[0] | ((unsigned long long)P[1] << 32), hi = (unsigned long long)P[2] | ((unsigned long long)P[3] << 32);
    const unsigned long long w = (i & 8u) ? hi : lo;
    return (unsigned)(w >> ((i & 7u) * 8u)) & 0xffu;
}
__device__ __forceinline__ void ph_topk(Frame& F) {
    const float* SC = (const float*)(F.ws + WS_SC); int* PIDX = (int*)(F.ws + WS_PIDX); float* PGATE = (float*)(F.ws + WS_PGATE);
    LAS float* scr = (LAS float*)(F.lds + F.wave * 16384);
    const int gw = F.vcu * NWAVES + F.wave, NGW = F.G * NWAVES, lane = F.lane;
    for (int item = gw; item < (M / 64) * 8; item += NGW) {
        const int bt = item >> 3, h = item & 7; const size_t t0 = (size_t)bt * 64;
        unsigned L0[16], L1[16];
#pragma unroll
        for (int q = 0; q < 16; ++q) { L0[q] = 0u; L1[q] = 0u; }
#pragma unroll
        for (int c = 0; c < 2; ++c) {
            for (int sub = 0; sub < 4; ++sub) {
                const float* src = SC + t0 * NSC + (h * 2 + c) * 128 + sub * 32;
#pragma unroll
                for (int it = 0; it < 8; ++it) { const int row = it * 8 + (lane >> 3), c4 = (lane & 7) * 4; const f32x4 v = *(const f32x4*)(src + (size_t)row * NSC + c4);
                    LAS float* d = scr + row * 33 + c4; d[0] = v.x; d[1] = v.y; d[2] = v.z; d[3] = v.w; }
                LDS_WAIT(); asm volatile("" ::: "memory");
#pragma unroll 4
                for (int ci = 0; ci < 32; ++ci) {
                    const float x = scr[lane * 33 + ci];
                    const unsigned key = (f2key(x) & ~127u) | (unsigned)(127 - (sub * 32 + ci));
                    if (c == 0) TOPK_INSERT(L0, key); else TOPK_INSERT(L1, key);
                }
                LDS_WAIT(); asm volatile("" ::: "memory");
            }
        }
        float v0[16], v1[16]; unsigned P0[4] = {0u, 0u, 0u, 0u}, P1[4] = {0u, 0u, 0u, 0u};
#pragma unroll
        for (int q = 0; q < 16; ++q) { v0[q] = key2f(L0[q] & ~127u); v1[q] = key2f(L1[q] & ~127u);
            P0[q >> 2] |= (127u - (L0[q] & 127u)) << ((q & 3) * 8); P1[q >> 2] |= (127u - (L1[q] & 127u)) << ((q & 3) * 8); }
        unsigned Fk[16];
#pragma unroll
        for (int q = 0; q < 16; ++q) Fk[q] = 0u;
#pragma unroll
        for (int i = 0; i < 16; ++i)
#pragma unroll
            for (int j = 0; j < 16; ++j) if ((i + 1) * (j + 1) <= 16) { const unsigned key = (f2key(v0[i] + v1[j]) & ~255u) | (unsigned)(255 - (i * 16 + j)); TOPK_INSERT(Fk, key); }
        float fv[16]; const float fmax_ = key2f(Fk[0] & ~255u); float sum = 0.f;
#pragma unroll
        for (int q = 0; q < 16; ++q) { fv[q] = __expf(key2f(Fk[q] & ~255u) - fmax_); sum += fv[q]; }
        const float rs = 1.f / sum;
        int* pi = PIDX + (t0 + lane) * 128 + h * 16; float* pg = PGATE + (t0 + lane) * 128 + h * 16;
#pragma unroll
        for (int q4 = 0; q4 < 4; ++q4) {
            int e[4]; float gg[4];
#pragma unroll
            for (int r = 0; r < 4; ++r) { const int q = q4 * 4 + r; const unsigned code = 255u - (Fk[q] & 255u); const unsigned i = code >> 4, j = code & 15u;
                e[r] = (int)(pick_byte(P0, i) * 128u + pick_byte(P1, j)); gg[r] = fv[q] * rs; }
            *(int4*)(pi + q4 * 4) = make_int4(e[0], e[1], e[2], e[3]); *(f32x4*)(pg + q4 * 4) = (f32x4){gg[0], gg[1], gg[2], gg[3]};
        }
    }
}

__device__ __forceinline__ float dot2bf(unsigned a, unsigned b, float acc) { return __builtin_amdgcn_fdot2_f32_bf16(__builtin_bit_cast(bf16x2_t, a), __builtin_bit_cast(bf16x2_t, b), acc, false); }
__device__ __forceinline__ void ph_gather(Frame& F) {
    const int gw = F.vcu * NWAVES + F.wave, NGW = F.G * NWAVES, lane = F.lane, li = lane & 15, gg = lane >> 4;
    const bf16* H2 = (const bf16*)(F.ws + WS_H); const bf16* UB = (const bf16*)(F.ws + WS_UB); const bf16* VB = (const bf16*)(F.ws + WS_VB);
    const int* PIDX = (const int*)(F.ws + WS_PIDX); const float* PGATE = (const float*)(F.ws + WS_PGATE); const float* modp = (const float*)(F.ws + WS_MOD);
    const float* lng = F.in[24]; const float* lnb = F.in[25];
    LAS int* sidx = (LAS int*)(F.lds + F.wave * 16384); LAS float* sgate = (LAS float*)(F.lds + F.wave * 16384 + 512); LAS float* scoef = (LAS float*)(F.lds + F.wave * 16384 + 1024);
    for (int m = gw; m < M; m += NGW) {
        sidx[lane] = PIDX[(size_t)m * 128 + lane]; sidx[lane + 64] = PIDX[(size_t)m * 128 + 64 + lane];
        sgate[lane] = PGATE[(size_t)m * 128 + lane]; sgate[lane + 64] = PGATE[(size_t)m * 128 + 64 + lane];
        v4u hx[8];
#pragma unroll
        for (int c = 0; c < 8; ++c) hx[c] = *(const v4u*)(H2 + (size_t)m * D + 8 * (li + 16 * c));
        LDS_WAIT(); asm volatile("" ::: "memory");
        for (int r = 0; r < 32; ++r) {
            const int slot = 4 * r + gg; const int e = sidx[slot];
            const bf16* up = UB + (size_t)e * D + 8 * li;
            v4u ux[8];
#pragma unroll
            for (int c = 0; c < 8; ++c) ux[c] = *(const v4u*)(up + 128 * c);
            float a0 = 0.f, a1 = 0.f, a2 = 0.f, a3 = 0.f;
#pragma unroll
            for (int c = 0; c < 8; ++c) { a0 = dot2bf(ux[c].x, hx[c].x, a0); a1 = dot2bf(ux[c].y, hx[c].y, a1); a2 = dot2bf(ux[c].z, hx[c].z, a2); a3 = dot2bf(ux[c].w, hx[c].w, a3); }
            float d = red16((a0 + a1) + (a2 + a3));
            const float act = 0.5f * d * (1.f + erff(d * 0.70710678118654752f));
            if (li == 0) scoef[slot] = act * sgate[slot];
        }
        LDS_WAIT(); asm volatile("" ::: "memory");
        float y[16];
#pragma unroll
        for (int i = 0; i < 16; ++i) y[i] = 0.f;
#pragma unroll 4
        for (int s = 0; s < 128; ++s) {
            const int e = sidx[s]; const float cf = scoef[s];
            const bf16* vp = VB + (size_t)e * D + 8 * lane;
            const v4u va = *(const v4u*)vp, vb = *(const v4u*)(vp + 512);
            y[0] += cf * bflo(va.x); y[1] += cf * bfhi(va.x); y[2] += cf * bflo(va.y); y[3] += cf * bfhi(va.y); y[4] += cf * bflo(va.z); y[5] += cf * bfhi(va.z); y[6] += cf * bflo(va.w); y[7] += cf * bfhi(va.w);
            y[8] += cf * bflo(vb.x); y[9] += cf * bfhi(vb.x); y[10] += cf * bflo(vb.y); y[11] += cf * bfhi(vb.y); y[12] += cf * bflo(vb.z); y[13] += cf * bfhi(vb.z); y[14] += cf * bflo(vb.w); y[15] += cf * bfhi(vb.w);
        }
        const float* md = modp + (m >> 11) * 6144 + 5120; float* orow = F.out + (size_t)m * D;
        float v[16]; float sum = 0.f;
#pragma unroll
        for (int hlf = 0; hlf < 2; ++hlf)
#pragma unroll
            for (int q = 0; q < 2; ++q) { const int col = 512 * hlf + 8 * lane + 4 * q; const f32x4 xv = *(const f32x4*)(orow + col), gt = *(const f32x4*)(md + col);
#pragma unroll
                for (int i = 0; i < 4; ++i) { const float t = xv[i] * ALPHA + gt[i] * y[8 * hlf + 4 * q + i]; v[8 * hlf + 4 * q + i] = t; sum += t; } }
        const float mean = wave_sum(sum) * (1.f / D); float s2 = 0.f;
#pragma unroll
        for (int i = 0; i < 16; ++i) { v[i] -= mean; s2 += v[i] * v[i]; }
        const float rstd = rsqrtf(wave_sum(s2) * (1.f / D) + LN_EPS);
#pragma unroll
        for (int hlf = 0; hlf < 2; ++hlf)
#pragma unroll
            for (int q = 0; q < 2; ++q) { const int col = 512 * hlf + 8 * lane + 4 * q; const f32x4 gv = *(const f32x4*)(lng + col), bv = *(const f32x4*)(lnb + col); f32x4 o;
#pragma unroll
                for (int i = 0; i < 4; ++i) o[i] = (v[8 * hlf + 4 * q + i] * rstd) * gv[i] + bv[i];
                *(f32x4*)(orow + col) = o; }
    }
}

struct Args { const float* in[26]; float* out; unsigned char* ws; int ph_lo, ph_hi, li, pad; };
__global__ void __launch_bounds__(NWAVES * 64, 2) hymba_fwd(Args args) {
    extern __shared__ __attribute__((aligned(16))) unsigned char lds[];
    Frame F;
    F.lds = (LAS unsigned char*)lds;
    F.MISC = (volatile LAS unsigned*)(F.lds + MISC_OFF);
    F.tid = threadIdx.x; F.lane = F.tid & 63; F.wave = __builtin_amdgcn_readfirstlane(F.tid >> 6);
    F.G = gridDim.x; { const int bx = blockIdx.x; F.vcu = (F.G % 8 == 0) ? (bx % 8) * (F.G / 8) + bx / 8 : bx; }
    F.ws = args.ws; F.out = args.out; F.ctl = (gu32*)(args.ws + WS_CTL);
#pragma unroll
    for (int i = 0; i < 26; ++i) F.in[i] = args.in[i];
    for (int u = F.tid; u < (LDS_BYTES - LDSCTL_OFF) / 4; u += NWAVES * 64) ((LAS unsigned*)(F.lds + LDSCTL_OFF))[u] = 0u;
    __syncthreads();
    XcdBarrier bar; bar.bar = (unsigned*)(F.ctl + CW_BAR); bar.x = 0; bar.st = nullptr;
    if (N_LAUNCHES == 1) bar = xcd_barrier_post((unsigned*)(F.ctl + CW_BAR), F.MISC + 8);
#define GRID_BAR() do { if (N_LAUNCHES == 1) xcd_barrier(bar); } while (0)
    const int lo = args.ph_lo, hi = args.ph_hi;
#ifndef PHMASK
#define PHMASK 0x7ff
#endif
#define IN(k) (((PHMASK >> (k)) & 1) && lo <= (k) && (k) < hi)
#define BOTH(k) (IN(k) && IN((k) + 1))
    bf16* WinT = (bf16*)(F.ws + WS_WIN); bf16* WoutT = (bf16*)(F.ws + WS_WOUT); bf16* WpT = (bf16*)(F.ws + WS_WP);
    bf16* HB = (bf16*)(F.ws + WS_H); bf16* PROJ = (bf16*)(F.ws + WS_PROJ); bf16* MIX = (bf16*)(F.ws + WS_MIX); bf16* Y1 = (bf16*)(F.ws + WS_Y1); float* SCp = (float*)(F.ws + WS_SC);

    if (IN(0)) { ph_mod(F); if (BOTH(0)) GRID_BAR(); }
    if (IN(1)) { ph_prologue(F); if (BOTH(1)) GRID_BAR(); }
    if (IN(2)) {
        pg8::Gemm g{HB, WinT, M, IN_COLS, D}; pg8::StaticOrder S; S.init(M, IN_COLS, F.G, (int)blockIdx.x);
        pg8::EpiBf16<0> E{PROJ, IN_COLS, nullptr, 0, 0, 1.f};
        pg8::gemm_phase<pg8::EpiBf16<0>, pg8::StaticOrder, true, true>(F.lds + RING_OFF, g, S, E);
        if (BOTH(2)) GRID_BAR();
    }
    if (IN(3)) {
#ifndef NO_ATTN
        ph_attn(F);
#endif
#ifndef NO_PREP
        ph_prep(F);
#endif
 if (BOTH(3)) GRID_BAR(); }
    if (IN(4)) { ph_scan(F); if (BOTH(4)) GRID_BAR(); }
    if (IN(5)) { ph_post(F); if (BOTH(5)) GRID_BAR(); }
    if (IN(6)) {
        pg8::Gemm g{MIX, WoutT, M, D, D}; pg8::StaticOrder S; S.init(M, D, F.G, (int)blockIdx.x);
        pg8::EpiBf16<0> E{Y1, D, nullptr, 0, 0, 1.f};
        pg8::gemm_phase<pg8::EpiBf16<0>, pg8::StaticOrder, true, true>(F.lds + RING_OFF, g, S, E);
        if (BOTH(6)) GRID_BAR();
    }
    if (IN(7)) { ph_ln1(F); if (BOTH(7)) GRID_BAR(); }
    if (IN(8)) {
        pg8::Gemm g{HB, WpT, M, NSC, D}; pg8::StaticOrder S; S.init(M, NSC, F.G, (int)blockIdx.x);
        pg8::EpiF32 E{SCp, NSC, nullptr};
        pg8::gemm_phase<pg8::EpiF32, pg8::StaticOrder, true, true>(F.lds + RING_OFF, g, S, E);
        if (BOTH(8)) GRID_BAR();
    }
    if (IN(9)) { ph_topk(F); if (BOTH(9)) GRID_BAR(); }
    if (IN(10)) { ph_gather(F); }
#undef IN
#undef BOTH
#undef GRID_BAR
}

extern "C" void kernel_launch(void* const* d_in, const int* in_sizes, int n_in, void* d_out, int out_size, void* d_ws, size_t ws_size, hipStream_t stream) {
    static int grid = 0;
    if (grid == 0) {
        if (n_in != 26 || in_sizes[0] != M * D || out_size != M * D || ws_size < WS_END) { fprintf(stderr, "kernel_launch: unexpected shapes (n_in %d, in0 %d, out %d, ws %zu); nothing launched\n", n_in, n_in > 0 ? in_sizes[0] : -1, out_size, ws_size); grid = -1; return; }
        int dev = 0, cus = 0, per_cu = 0;
        if (hipGetDevice(&dev) != hipSuccess || hipDeviceGetAttribute(&cus, hipDeviceAttributeMultiprocessorCount, dev) != hipSuccess) { fprintf(stderr, "kernel_launch: device query failed\n"); grid = -1; return; }
        if (hipFuncSetAttribute((const void*)hymba_fwd, hipFuncAttributeMaxDynamicSharedMemorySize, LDS_BYTES) != hipSuccess) { fprintf(stderr, "kernel_launch: hipFuncSetAttribute failed\n"); grid = -1; return; }
        if (hipOccupancyMaxActiveBlocksPerMultiprocessor(&per_cu, (const void*)hymba_fwd, NWAVES * 64, LDS_BYTES) != hipSuccess || per_cu < 1)
            fprintf(stderr, "kernel_launch: note: occupancy query reports %d workgroups per CU\n", per_cu);
        (void)hipGetLastError();
        grid = cus;
    }
    if (grid < 0) return;
    if (hipMemsetAsync((char*)d_ws + WS_CTL, 0, CTL_ZERO_BYTES, stream) != hipSuccess) { fprintf(stderr, "kernel_launch: memset failed\n"); return; }
    Args a{};
    for (int i = 0; i < 26; ++i) a.in[i] = (const float*)d_in[i];
    a.out = (float*)d_out; a.ws = (unsigned char*)d_ws;
    for (int li = 0; li < N_LAUNCHES; ++li) {
        a.ph_lo = (N_LAUNCHES == 1) ? 0 : li; a.ph_hi = (N_LAUNCHES == 1) ? N_PHASES : li + 1; a.li = li;
        hipLaunchKernelGGL(hymba_fwd, dim3(grid), dim3(NWAVES * 64), LDS_BYTES, stream, a);
        const hipError_t le = hipPeekAtLastError();
        if (le != hipSuccess) { fprintf(stderr, "kernel_launch: launch %d failed: %s\n", li, hipGetErrorName(le)); break; }
    }
}
```

```cpp
#include <hip/hip_runtime.h>
#ifndef DBLMASK
#define DBLMASK 0
#endif
#include <cstdio>
#include <cstdint>
#include <cmath>
namespace pg8 {
#define PG8_LAS __attribute__((address_space(3)))
typedef unsigned short bf16_t;
typedef short bf16x8 __attribute__((ext_vector_type(8)));
typedef float f32x4 __attribute__((ext_vector_type(4)));
typedef unsigned u32x4 __attribute__((ext_vector_type(4)));
constexpr int BM = 256, BK = 64, HALF = 128, HTB = HALF * BK * 2  , STAGE_BYTES = 8 * HTB, NXCD = 8, WGM = 8;

__host__ __device__ __forceinline__ int lds_byte(int r, int c) { const int st = (r >> 4) * 2 + (c >> 5), rr = r & 15, cc = c & 31, ob = rr * 64 + cc * 2; return st * 1024 + (ob ^ (((ob >> 9) & 1) << 5)); }
__host__ __device__ __forceinline__ void stage_rc(int b, int& R, int& C) { const int st = b / 1024, sb = b % 1024, swz = sb ^ (((sb >> 9) & 1) << 5); R = (st >> 1) * 16 + swz / 64; C = (st & 1) * 32 + (swz % 64) / 2; }
__host__ __device__ __forceinline__ int perm32(int rho) { const int n = rho >> 4, i = rho & 15; return 8 * (i >> 2) + 4 * n + (i & 3); }

struct Unit { int pm, pn; };
struct Gemm { const bf16_t* A; const bf16_t* Bt; int M, N, K; };

struct StaticOrder {
    int nM, nN, nwg, G, c;
    __host__ __device__ void init(int M, int N, int G_, int c_) { nM = M / BM; nN = N / BM; nwg = nM * nN; G = G_; c = c_; }
    __host__ __device__ bool next(int i, Unit& u) const {
        const long L = (long)i * G + c; if (L >= nwg) return false;
        int wgid = (int)L; { const int q = nwg / NXCD, r = nwg % NXCD, xcd = wgid % NXCD, off = wgid / NXCD; wgid = (xcd < r ? xcd * (q + 1) : r * (q + 1) + (xcd - r) * q) + off; }
        const int nig = WGM * nN, gid = wgid / nig, fm = gid * WGM, gsz = (nM - fm) < WGM ? (nM - fm) : WGM;
        u.pm = fm + ((wgid % nig) % gsz); u.pn = (wgid % nig) / gsz; return true;
    }
    __device__ __forceinline__ void a_ready(const Unit&) const {}
    __device__ __forceinline__ void done(const Unit&) const {}
};

__device__ __forceinline__ unsigned cvt_pk_bf16(float lo, float hi) { unsigned r; asm volatile("v_cvt_pk_bf16_f32 %0, %1, %2" : "=v"(r) : "v"(lo), "v"(hi)); return r; }
typedef float f32x2 __attribute__((ext_vector_type(2)));
__device__ __forceinline__ f32x2 gelu_pk(f32x2 v) {
    const f32x2 av = __builtin_elementwise_abs(v), d = av * 0.2316418882f + 1.0f;
    f32x2 t; t.x = __builtin_amdgcn_rcpf(d.x); t.y = __builtin_amdgcn_rcpf(d.y);
    f32x2 q = t * 0.5307027145f + (-0.7265760135f); q = q * t + 0.7107068705f; q = q * t + (-0.142248368f); q = q * t + 0.127414796f; q = q * t;
    const f32x2 s = (v * v) * (-0.72134752044f);
    f32x2 e; e.x = __builtin_amdgcn_exp2f(s.x); e.y = __builtin_amdgcn_exp2f(s.y);
    const f32x2 m = v * (q * e), r = v - m;
    f32x2 o; o.x = v.x < 0.f ? m.x : r.x; o.y = v.y < 0.f ? m.y : r.y; return o;
}

template <int ACT  > struct EpiBf16 {
    static constexpr bool PERM = true, AFTER_DRAIN = false; static_assert(ACT == 0 || ACT == 1, "EpiBf16: ACT is 0 (none) or 1 (gelu_pk)");
    bf16_t* O; int ldc; const float* bias; int split_cols; size_t split_stride; float scale0;
    __device__ __forceinline__ void operator()(const f32x4 (&acc)[2][2][4][2], const Unit& u, int wr, int wc, int fr, int fq) const {
        const int row0 = u.pm * BM + wr * 64 + fr; int colt = u.pn * BM; bf16_t* base = O;
        float sc = 1.f; if (split_cols) { const int t = colt / split_cols; base += (size_t)t * split_stride; colt -= t * split_cols; if (t == 0) sc = scale0; }
        const int col0 = colt + wc * 32 + 8 * fq, bcol0 = u.pn * BM + wc * 32 + 8 * fq;
        f32x4 bv[2][2];
#pragma unroll
        for (int bj = 0; bj < 2; ++bj)
#pragma unroll
            for (int n = 0; n < 2; ++n) bv[bj][n] = bias ? *(const f32x4*)(bias + bcol0 + bj * HALF + 4 * n) : (f32x4){0.f, 0.f, 0.f, 0.f};
#pragma unroll
        for (int ai = 0; ai < 2; ++ai)
#pragma unroll
            for (int m = 0; m < 4; ++m) { bf16_t* rowp = base + (size_t)(row0 + ai * HALF + m * 16) * ldc + col0;
#pragma unroll
                for (int bj = 0; bj < 2; ++bj) { f32x4 v0 = acc[ai][bj][m][0] + bv[bj][0], v1 = acc[ai][bj][m][1] + bv[bj][1];
                    if (ACT == 1) { f32x2 a = gelu_pk((f32x2){v0[0], v0[1]}), b = gelu_pk((f32x2){v0[2], v0[3]}), c = gelu_pk((f32x2){v1[0], v1[1]}), d = gelu_pk((f32x2){v1[2], v1[3]});
                        v0 = (f32x4){a.x, a.y, b.x, b.y}; v1 = (f32x4){c.x, c.y, d.x, d.y}; }
                    v0 = v0 * sc; v1 = v1 * sc; u32x4 w; w.x = cvt_pk_bf16(v0[0], v0[1]); w.y = cvt_pk_bf16(v0[2], v0[3]); w.z = cvt_pk_bf16(v1[0], v1[1]); w.w = cvt_pk_bf16(v1[2], v1[3]);
                    *(u32x4*)(rowp + bj * HALF) = w; } }
    }
};
struct EpiF32 {
    static constexpr bool PERM = false, AFTER_DRAIN = false;
    float* C; int ldc; const float* bias;
    __device__ __forceinline__ void operator()(const f32x4 (&acc)[2][2][4][2], const Unit& u, int wr, int wc, int fr, int fq) const {
        const int row0 = u.pm * BM + wr * 64 + fr, col0 = u.pn * BM + wc * 32 + 4 * fq;
        f32x4 bv[2][2];
#pragma unroll
        for (int bj = 0; bj < 2; ++bj)
#pragma unroll
            for (int n = 0; n < 2; ++n) bv[bj][n] = bias ? *(const f32x4*)(bias + col0 + bj * HALF + n * 16) : (f32x4){0.f, 0.f, 0.f, 0.f};
#pragma unroll
        for (int ai = 0; ai < 2; ++ai)
#pragma unroll
            for (int m = 0; m < 4; ++m) { float* rowp = C + (size_t)(row0 + ai * HALF + m * 16) * ldc + col0;
#pragma unroll
                for (int bj = 0; bj < 2; ++bj)
#pragma unroll
                    for (int n = 0; n < 2; ++n) *(f32x4*)(rowp + bj * HALF + n * 16) = acc[ai][bj][m][n] + bv[bj][n]; }
    }
};
template <class Epi, class Sched, bool ALIGN_EPI = false, bool SP2 = false>
__device__ __forceinline__ void gemm_phase(PG8_LAS unsigned char* lds, const Gemm g, const Sched& S, const Epi& E) {
    const int tid = threadIdx.x, wid = __builtin_amdgcn_readfirstlane(tid >> 6), lane = tid & 63, wr = wid >> 2, wc = wid & 3, fr = lane & 15, fq = lane >> 4;
    const int K = g.K, nt = K / BK;
    unsigned voffA[2], voffB[2];
#pragma unroll
    for (int i = 0; i < 2; ++i) { int R, C; stage_rc(tid * 16 + i * 8192, R, C); const int Rb = Epi::PERM ? ((R & ~31) + perm32(R & 31)) : R;
        voffA[i] = (unsigned)(R * K + C) * 2u; voffB[i] = (unsigned)(Rb * K + C) * 2u; }
    const size_t kstep = (size_t)(BK * 2);
    const size_t hstep = (size_t)HALF * K * 2;
    const size_t tstep = 2 * hstep;
    const unsigned ldsw = (unsigned)wid * 1024u;
    const int aoff = lds_byte(wr * 64 + fr, fq * 8), boff = lds_byte(wc * 32 + fr, fq * 8);
#define PG8_SA(b, h) (((b) * 2 + (h)) * HTB)
#define PG8_SB(b, h) ((4 + (b) * 2 + (h)) * HTB)
#define PG8_STAGE(bufoff, gbase, voff) do { _Pragma("unroll") for (int _i = 0; _i < 2; ++_i) \
        __builtin_amdgcn_global_load_lds((const unsigned*)((const char*)(gbase) + (voff)[_i]), (PG8_LAS unsigned*)(lds + (bufoff) + ldsw + _i * 8192), 16, 0, 0); } while (0)
#define PG8_LDA(dst, b, h) do { _Pragma("unroll") for (int m = 0; m < 4; ++m) _Pragma("unroll") for (int k = 0; k < 2; ++k) dst[m][k] = *(const PG8_LAS bf16x8*)(lds + PG8_SA(b, h) + aoff + m * 2048 + k * 1024); } while (0)
#define PG8_LDB(dst, b, h) do { _Pragma("unroll") for (int n = 0; n < 2; ++n) _Pragma("unroll") for (int k = 0; k < 2; ++k) dst[n][k] = *(const PG8_LAS bf16x8*)(lds + PG8_SB(b, h) + boff + n * 2048 + k * 1024); } while (0)
#define PG8_MMA(ai, bj, At, Bt) do { __builtin_amdgcn_s_setprio(1); _Pragma("unroll") for (int m = 0; m < 4; ++m) _Pragma("unroll") for (int n = 0; n < 2; ++n) _Pragma("unroll") for (int k = 0; k < 2; ++k) \
        acc[ai][bj][m][n] = __builtin_amdgcn_mfma_f32_16x16x32_bf16(Bt[n][k], At[m][k], acc[ai][bj][m][n], 0, 0, 0); __builtin_amdgcn_s_setprio(0); } while (0)
#define PG8_WAIT_V(n) asm volatile("s_waitcnt vmcnt(" #n ")" ::: "memory")
#define PG8_WAIT_L(n) asm volatile("s_waitcnt lgkmcnt(" #n ")" ::: "memory")
#define PG8_BAR __builtin_amdgcn_s_barrier()
#define PG8_SCHED __builtin_amdgcn_sched_barrier(0)
    Unit cur, nxt; int ui = 0;
    if (!S.next(0, cur)) return;
    f32x4 acc[2][2][4][2];
#pragma unroll
    for (int a = 0; a < 2; ++a)
#pragma unroll
        for (int b = 0; b < 2; ++b)
#pragma unroll
            for (int m = 0; m < 4; ++m)
#pragma unroll
                for (int n = 0; n < 2; ++n) acc[a][b][m][n] = (f32x4){0.f, 0.f, 0.f, 0.f};
    bf16x8 At[4][2], B0[2][2], B1[2][2];
    const char* cA = (const char*)g.A + (size_t)cur.pm * tstep; const char* cB = (const char*)g.Bt + (size_t)cur.pn * tstep;
    S.a_ready(cur);
    if constexpr (SP2) {
        PG8_STAGE(PG8_SB(0, 0), cB, voffB); PG8_STAGE(PG8_SB(0, 1), cB + hstep, voffB); PG8_STAGE(PG8_SA(0, 0), cA, voffA); PG8_STAGE(PG8_SA(0, 1), cA + hstep, voffA);
        if (wr == 1) PG8_BAR;
        PG8_WAIT_V(2); PG8_BAR;
        PG8_STAGE(PG8_SB(1, 0), cB + kstep, voffB); PG8_STAGE(PG8_SA(1, 0), cA + kstep, voffA); PG8_STAGE(PG8_SB(1, 1), cB + hstep + kstep, voffB);
        PG8_WAIT_V(6); PG8_BAR;
    } else {
        PG8_STAGE(PG8_SB(0, 0), cB, voffB); PG8_STAGE(PG8_SA(0, 0), cA, voffA); PG8_STAGE(PG8_SB(0, 1), cB + hstep, voffB); PG8_STAGE(PG8_SA(0, 1), cA + hstep, voffA);
        if (wr == 1) PG8_BAR;
        PG8_WAIT_V(4); PG8_BAR;
        PG8_STAGE(PG8_SB(1, 0), cB + kstep, voffB); PG8_STAGE(PG8_SA(1, 0), cA + kstep, voffA); PG8_STAGE(PG8_SB(1, 1), cB + hstep + kstep, voffB);
        PG8_WAIT_V(6); PG8_BAR;
    }
    for (;;) {
        const bool has_next = S.next(ui + 1, nxt);
        const char* nA = has_next ? (const char*)g.A + (size_t)nxt.pm * tstep : cA; const char* nB = has_next ? (const char*)g.Bt + (size_t)nxt.pn * tstep : cB;
        for (int t = 0; t < nt; t += 2) {
            const bool last = (t == nt - 2);
            const char* a1 = cA + (size_t)(t + 1) * kstep;
            const char* a2 = last ? nA : cA + (size_t)(t + 2) * kstep; const char* b2 = last ? nB : cB + (size_t)(t + 2) * kstep;
            const char* a3 = a2 + kstep; const char* b3 = b2 + kstep;
            if (last && has_next) S.a_ready(nxt);
            if constexpr (SP2) {
            PG8_LDB(B0, 0, 0); PG8_LDB(B1, 0, 1); PG8_SCHED; PG8_LDA(At, 0, 0); PG8_STAGE(PG8_SA(1, 1), a1 + hstep, voffA);
            PG8_WAIT_V(8); PG8_WAIT_L(0); PG8_BAR; PG8_MMA(0, 0, At, B0); PG8_MMA(0, 1, At, B1); PG8_BAR; PG8_SCHED;
            PG8_LDA(At, 0, 1); PG8_STAGE(PG8_SB(0, 0), b2, voffB); PG8_STAGE(PG8_SB(0, 1), b2 + hstep, voffB); PG8_STAGE(PG8_SA(0, 0), a2, voffA);
            PG8_WAIT_V(8); PG8_WAIT_L(0); PG8_BAR; PG8_MMA(1, 0, At, B0); PG8_MMA(1, 1, At, B1); PG8_BAR; PG8_SCHED;
            PG8_LDB(B0, 1, 0); PG8_LDB(B1, 1, 1); PG8_SCHED; PG8_LDA(At, 1, 0); PG8_STAGE(PG8_SA(0, 1), a2 + hstep, voffA);
            PG8_WAIT_V(8); PG8_WAIT_L(0); PG8_BAR; PG8_MMA(0, 0, At, B0); PG8_MMA(0, 1, At, B1); PG8_BAR; PG8_SCHED;
            PG8_LDA(At, 1, 1); PG8_STAGE(PG8_SB(1, 0), b3, voffB); PG8_STAGE(PG8_SB(1, 1), b3 + hstep, voffB); PG8_STAGE(PG8_SA(1, 0), a3, voffA);
            PG8_WAIT_V(8); PG8_WAIT_L(0); PG8_BAR; PG8_MMA(1, 0, At, B0); PG8_MMA(1, 1, At, B1); PG8_BAR; PG8_SCHED;
            } else {
            PG8_LDB(B0, 0, 0); PG8_SCHED; PG8_LDA(At, 0, 0); PG8_STAGE(PG8_SA(1, 1), a1 + hstep, voffA);
            PG8_WAIT_L(8); PG8_BAR; PG8_WAIT_L(0); PG8_MMA(0, 0, At, B0); PG8_BAR; PG8_SCHED;
            PG8_LDB(B1, 0, 1); PG8_STAGE(PG8_SB(0, 0), b2, voffB);
            PG8_BAR; PG8_WAIT_L(0); PG8_MMA(0, 1, At, B1); PG8_BAR;
            PG8_LDA(At, 0, 1); PG8_STAGE(PG8_SA(0, 0), a2, voffA);
            PG8_BAR; PG8_WAIT_L(0); PG8_MMA(1, 0, At, B0); PG8_BAR; PG8_SCHED;
            PG8_STAGE(PG8_SB(0, 1), b2 + hstep, voffB);
            PG8_WAIT_V(6); PG8_BAR; PG8_MMA(1, 1, At, B1); PG8_BAR;
            PG8_LDB(B0, 1, 0); PG8_SCHED; PG8_LDA(At, 1, 0); PG8_STAGE(PG8_SA(0, 1), a2 + hstep, voffA);
            PG8_WAIT_L(8); PG8_BAR; PG8_WAIT_L(0); PG8_MMA(0, 0, At, B0); PG8_BAR; PG8_SCHED;
            PG8_LDB(B1, 1, 1); PG8_STAGE(PG8_SB(1, 0), b3, voffB);
            PG8_BAR; PG8_WAIT_L(0); PG8_MMA(0, 1, At, B1); PG8_BAR;
            PG8_LDA(At, 1, 1); PG8_STAGE(PG8_SA(1, 0), a3, voffA);
            PG8_BAR; PG8_WAIT_L(0); PG8_MMA(1, 0, At, B0); PG8_BAR; PG8_SCHED;
            PG8_STAGE(PG8_SB(1, 1), b3 + hstep, voffB);
            PG8_WAIT_V(6); PG8_BAR; PG8_MMA(1, 1, At, B1); PG8_BAR;
            }
        }
        if constexpr (ALIGN_EPI) { if (wr == 0) PG8_BAR; }
        if constexpr (!Epi::AFTER_DRAIN) { E(acc, cur, wr, wc, fr, fq); S.done(cur); }
        if (!has_next) break;
#pragma unroll
        for (int a = 0; a < 2; ++a)
#pragma unroll
            for (int b = 0; b < 2; ++b)
#pragma unroll
                for (int m = 0; m < 4; ++m)
#pragma unroll
                    for (int n = 0; n < 2; ++n) acc[a][b][m][n] = (f32x4){0.f, 0.f, 0.f, 0.f};
        cur = nxt; cA = nA; cB = nB; ++ui;
        if constexpr (ALIGN_EPI) { if (wr == 1) PG8_BAR; }
    }
    PG8_WAIT_V(0);
    if constexpr (!ALIGN_EPI) { if (wr == 0) PG8_BAR; }
    PG8_BAR;
    if constexpr (Epi::AFTER_DRAIN) { E.fused(acc, cur, wr, wc, fr, fq, lds, wid, lane); S.done(cur); }
#undef PG8_SA
#undef PG8_SB
#undef PG8_STAGE
#undef PG8_LDA
#undef PG8_LDB
#undef PG8_MMA
#undef PG8_WAIT_V
#undef PG8_WAIT_L
#undef PG8_BAR
#undef PG8_SCHED
}
}

#ifndef PG8_SP2
#define PG8_SP2 true
#endif

constexpr int NWAVES = 8;
#ifndef MK_N_LAUNCHES
#define MK_N_LAUNCHES 1
#endif
constexpr int N_PHASES = 13;
constexpr int N_LAUNCHES = MK_N_LAUNCHES;

constexpr int BATCH = 16, SEQ = 2048, D = 1024, M = BATCH * SEQ;
constexpr int IN_COLS = 2560;
constexpr int C_Q = 0, C_K = 512, C_V = 640, C_RW = 768;
constexpr int RW_R = 0, RW_K = 512, RW_V = 1024, RW_WD = 1536, RW_AD = 1600, RW_GD = 1664;
constexpr int NSC = 2048;
constexpr float LN_EPS = 1e-5f, GN_EPS = 64e-5f;
constexpr float ALPHA = 1.189207115002721f;

constexpr size_t MiB = 1u << 20;
constexpr size_t WS_CTL = 0, CTL_ZERO_BYTES = 1 * MiB;
constexpr size_t WS_WIN = 1 * MiB;
constexpr size_t WS_WOUT = 6 * MiB;
constexpr size_t WS_WP = 8 * MiB;
constexpr size_t WS_MOD = 12 * MiB;
constexpr size_t WS_FRAG = 13 * MiB;
constexpr size_t WS_H = 16 * MiB;
constexpr size_t WS_PROJ = 80 * MiB;
constexpr size_t WS_YB = 16 * MiB;
constexpr size_t WS_G = 48 * MiB;
constexpr size_t WS_DOTRK = 14 * MiB;
constexpr size_t WS_REC = 240 * MiB;
constexpr size_t WS_Y1 = 336 * MiB;
constexpr size_t WS_U8 = 448 * MiB;
constexpr size_t WS_V8 = 464 * MiB;
constexpr size_t WS_H8 = 240 * MiB;
constexpr size_t WS_US = 13 * MiB + 512 * 1024, WS_VS = WS_US + 65536, WS_HS = WS_US + 262144;
constexpr size_t WS_COEF = 304 * MiB;
constexpr size_t WS_YS = 80 * MiB;
constexpr size_t WS_SC = 80 * MiB;
constexpr size_t WS_PIDX = 272 * MiB;
constexpr size_t WS_PGATE = 288 * MiB;
constexpr size_t WS_END = 512 * MiB;

constexpr int CW_TMO = 0, CW_CODE = 1;
constexpr int CW_BAR = 4096;

constexpr int RING_OFF = 0, RING_BYTES = 131072;
constexpr int LDSCTL_OFF = RING_BYTES, MISC_OFF = LDSCTL_OFF + 320;
constexpr int LDS_BYTES = 147456;
#define GAS __attribute__((address_space(1)))
#define LAS __attribute__((address_space(3)))
typedef unsigned short bf16;
typedef unsigned v4u __attribute__((ext_vector_type(4)));
typedef float f32x4 __attribute__((ext_vector_type(4)));
typedef short bf16x8 __attribute__((ext_vector_type(8)));
typedef GAS unsigned gu32;
typedef GAS unsigned long long gu64;
#define RLX_AGENT __ATOMIC_RELAXED, __HIP_MEMORY_SCOPE_AGENT
#define LDS_WAIT() asm volatile("s_waitcnt lgkmcnt(0)" ::: "memory")
#define VM_WAIT() asm volatile("s_waitcnt vmcnt(0)" ::: "memory")
__device__ __forceinline__ unsigned long long rt() { return __builtin_amdgcn_s_memrealtime(); }
typedef float f32x2_t_ __attribute__((ext_vector_type(2))); typedef __bf16 bf16x2_t_ __attribute__((ext_vector_type(2)));
__device__ __forceinline__ unsigned f2bf(float f) { return (unsigned)__builtin_bit_cast(unsigned short, (__bf16)f); }
__device__ __forceinline__ unsigned pk2(float lo, float hi) { const f32x2_t_ v = {lo, hi}; return __builtin_bit_cast(unsigned, __builtin_convertvector(v, bf16x2_t_)); }

#define XB_TMO      128
#define XB_XCNT(j)  (256  + 64 * (j))
#define XB_XSUB(j)  (1280 + 64 * (j))
#define XB_XGEN(j)  (2304 + 64 * (j))
#define XB_TOP      3328
#define XB_TOPGEN   3392
#define XCD_BAR_WORDS 3456
#define XB_SPIN_CAP (1u << 18)

__device__ __forceinline__ unsigned xb_ld(unsigned* p)              { return __hip_atomic_load(p, __ATOMIC_RELAXED, __HIP_MEMORY_SCOPE_AGENT); }
__device__ __forceinline__ unsigned xb_add(unsigned* p, unsigned v) { return __hip_atomic_fetch_add(p, v, __ATOMIC_RELAXED, __HIP_MEMORY_SCOPE_AGENT); }
__device__ __forceinline__ unsigned xb_xcc_id() { return (unsigned)__builtin_amdgcn_s_getreg((3 << 11) | 20) & 0xFu; }
#define XB_SPIN(cond, bar) do { unsigned _sp = 0; while (cond) { __builtin_amdgcn_s_sleep(1); \
    if ((++_sp & 255u) == 0u) { if (xb_ld(&(bar)[XB_TMO])) break; if (_sp > XB_SPIN_CAP) { atomicAdd(&(bar)[XB_TMO], 1u); break; } } } } while (0)

struct XcdBarrier {
    unsigned* bar; unsigned x;
    volatile LAS unsigned* st;
};

__device__ __forceinline__ XcdBarrier xcd_barrier_post(unsigned* bar, volatile LAS unsigned* st) {
    XcdBarrier b; b.bar = bar; b.x = xb_xcc_id(); b.st = st;
    if (threadIdx.x == 0) (void)xb_add(&bar[XB_XCNT(b.x)], 1u);
    return b;
}
__device__ __forceinline__ void xcd_barrier_complete(unsigned* bar, unsigned x, unsigned& nloc, unsigned& nx) {
    const unsigned G = gridDim.x * gridDim.y * gridDim.z;
    unsigned sum, cnt, mine, sp = 0u;
    for (;;) {
        sum = 0u; cnt = 0u; mine = 0u;
#pragma unroll
        for (unsigned j = 0; j < 16; ++j) { const unsigned c = xb_ld(&bar[XB_XCNT(j)]); sum += c; cnt += (c > 0u) ? 1u : 0u; mine = (j == x) ? c : mine; }
        if (sum == G) break;
        __builtin_amdgcn_s_sleep(1);
        if ((++sp & 255u) == 0u) { if (xb_ld(&bar[XB_TMO])) break; if (sp > XB_SPIN_CAP) { atomicAdd(&bar[XB_TMO], 1u); break; } }
    }
    nloc = mine > 0u ? mine : 1u; nx = cnt > 0u ? cnt : 1u;
}

__device__ __forceinline__ void xcd_barrier(const XcdBarrier& b) {
    asm volatile("s_waitcnt vmcnt(0)" ::: "memory");
    __syncthreads();
    if (threadIdx.x == 0) {
        unsigned* bar = b.bar;
        __builtin_amdgcn_s_waitcnt(0);
        unsigned nloc = b.st[0], nx = b.st[1];
        if (nloc == 0u) { xcd_barrier_complete(bar, b.x, nloc, nx); b.st[0] = nloc; b.st[1] = nx; }
        const unsigned old = xb_add(&bar[XB_XSUB(b.x)], 1u);
        const unsigned gen = old / nloc;
        if (old + 1u == (gen + 1u) * nloc) {
            __builtin_amdgcn_fence(__ATOMIC_RELEASE, "agent");
            asm volatile("s_waitcnt vmcnt(0)" ::: "memory");
            const unsigned og = xb_add(&bar[XB_TOP], 1u);
            const unsigned tg = og / nx;
            if (og + 1u == (tg + 1u) * nx) xb_add(&bar[XB_TOPGEN], 1u);
            else XB_SPIN(xb_ld(&bar[XB_TOPGEN]) == tg, bar);
            __builtin_amdgcn_fence(__ATOMIC_ACQUIRE, "agent");
            xb_add(&bar[XB_XGEN(b.x)], 1u);
            asm volatile("s_waitcnt vmcnt(0)" ::: "memory");
        } else {
            XB_SPIN(xb_ld(&bar[XB_XGEN(b.x)]) == gen, bar);
            __builtin_amdgcn_fence(__ATOMIC_ACQUIRE, "agent");
            asm volatile("s_waitcnt vmcnt(0)" ::: "memory");
        }
    }
    __syncthreads();
}

typedef unsigned v2u __attribute__((ext_vector_type(2)));
typedef short s16x4 __attribute__((ext_vector_type(4)));
typedef __bf16 bf16x2_t __attribute__((ext_vector_type(2)));
struct Frame {
    LAS unsigned char* lds;
    volatile LAS unsigned* MISC;
    gu32* ctl;
    int tid, lane, wave;
    int vcu, G;
    const float* in[26]; float* out; unsigned char* ws;
};
__device__ __forceinline__ float bflo(unsigned u) { return __uint_as_float(u << 16); }
__device__ __forceinline__ float bfhi(unsigned u) { return __uint_as_float(u & 0xffff0000u); }
__device__ __forceinline__ float wave_sum(float v) {
#pragma unroll
    for (int o = 1; o < 64; o <<= 1) v += __shfl_xor(v, o);
    return v;
}
__device__ __forceinline__ float dpp_f(float x, const int ctrl_sel) {
    const int xi = __float_as_int(x); int r;
    if (ctrl_sel == 0) r = __builtin_amdgcn_update_dpp(0, xi, 0xB1, 0xf, 0xf, true);
    else if (ctrl_sel == 1) r = __builtin_amdgcn_update_dpp(0, xi, 0x4E, 0xf, 0xf, true);
    else if (ctrl_sel == 2) r = __builtin_amdgcn_update_dpp(0, xi, 0x141, 0xf, 0xf, true);
    else r = __builtin_amdgcn_update_dpp(0, xi, 0x140, 0xf, 0xf, true);
    return __int_as_float(r);
}
__device__ __forceinline__ float red8(float x) { x += dpp_f(x, 0); x += dpp_f(x, 1); x += dpp_f(x, 2); return x; }
__device__ __forceinline__ float red16(float x) { x += dpp_f(x, 0); x += dpp_f(x, 1); x += dpp_f(x, 2); x += dpp_f(x, 3); return x; }

__device__ __forceinline__ void ph_mod(Frame& F) {
    const float* c = F.in[1]; const float* W = F.in[2]; const float* bias = F.in[3];
    float* mod = (float*)(F.ws + WS_MOD);
    LAS float* scr = (LAS float*)(F.lds + F.wave * 16384);
    for (int it = blockIdx.x; it < 96; it += F.G) {
        const int col = it * 64 + F.lane, k0 = F.wave * 128;
        for (int i = F.lane; i < 2048; i += 64) { const int b = i >> 7, k = i & 127; const float v = c[b * 1024 + k0 + k]; scr[i] = v / (1.f + __expf(-v)); }
        LDS_WAIT();
        float acc[16];
#pragma unroll
        for (int b = 0; b < 16; ++b) acc[b] = 0.f;
        for (int k = 0; k < 128; k += 16) {
            const float* wp = W + (size_t)(k0 + k) * 6144 + col;
            float wv[16];
#pragma unroll
            for (int q = 0; q < 16; ++q) wv[q] = wp[(size_t)q * 6144];
#pragma unroll
            for (int q4_ = 0; q4_ < 4; ++q4_)
#pragma unroll
                for (int b = 0; b < 16; ++b) { const f32x4 cs = *(const LAS f32x4*)(scr + b * 128 + k + 4 * q4_); acc[b] += (cs.x * wv[4 * q4_] + cs.y * wv[4 * q4_ + 1]) + (cs.z * wv[4 * q4_ + 2] + cs.w * wv[4 * q4_ + 3]); }
        }
#pragma unroll
        for (int b = 0; b < 16; ++b) scr[2048 + b * 64 + F.lane] = acc[b];
        __syncthreads();
        for (int o = F.tid; o < 1024; o += 512) {
            const int b = o >> 6, cc = o & 63; float s = bias[it * 64 + cc];
#pragma unroll
            for (int w = 0; w < 8; ++w) s += ((const LAS float*)(F.lds + w * 16384))[2048 + b * 64 + cc];
            mod[b * 6144 + it * 64 + cc] = s;
        }
        __syncthreads();
    }
}

__device__ __forceinline__ void p0_transpose_item(const float* W, int K, int N, bf16* WT, int row_off, LAS float* scr, int item, int lane) {
    const int nblk = N / 32, kb = item / nblk, nb = item % nblk, k0 = 64 * kb, n0 = 32 * nb;
#pragma unroll 8
    for (int i = 0; i < 32; ++i) { const int kk = 2 * i + (lane >> 5); scr[kk * 33 + (lane & 31)] = W[(size_t)(k0 + kk) * N + n0 + (lane & 31)]; }
    LDS_WAIT(); asm volatile("" ::: "memory");
    const int c = lane & 7;
#pragma unroll
    for (int j = 0; j < 4; ++j) { const int n = (lane >> 3) + 8 * j; const LAS float* s = scr + (8 * c) * 33 + n;
        v4u o; o.x = pk2(s[0 * 33], s[1 * 33]); o.y = pk2(s[2 * 33], s[3 * 33]); o.z = pk2(s[4 * 33], s[5 * 33]); o.w = pk2(s[6 * 33], s[7 * 33]);
        *(GAS v4u*)(WT + (size_t)(row_off + n0 + n) * K + k0 + 8 * c) = o; }
    LDS_WAIT(); asm volatile("" ::: "memory");
}
__device__ __forceinline__ void p0_wp_item(const float* wq, const float* sk, bf16* WpT, LAS float* scr, int item, int lane) {
    const int nq = item & 3, kb = (item >> 2) & 15, hc = item >> 6;
    const int k = kb * 64 + lane, n0 = nq * 32;
    const float* skb = sk + (size_t)(hc * 128 + n0) * 128;
    for (int i = lane; i < 1024; i += 64) ((LAS f32x4*)scr)[i] = ((const f32x4*)skb)[i];
    LDS_WAIT(); asm volatile("" ::: "memory");
    float acc[32];
#pragma unroll
    for (int n = 0; n < 32; ++n) acc[n] = 0.f;
    const float* wrow = wq + (size_t)k * 2048 + hc * 128;
    for (int d4 = 0; d4 < 32; ++d4) {
        const f32x4 w = *(const f32x4*)(wrow + 4 * d4);
#pragma unroll
        for (int n = 0; n < 32; ++n) { const f32x4 s = *(const LAS f32x4*)(scr + n * 128 + 4 * d4); acc[n] += (w.x * s.x + w.y * s.y) + (w.z * s.z + w.w * s.w); }
    }
#pragma unroll
    for (int n = 0; n < 32; ++n) WpT[(size_t)(hc * 128 + n0 + n) * 1024 + k] = (bf16)f2bf(acc[n]);
    LDS_WAIT(); asm volatile("" ::: "memory");
}
__device__ __forceinline__ void ph_prologue(Frame& F) {
    LAS float* scr = (LAS float*)(F.lds + F.wave * 16384);
    const int gw = F.vcu * NWAVES + F.wave, NGW = F.G * NWAVES;
    constexpr int I_WP = 16 * 16 * 4, I_IN = (D / 64) * (IN_COLS / 32), I_OUT = (D / 64) * (D / 32);
    constexpr int NITEMS = I_WP + I_IN + I_OUT;
    bf16* WinT = (bf16*)(F.ws + WS_WIN); bf16* WoutT = (bf16*)(F.ws + WS_WOUT); bf16* WpT = (bf16*)(F.ws + WS_WP);
    for (int it = gw; it < NITEMS; it += NGW) {
        int r = it;
        if (r < I_WP) { p0_wp_item(F.in[20], F.in[21], WpT, scr, r, F.lane); continue; } r -= I_WP;
        if (r < I_IN) { p0_transpose_item(F.in[4], D, IN_COLS, WinT, 0, scr, r, F.lane); continue; } r -= I_IN;
        p0_transpose_item(F.in[17], D, D, WoutT, 0, scr, r, F.lane);
    }
    for (int it = gw; it < 256; it += NGW) {
        const float* W; int rel, KS;
        if (it < 64) { W = F.in[8]; rel = it; KS = 2; } else if (it < 128) { W = F.in[10]; rel = it - 64; KS = 2; } else { W = F.in[11]; rel = it - 128; KS = 4; }
        const int nb = rel & 3, ks = (rel >> 2) % KS, head = (rel >> 2) / KS, tq = F.lane & 15, g = F.lane >> 4;
        float wv[8];
#pragma unroll
        for (int j = 0; j < 8; ++j) wv[j] = W[(size_t)(32 * ks + 8 * g + j) * 512 + head * 64 + nb * 16 + tq];
        v4u o; o.x = pk2(wv[0], wv[1]); o.y = pk2(wv[2], wv[3]); o.z = pk2(wv[4], wv[5]); o.w = pk2(wv[6], wv[7]);
        *(v4u*)(F.ws + WS_FRAG + ((size_t)it * 64 + F.lane) * 16) = o;
    }
    const float* modp = (const float*)(F.ws + WS_MOD);
    const int rpw = M / NGW, m_begin = gw * rpw, m_end = m_begin + rpw;
    const float* md = modp + (m_begin >> 11) * 6144;
    f32x4 sh[4], sc[4];
#pragma unroll
    for (int j = 0; j < 4; ++j) { const int col = 4 * F.lane + 256 * j; sh[j] = *(const f32x4*)(md + col); sc[j] = *(const f32x4*)(md + 1024 + col) + 1.0f; }
    f32x4 xn[4];
#define MOD_LOAD(m_) do { const float* x_ = F.in[0] + (size_t)(m_) * D; _Pragma("unroll") for (int j = 0; j < 4; ++j) xn[j] = *(const f32x4*)(x_ + 4 * F.lane + 256 * j); } while (0)
    MOD_LOAD(m_begin);
    for (int m = m_begin; m < m_end; ++m) {
        f32x4 xv[4];
#pragma unroll
        for (int j = 0; j < 4; ++j) xv[j] = xn[j];
        if (m + 1 < m_end) MOD_LOAD(m + 1);
        bf16* h = (bf16*)(F.ws + WS_H) + (size_t)m * D;
#pragma unroll
        for (int j = 0; j < 4; ++j) { const f32x4 v = xv[j] * sc[j] + sh[j]; v2u o; o.x = pk2(v.x, v.y); o.y = pk2(v.z, v.w); *(v2u*)(h + 4 * F.lane + 256 * j) = o; }
    }
#undef MOD_LOAD
}

constexpr int ACT_PITCH = 264;
constexpr int REC_BYTES = 12544, REC_AT = 0, REC_RT = 2048, REC_BK = 4096, REC_TM = 8192, REC_QB = 8704, REC_NKA = 9216, REC_QK = 9728, REC_VT = 10240, REC_P15 = 12288;
__device__ __forceinline__ bf16x8 pk8(const float (&lo)[4], const float (&hi)[4]) {
    const unsigned a = pk2(lo[0], lo[1]), b = pk2(lo[2], lo[3]), c = pk2(hi[0], hi[1]), d = pk2(hi[2], hi[3]);
    return __builtin_bit_cast(bf16x8, (v4u){a, b, c, d});
}
__device__ __forceinline__ bf16x8 pk4lo(const f32x4 a) {
    return __builtin_bit_cast(bf16x8, (v4u){pk2(a[0], a[1]), pk2(a[2], a[3]), 0u, 0u});
}
__device__ __forceinline__ f32x4 mm16(const bf16x8 x, const bf16x8 y, const f32x4 c) { return __builtin_amdgcn_mfma_f32_16x16x32_bf16(x, y, c, 0, 0, 0); }
__device__ __forceinline__ float row_shr_f(float x, const int d) {
    int r; const int xi = __float_as_int(x);
    if (d == 1) r = __builtin_amdgcn_update_dpp(0, xi, 0x111, 0xf, 0xf, true); else if (d == 2) r = __builtin_amdgcn_update_dpp(0, xi, 0x112, 0xf, 0xf, true);
    else if (d == 4) r = __builtin_amdgcn_update_dpp(0, xi, 0x114, 0xf, 0xf, true); else r = __builtin_amdgcn_update_dpp(0, xi, 0x118, 0xf, 0xf, true);
    return __int_as_float(r);
}
__device__ __forceinline__ void ph_prep(Frame& F) {
    const bf16* PROJ = (const bf16*)(F.ws + WS_PROJ);
    const float* mu_ = F.in[6]; const float* w0_ = F.in[7]; const float* a0_ = F.in[9];
    const float* k_k_ = F.in[12]; const float* k_a_ = F.in[13]; const float* r_k_ = F.in[14];
    bf16* RWG = (bf16*)(F.ws + WS_G); float* DOTRK = (float*)(F.ws + WS_DOTRK); unsigned char* REC = F.ws + WS_REC;
    LAS bf16* act = (LAS bf16*)(F.lds);
    const int lane = F.lane, tq = lane & 15, g = lane >> 4, head = F.wave;
    const bf16x8* FR = (const bf16x8*)(F.ws + WS_FRAG);
    bf16x8 Sel0, Sel1;
#pragma unroll
    for (int j = 0; j < 8; ++j) { Sel0[j] = (short)((j < 4 && 4 * g + j == tq) ? 0x3F80 : 0); Sel1[j] = (short)((j >= 4 && 4 * g + j - 4 == tq) ? 0x3F80 : 0); }
    const f32x4 Z4 = (f32x4){0.f, 0.f, 0.f, 0.f};
    LAS float* cst = (LAS float*)(F.lds + 16384);
    { const int t_ = F.tid; cst[t_] = mu_[RW_K + t_]; cst[512 + t_] = mu_[RW_R + t_]; cst[1024 + t_] = mu_[RW_V + t_]; cst[1536 + t_] = k_k_[t_]; cst[2048 + t_] = k_a_[t_]; cst[2560 + t_] = r_k_[t_]; cst[3072 + t_] = w0_[t_]; cst[3584 + t_] = a0_[t_]; }
    __syncthreads();
#pragma unroll 1
    for (int tile = F.vcu; tile < M / 16; tile += F.G) {
        const int t0 = tile * 16;
        {
            const int token = F.tid >> 5, cg = F.tid & 31; const int row = t0 + token; const bool has_prev = (row & (SEQ - 1)) != 0;
            const bf16* p = PROJ + (size_t)row * IN_COLS + C_RW + RW_WD + 8 * cg;
            const v4u cur = *(const v4u*)p; v4u prv = (v4u){0u, 0u, 0u, 0u}; if (has_prev) prv = *(const v4u*)(p - IN_COLS);
            const f32x4 m0 = *(const f32x4*)(mu_ + RW_WD + 8 * cg), m1 = *(const f32x4*)(mu_ + RW_WD + 8 * cg + 4);
            float v[8];
            { const unsigned cu[4] = {cur.x, cur.y, cur.z, cur.w}, pu[4] = {prv.x, prv.y, prv.z, prv.w}; const float mm[8] = {m0.x, m0.y, m0.z, m0.w, m1.x, m1.y, m1.z, m1.w};
#pragma unroll
              for (int e = 0; e < 4; ++e) { const float c0 = bflo(cu[e]), c1 = bfhi(cu[e]), p0 = bflo(pu[e]), p1 = bfhi(pu[e]);
                  v[2 * e] = c0 + (p0 - c0) * mm[2 * e]; v[2 * e + 1] = c1 + (p1 - c1) * mm[2 * e + 1]; } }
            if (cg < 8) {
#pragma unroll
                for (int e = 0; e < 8; ++e) v[e] = 1.f - 2.f / (1.f + __expf(2.f * v[e]));
            } else if (cg >= 16) {
#pragma unroll
                for (int e = 0; e < 8; ++e) v[e] = 1.f / (1.f + __expf(-v[e]));
            }
            v4u o; o.x = pk2(v[0], v[1]); o.y = pk2(v[2], v[3]); o.z = pk2(v[4], v[5]); o.w = pk2(v[6], v[7]);
            *(LAS v4u*)(act + token * ACT_PITCH + 8 * cg) = o;
        }
        const int row = t0 + tq; const bool has_prev = (row & (SEQ - 1)) != 0;
        v2u kcA[4], kpA[4], rcA[4], rpA[4], vcA[4], vpA[4];
#pragma unroll
        for (int nb = 0; nb < 4; ++nb) { const int col = head * 64 + nb * 16 + 4 * g; const bf16* pb = PROJ + (size_t)row * IN_COLS + C_RW + col;
            kcA[nb] = *(const v2u*)(pb + RW_K); rcA[nb] = *(const v2u*)(pb + RW_R); vcA[nb] = *(const v2u*)(pb + RW_V);
            kpA[nb] = (v2u){0u, 0u}; rpA[nb] = kpA[nb]; vpA[nb] = kpA[nb];
            if (has_prev) { kpA[nb] = *(const v2u*)(pb + RW_K - IN_COLS); rpA[nb] = *(const v2u*)(pb + RW_R - IN_COLS); vpA[nb] = *(const v2u*)(pb + RW_V - IN_COLS); } }
        __syncthreads();
        const bf16x8* FRl = FR; asm volatile("" : "+s"(FRl));
        {
            f32x4 accg[4];
#pragma unroll
            for (int nb = 0; nb < 4; ++nb) accg[nb] = Z4;
#pragma unroll
            for (int ks = 0; ks < 4; ++ks) {
                const bf16x8 Ag = *(const LAS bf16x8*)(act + tq * ACT_PITCH + 128 + 32 * ks + 8 * g);
#pragma unroll
                for (int nb = 0; nb < 4; ++nb) { const bf16x8 Bg = FRl[(size_t)(128 + ((head * 4 + ks) * 4 + nb)) * 64 + lane]; accg[nb] = mm16(Bg, Ag, accg[nb]); }
            }
#pragma unroll
            for (int nb = 0; nb < 4; ++nb) { const int col = head * 64 + nb * 16 + 4 * g; v2u o; o.x = pk2(accg[nb][0], accg[nb][1]); o.y = pk2(accg[nb][2], accg[nb][3]); *(v2u*)(RWG + (size_t)row * 512 + col) = o; }
        }
        f32x4 accw[4], acca[4];
#pragma unroll
        for (int nb = 0; nb < 4; ++nb) { accw[nb] = Z4; acca[nb] = Z4; }
#pragma unroll
        for (int ks = 0; ks < 2; ++ks) {
            const bf16x8 Aw = *(const LAS bf16x8*)(act + tq * ACT_PITCH + 32 * ks + 8 * g);
            const bf16x8 Aa = *(const LAS bf16x8*)(act + tq * ACT_PITCH + 64 + 32 * ks + 8 * g);
#pragma unroll
            for (int nb = 0; nb < 4; ++nb) { const bf16x8 Bw = FRl[(size_t)(((head * 2 + ks) * 4 + nb)) * 64 + lane], Ba = FRl[(size_t)(64 + ((head * 2 + ks) * 4 + nb)) * 64 + lane];
                accw[nb] = mm16(Bw, Aw, accw[nb]); acca[nb] = mm16(Ba, Aa, acca[nb]); }
        }
        float ss = 0.f;
#pragma unroll
        for (int nb = 0; nb < 4; ++nb) {
            const int col = head * 64 + nb * 16 + 4 * g;
            const v2u cur = kcA[nb], prv = kpA[nb];
            const f32x4 mk = *(const LAS f32x4*)(cst + col), kk4 = *(const LAS f32x4*)(cst + 1536 + col);
            const float cc[4] = {bflo(cur.x), bfhi(cur.x), bflo(cur.y), bfhi(cur.y)}, pp[4] = {bflo(prv.x), bfhi(prv.x), bflo(prv.y), bfhi(prv.y)};
#pragma unroll
            for (int i = 0; i < 4; ++i) { const float kr = (cc[i] + (pp[i] - cc[i]) * mk[i]) * kk4[i]; ss += kr * kr; }
        }
        ss += __shfl_xor(ss, 16); ss += __shfl_xor(ss, 32);
        const float rn = rsqrtf(fmaxf(ss, 1e-24f));
        float drk = 0.f;
        unsigned char* rec = REC + ((size_t)((row >> 11) * 8 + head) * (SEQ / 16) + (size_t)((t0 & (SEQ - 1)) >> 4)) * REC_BYTES;
        f32x4 N = Z4, NT = Z4, Nka = Z4, Qb = Z4, Qk = Z4;
#pragma unroll
        for (int s2 = 0; s2 < 2; ++s2) {
            v2u dAt[2], dRt[2], dBt[2], dKt[2], dBp[2], dKp[2], dVv[2];
#pragma unroll
            for (int h2 = 0; h2 < 2; ++h2) {
                const int nb = 2 * s2 + h2;
                const int col = head * 64 + nb * 16 + 4 * g;
                const v2u kc = kcA[nb], rc = rcA[nb], vc = vcA[nb], kp_ = kpA[nb], rp = rpA[nb], vp = vpA[nb];
                const f32x4 mk = *(const LAS f32x4*)(cst + col), mr = *(const LAS f32x4*)(cst + 512 + col), mv = *(const LAS f32x4*)(cst + 1024 + col), kk4 = *(const LAS f32x4*)(cst + 1536 + col), ka4 = *(const LAS f32x4*)(cst + 2048 + col), rk4 = *(const LAS f32x4*)(cst + 2560 + col);
                const f32x4 w04 = *(const LAS f32x4*)(cst + 3072 + col), a04 = *(const LAS f32x4*)(cst + 3584 + col);
                const float kcc[4] = {bflo(kc.x), bfhi(kc.x), bflo(kc.y), bfhi(kc.y)}, kpp[4] = {bflo(kp_.x), bfhi(kp_.x), bflo(kp_.y), bfhi(kp_.y)};
                const float rcc[4] = {bflo(rc.x), bfhi(rc.x), bflo(rc.y), bfhi(rc.y)}, rpp[4] = {bflo(rp.x), bfhi(rp.x), bflo(rp.y), bfhi(rp.y)};
                const float vcc[4] = {bflo(vc.x), bfhi(vc.x), bflo(vc.y), bfhi(vc.y)}, vpp[4] = {bflo(vp.x), bfhi(vp.x), bflo(vp.y), bfhi(vp.y)};
                f32x4 p15; float At[4], Rt[4], Bt[4], Kt[4], Bp[4], Kp[4], Vv[4];
#pragma unroll
                for (int i = 0; i < 4; ++i) {
                    const float lw = accw[nb][i] + w04[i], z = -lw;
                    const float sp = fmaxf(z, 0.f) + __logf(1.f + __expf(-fabsf(z)));
                    const float ld = -__expf(-sp - 0.5f);
                    float cs = ld; cs += row_shr_f(cs, 1); cs += row_shr_f(cs, 2); cs += row_shr_f(cs, 4); cs += row_shr_f(cs, 8);
                    const float Pt = __expf(cs), Pinv = __expf(-cs), Pprev = __expf(cs - ld);
                    const float a = 1.f / (1.f + __expf(-(acca[nb][i] + a04[i])));
                    const float k = kcc[i] + (kpp[i] - kcc[i]) * mk[i], r = rcc[i] + (rpp[i] - rcc[i]) * mr[i], v = vcc[i] + (vpp[i] - vcc[i]) * mv[i];
                    const float kkn = k * kk4[i] * rn, bb = kkn * a, kp = k * (1.f + (a - 1.f) * ka4[i]);
                    drk += r * kp * rk4[i];
                    const float P15 = __shfl(Pt, (lane & 48) | 15); p15[i] = P15;
                    const float Pend = P15 * Pinv;
                    At[i] = -kkn * Pprev; Rt[i] = r * Pt; Bt[i] = bb * Pinv; Kt[i] = kp * Pinv; Bp[i] = bb * Pend; Kp[i] = kp * Pend; Vv[i] = v;
                }
                if (tq == 0) *(f32x4*)(rec + REC_P15 + (g * 16 + nb * 4) * 4) = p15;
                dAt[h2] = (v2u){pk2(At[0], At[1]), pk2(At[2], At[3])}; dRt[h2] = (v2u){pk2(Rt[0], Rt[1]), pk2(Rt[2], Rt[3])}; dBt[h2] = (v2u){pk2(Bt[0], Bt[1]), pk2(Bt[2], Bt[3])}; dKt[h2] = (v2u){pk2(Kt[0], Kt[1]), pk2(Kt[2], Kt[3])};
                dBp[h2] = (v2u){pk2(Bp[0], Bp[1]), pk2(Bp[2], Bp[3])}; dKp[h2] = (v2u){pk2(Kp[0], Kp[1]), pk2(Kp[2], Kp[3])}; dVv[h2] = (v2u){pk2(Vv[0], Vv[1]), pk2(Vv[2], Vv[3])};
                __builtin_amdgcn_sched_barrier(0);
            }
#define FR8(d) __builtin_bit_cast(bf16x8, (v4u){d[0].x, d[0].y, d[1].x, d[1].y})
            const bf16x8 AtF = FR8(dAt), RtF = FR8(dRt), BtF = FR8(dBt), KtF = FR8(dKt), BpF = FR8(dBp), KpF = FR8(dKp), VF = FR8(dVv);
#undef FR8
            ((bf16x8*)(rec + REC_AT + s2 * 1024))[lane] = AtF; ((bf16x8*)(rec + REC_RT + s2 * 1024))[lane] = RtF;
            N = mm16(BtF, AtF, N); NT = mm16(AtF, BtF, NT); Nka = mm16(KtF, AtF, Nka); Qb = mm16(BtF, RtF, Qb); Qk = mm16(KtF, RtF, Qk);
#pragma unroll
            for (int h2 = 0; h2 < 2; ++h2) {
                const int kt = 2 * s2 + h2; const bf16x8 sel = h2 ? Sel1 : Sel0;
                const f32x4 bT = mm16(BpF, sel, Z4), kT = mm16(KpF, sel, Z4), vT = mm16(VF, sel, Z4);
                const float bl[4] = {bT[0], bT[1], bT[2], bT[3]}, kl[4] = {kT[0], kT[1], kT[2], kT[3]};
                ((bf16x8*)(rec + REC_BK + kt * 1024))[lane] = pk8(bl, kl);
                v2u o; o.x = pk2(vT[0], vT[1]); o.y = pk2(vT[2], vT[3]); ((v2u*)(rec + REC_VT + kt * 512))[lane] = o;
            }
            __builtin_amdgcn_sched_barrier(0);
        }
        drk += __shfl_xor(drk, 16); drk += __shfl_xor(drk, 32);
        if (g == 0) DOTRK[(size_t)row * 8 + head] = drk;
#pragma unroll
        for (int i = 0; i < 4; ++i) { const int rr = 4 * g + i;
            if (!(rr < tq)) { N[i] = 0.f; Nka[i] = 0.f; }
            if (!(tq < rr)) NT[i] = 0.f;
            if (!(rr <= tq)) { Qb[i] = 0.f; Qk[i] = 0.f; } }
        f32x4 R = N, RT = NT;
#pragma unroll
        for (int i = 0; i < 4; ++i) { if (4 * g + i == tq) { R[i] += 1.f; RT[i] += 1.f; } }
        {
            const f32x4 N2 = mm16(pk4lo(NT), pk4lo(N), Z4), N2T = mm16(pk4lo(N), pk4lo(NT), Z4);
            const f32x4 R1 = mm16(pk4lo(RT), pk4lo(N2), R), RT1 = mm16(pk4lo(N2), pk4lo(RT), RT);
            const f32x4 N4 = mm16(pk4lo(N2T), pk4lo(N2), Z4), N4T = mm16(pk4lo(N2), pk4lo(N2T), Z4);
            const f32x4 R2 = mm16(pk4lo(RT1), pk4lo(N4), R1), RT2 = mm16(pk4lo(N4), pk4lo(RT1), RT1);
            const f32x4 N8 = mm16(pk4lo(N4T), pk4lo(N4), Z4);
            R = mm16(pk4lo(RT2), pk4lo(N8), R2);
        }
        { v2u o; o.x = pk2(R[0], R[1]); o.y = pk2(R[2], R[3]); ((v2u*)(rec + REC_TM))[lane] = o;
          o.x = pk2(Qb[0], Qb[1]); o.y = pk2(Qb[2], Qb[3]); ((v2u*)(rec + REC_QB))[lane] = o;
          o.x = pk2(Nka[0], Nka[1]); o.y = pk2(Nka[2], Nka[3]); ((v2u*)(rec + REC_NKA))[lane] = o;
          o.x = pk2(Qk[0], Qk[1]); o.y = pk2(Qk[2], Qk[3]); ((v2u*)(rec + REC_QK))[lane] = o; }
        __syncthreads();
    }
}

constexpr int KV_PITCH = 72;
__device__ __forceinline__ s16x4 tr_read(const LAS bf16* p) { typedef short v4i16_t __attribute__((ext_vector_type(4))); return __builtin_bit_cast(s16x4, __builtin_amdgcn_ds_read_tr16_b64_v4i16((LAS v4i16_t*)p)); }
__device__ __forceinline__ void ph_attn(Frame& F) {
    const bf16* PROJ = (const bf16*)(F.ws + WS_PROJ); bf16* MIX = (bf16*)F.out; const float* sink = F.in[5];
    LAS bf16* Ks = (LAS bf16*)(F.lds); LAS bf16* Vs = Ks + 256 * KV_PITCH;
    for (int i = F.tid; i < 16 * KV_PITCH / 2; i += 512) ((LAS unsigned*)(Vs + 256 * KV_PITCH))[i] = 0u;
    const int tq = F.lane & 15, g = F.lane >> 4;
    for (int u = F.vcu; u < 512; u += F.G) {
        const int b = u >> 5, kvh = (u >> 4) & 1, n = u & 15;
        const size_t row0 = (size_t)b * SEQ + (size_t)n * 128;
#pragma unroll
        for (int i = 0; i < 4; ++i) {
            const int c = F.tid + 512 * i, krow = c >> 3, part = c & 7;
            v4u kx = (v4u){0u, 0u, 0u, 0u}, vx = kx;
            if (n > 0 || krow >= 128) { const bf16* src = PROJ + (row0 - 128 + krow) * IN_COLS + kvh * 64 + part * 8; kx = *(const v4u*)(src + C_K); vx = *(const v4u*)(src + C_V); }
            *(LAS v4u*)(Ks + krow * KV_PITCH + part * 8) = kx; *(LAS v4u*)(Vs + krow * KV_PITCH + part * 8) = vx;
        }
        __syncthreads();
        const int gq = F.wave >> 1, qh = F.wave & 1, hq = kvh * 4 + gq; const float sinkv = sink[hq];
        for (int qb = 0; qb < 4; ++qb) {
            const int i0 = 64 * qh + 16 * qb, kb0 = 4 * qh + qb, iq = i0 + tq;
            const bf16* qp = PROJ + (row0 + iq) * IN_COLS + C_Q + hq * 64 + 8 * g;
            const bf16x8 Q0 = *(const bf16x8*)qp, Q1 = *(const bf16x8*)(qp + 32);
            float s[9][4]; float mx = -INFINITY;
#pragma unroll
            for (int kbi = 0; kbi < 9; ++kbi) {
                const LAS bf16* kp = Ks + ((kb0 + kbi) * 16 + tq) * KV_PITCH + 8 * g;
                f32x4 a = (f32x4){0.f, 0.f, 0.f, 0.f};
                a = __builtin_amdgcn_mfma_f32_16x16x32_bf16(*(const LAS bf16x8*)kp, Q0, a, 0, 0, 0);
                a = __builtin_amdgcn_mfma_f32_16x16x32_bf16(*(const LAS bf16x8*)(kp + 32), Q1, a, 0, 0, 0);
#pragma unroll
                for (int i = 0; i < 4; ++i) { const int j = (kb0 + kbi) * 16 + 4 * g + i; const bool ok = (j > iq) && (j <= iq + 128) && (n > 0 || j >= 128);
                    const float sv = ok ? a[i] * 0.125f : -INFINITY; s[kbi][i] = sv; mx = fmaxf(mx, sv); }
            }
            mx = fmaxf(mx, __shfl_xor(mx, 16)); mx = fmaxf(mx, __shfl_xor(mx, 32)); mx = fmaxf(mx, sinkv);
            float l = 0.f;
#pragma unroll
            for (int kbi = 0; kbi < 9; ++kbi)
#pragma unroll
                for (int i = 0; i < 4; ++i) { const float p = __expf(s[kbi][i] - mx); s[kbi][i] = p; l += p; }
            l += __shfl_xor(l, 16); l += __shfl_xor(l, 32); l += __expf(sinkv - mx);
            const float rl = 1.f / l;
            bf16x8 P[5];
#pragma unroll
            for (int pr = 0; pr < 5; ++pr) {
#pragma unroll
                for (int i = 0; i < 4; ++i) { P[pr][i] = (short)f2bf(s[2 * pr][i]); P[pr][4 + i] = (pr < 4) ? (short)f2bf(s[(pr < 4) ? 2 * pr + 1 : 0][i]) : (short)0; }
            }
            bf16* op = MIX + (row0 + iq) * D + hq * 64 + 4 * g;
#pragma unroll
            for (int db = 0; db < 4; ++db) {
                f32x4 o = (f32x4){0.f, 0.f, 0.f, 0.f};
#pragma unroll
                for (int pr = 0; pr < 5; ++pr) {
                    const LAS bf16* vp = Vs + ((kb0 + 2 * pr) * 16 + 4 * g + (tq >> 2)) * KV_PITCH + db * 16 + 4 * (tq & 3);
                    const s16x4 lo = tr_read(vp), hi = tr_read(vp + 16 * KV_PITCH);
                    const bf16x8 Vf = (bf16x8){lo[0], lo[1], lo[2], lo[3], hi[0], hi[1], hi[2], hi[3]};
                    o = __builtin_amdgcn_mfma_f32_16x16x32_bf16(Vf, P[pr], o, 0, 0, 0);
                }
                v2u w; w.x = pk2(o[0] * rl, o[1] * rl); w.y = pk2(o[2] * rl, o[3] * rl);
                *(v2u*)(op + db * 16) = w;
            }
        }
        __syncthreads();
    }
}

struct ScanRec { bf16x8 f[8]; v2u m[4]; v2u vt; f32x4 p[4]; };
__device__ __forceinline__ void scan_load(ScanRec& Rr, const unsigned char* rec, int lane, int vt, int g) {
#pragma unroll
    for (int i = 0; i < 8; ++i) Rr.f[i] = ((const bf16x8*)(rec + i * 1024))[lane];
#pragma unroll
    for (int i = 0; i < 4; ++i) Rr.m[i] = ((const v2u*)(rec + REC_TM + i * 512))[lane];
    Rr.vt = ((const v2u*)(rec + REC_VT + vt * 512))[lane];
#pragma unroll
    for (int i = 0; i < 4; ++i) Rr.p[i] = *(const f32x4*)(rec + REC_P15 + (g * 16 + i * 4) * 4);
}
__device__ __forceinline__ bf16x8 lo8(const v2u a) { return __builtin_bit_cast(bf16x8, (v4u){a.x, a.y, 0u, 0u}); }
__device__ __forceinline__ void scan_chunk(const ScanRec& Rr, f32x4 (&S)[4], bf16* yp) {
    const f32x4 Z4 = (f32x4){0.f, 0.f, 0.f, 0.f};
    const bf16x8 Vlo = lo8(Rr.vt);
    const f32x4 W0 = mm16(lo8(Rr.m[2]), Vlo, Z4), Y0 = mm16(lo8(Rr.m[3]), Vlo, Z4);
    const bf16x8 Sb0 = __builtin_bit_cast(bf16x8, (v4u){pk2(S[0][0], S[0][1]), pk2(S[0][2], S[0][3]), pk2(S[1][0], S[1][1]), pk2(S[1][2], S[1][3])});
    const bf16x8 Sb1 = __builtin_bit_cast(bf16x8, (v4u){pk2(S[2][0], S[2][1]), pk2(S[2][2], S[2][3]), pk2(S[3][0], S[3][1]), pk2(S[3][2], S[3][3])});
    const f32x4 XW = mm16(Rr.f[1], Sb1, mm16(Rr.f[0], Sb0, W0));
    f32x4 YT = mm16(Rr.f[3], Sb1, mm16(Rr.f[2], Sb0, Y0));
    const f32x4 UT = mm16(lo8(Rr.m[0]), pk4lo(XW), Z4);
    const v2u utp = (v2u){pk2(UT[0], UT[1]), pk2(UT[2], UT[3])};
    YT = mm16(lo8(Rr.m[1]), lo8(utp), YT);
    const bf16x8 UV = __builtin_bit_cast(bf16x8, (v4u){utp.x, utp.y, Rr.vt.x, Rr.vt.y});
#pragma unroll
    for (int kt = 0; kt < 4; ++kt) S[kt] = mm16(Rr.f[4 + kt], UV, S[kt] * Rr.p[kt]);
#pragma unroll
    for (int i = 0; i < 4; ++i) yp[(size_t)i * 512] = (bf16)f2bf(YT[i]);
}
__device__ __forceinline__ float wave_sum_f(float v) { v = red16(v); v += __shfl_xor(v, 16); v += __shfl_xor(v, 32); return v; }
__device__ __forceinline__ float wave_max(float v) {
    v = fmaxf(v, dpp_f(v, 0)); v = fmaxf(v, dpp_f(v, 1)); v = fmaxf(v, dpp_f(v, 2)); v = fmaxf(v, dpp_f(v, 3));
    v = fmaxf(v, __shfl_xor(v, 16)); v = fmaxf(v, __shfl_xor(v, 32)); return v;
}
__device__ __forceinline__ unsigned q4(const f32x4 v, float inv, int bias) {
    const int a = (int)rintf(v.x * inv) + bias, b = (int)rintf(v.y * inv) + bias, c = (int)rintf(v.z * inv) + bias, d = (int)rintf(v.w * inv) + bias;
    return (unsigned)(a & 0xff) | ((unsigned)(b & 0xff) << 8) | ((unsigned)(c & 0xff) << 16) | ((unsigned)(d & 0xff) << 24);
}
__device__ __forceinline__ void ph_convert(Frame& F, int gw, int NGW) {
    const int lane = F.lane;
    unsigned* U8 = (unsigned*)(F.ws + WS_U8); unsigned* V8 = (unsigned*)(F.ws + WS_V8); float* US = (float*)(F.ws + WS_US); float* VS = (float*)(F.ws + WS_VS);
    f32x4 rn[4];
#define CV_LOAD(r_) do { const float* s_ = ((r_) < 16384) ? F.in[22] + (size_t)(r_) * D : F.in[23] + (size_t)((r_) - 16384) * D; \
        _Pragma("unroll") for (int j = 0; j < 4; ++j) rn[j] = *(const f32x4*)(s_ + 4 * lane + 256 * j); } while (0)
    if (gw < 32768) CV_LOAD(gw);
    for (int r = gw; r < 32768; r += NGW) {
        f32x4 xv[4];
#pragma unroll
        for (int j = 0; j < 4; ++j) xv[j] = rn[j];
        if (r + NGW < 32768) CV_LOAD(r + NGW);
        float am = 0.f;
#pragma unroll
        for (int j = 0; j < 4; ++j) am = fmaxf(am, fmaxf(fmaxf(fabsf(xv[j].x), fabsf(xv[j].y)), fmaxf(fabsf(xv[j].z), fabsf(xv[j].w))));
        am = fmaxf(wave_max(am), 1e-30f); const float inv = 127.f / am;
        if (r < 16384) {
#pragma unroll
            for (int j = 0; j < 4; ++j) U8[(size_t)r * 256 + lane + 64 * j] = q4(xv[j], inv, 0);
            if (lane == 0) US[r] = am * (1.f / 127.f);
        } else {
            const int e = r - 16384;
#pragma unroll
            for (int j = 0; j < 4; ++j) V8[((size_t)(2 * j + (lane >> 5)) * 16384 + e) * 32 + (lane & 31)] = q4(xv[j], inv, 0);
            if (lane == 0) VS[e] = am * (1.f / 127.f);
        }
    }
#undef CV_LOAD
}
__device__ __forceinline__ void scan_lds_load(ScanRec& Rr, const LAS unsigned char* rec, int lane, int vt, int g) {
#pragma unroll
    for (int i = 0; i < 8; ++i) Rr.f[i] = ((const LAS bf16x8*)(rec + i * 1024))[lane];
#pragma unroll
    for (int i = 0; i < 4; ++i) Rr.m[i] = ((const LAS v2u*)(rec + REC_TM + i * 512))[lane];
    Rr.vt = ((const LAS v2u*)(rec + REC_VT + vt * 512))[lane];
#pragma unroll
    for (int i = 0; i < 4; ++i) Rr.p[i] = *(const LAS f32x4*)(rec + REC_P15 + (g * 16 + i * 4) * 4);
}
__device__ __forceinline__ void ph_scan(Frame& F) {
    const unsigned char* REC = F.ws + WS_REC; bf16* YB = (bf16*)(F.ws + WS_YB);
    const int lane = F.lane, tq = lane & 15, g = lane >> 4;
    constexpr int NCH = SEQ / 16;
#define SC_BAR() do { asm volatile("s_waitcnt lgkmcnt(0)" ::: "memory"); __builtin_amdgcn_s_barrier(); asm volatile("" ::: "memory"); } while (0)
    const bool split = (F.G == 256); const int n_scan = split ? 128 : F.G, sidx = split ? (F.vcu >> 1) : F.vcu; const bool scanner = split ? ((F.vcu & 1) == 0) : true;
    if (scanner) for (int item = sidx; item < 128; item += n_scan) {
        const int bh = item, b = bh >> 3, h = bh & 7;
        const unsigned char* rec = REC + (size_t)bh * NCH * REC_BYTES;
        if (F.wave < 4) {
            const int vt = F.wave;
            bf16* yp = YB + ((size_t)b * SEQ + 4 * g) * 512 + h * 64 + vt * 16 + tq;
            f32x4 S[4];
#pragma unroll
            for (int kt = 0; kt < 4; ++kt) S[kt] = (f32x4){0.f, 0.f, 0.f, 0.f};
            SC_BAR();
            for (int c = 0; c < NCH; ++c) {
                ScanRec Rr; scan_lds_load(Rr, F.lds + (c & 1) * REC_BYTES, lane, vt, g);
                scan_chunk(Rr, S, yp + (size_t)c * 16 * 512);
                SC_BAR();
            }
        } else {
            const int l = F.tid - 256;
            const bool fourth = l < 16;
            v4u bf[4][4];
#define LD_CH(ch_, bi_) do { const unsigned char* r_ = rec + (size_t)(ch_) * REC_BYTES; bf[bi_][0] = *(const v4u*)(r_ + l * 16); bf[bi_][1] = *(const v4u*)(r_ + (l + 256) * 16); bf[bi_][2] = *(const v4u*)(r_ + (l + 512) * 16); if (fourth) bf[bi_][3] = *(const v4u*)(r_ + (768 + l) * 16); } while (0)
#define WR_CH(slot_, bi_) do { LAS unsigned char* s_ = F.lds + (slot_) * REC_BYTES; *(LAS v4u*)(s_ + l * 16) = bf[bi_][0]; *(LAS v4u*)(s_ + (l + 256) * 16) = bf[bi_][1]; *(LAS v4u*)(s_ + (l + 512) * 16) = bf[bi_][2]; if (fourth) *(LAS v4u*)(s_ + (768 + l) * 16) = bf[bi_][3]; } while (0)
            LD_CH(0, 0); WR_CH(0, 0);
            LD_CH(1, 1); LD_CH(2, 2); LD_CH(3, 3); LD_CH(4, 0);
            SC_BAR();
            for (int c = 0; c < NCH; c += 4) {
#define LD_STEP(k_) do { const int cc_ = c + (k_); if (cc_ + 1 < NCH) { WR_CH((cc_ + 1) & 1, ((k_) + 1) & 3); if (cc_ + 5 < NCH) LD_CH(cc_ + 5, ((k_) + 1) & 3); } SC_BAR(); } while (0)
                LD_STEP(0); LD_STEP(1); LD_STEP(2); LD_STEP(3);
#undef LD_STEP
            }
#undef LD_CH
#undef WR_CH
        }
    }
#undef SC_BAR
    if (split) { if (!scanner) ph_convert(F, (F.vcu >> 1) * NWAVES + F.wave, 128 * NWAVES); }
    else ph_convert(F, F.vcu * NWAVES + F.wave, F.G * NWAVES);
}

__device__ __forceinline__ void unpack8(const v4u u, float (&o)[8]) { o[0] = bflo(u.x); o[1] = bfhi(u.x); o[2] = bflo(u.y); o[3] = bfhi(u.y); o[4] = bflo(u.z); o[5] = bfhi(u.z); o[6] = bflo(u.w); o[7] = bfhi(u.w); }
__device__ __forceinline__ void ph_post(Frame& F) {
    const bf16* PROJ = (const bf16*)(F.ws + WS_PROJ); const float* mu = F.in[6]; const float* lnx_g = F.in[15]; const float* lnx_b = F.in[16];
    const bf16* YB = (const bf16*)(F.ws + WS_YB); const float* DOTRK = (const float*)(F.ws + WS_DOTRK); const bf16* RWG = (const bf16*)(F.ws + WS_G); bf16* MIX = (bf16*)F.out;
    const int gw = F.vcu * NWAVES + F.wave, NGW = F.G * NWAVES, j = F.lane * 8;
    float mv[8], lg[8], lb[8];
    { const f32x4 a = *(const f32x4*)(mu + RW_V + j), b = *(const f32x4*)(mu + RW_V + j + 4); mv[0] = a.x; mv[1] = a.y; mv[2] = a.z; mv[3] = a.w; mv[4] = b.x; mv[5] = b.y; mv[6] = b.z; mv[7] = b.w; }
    { const f32x4 a = *(const f32x4*)(lnx_g + j), b = *(const f32x4*)(lnx_g + j + 4); lg[0] = a.x; lg[1] = a.y; lg[2] = a.z; lg[3] = a.w; lg[4] = b.x; lg[5] = b.y; lg[6] = b.z; lg[7] = b.w; }
    { const f32x4 a = *(const f32x4*)(lnx_b + j), b = *(const f32x4*)(lnx_b + j + 4); lb[0] = a.x; lb[1] = a.y; lb[2] = a.z; lb[3] = a.w; lb[4] = b.x; lb[5] = b.y; lb[6] = b.z; lb[7] = b.w; }
    for (int m = gw; m < M; m += NGW) {
        const bool has_prev = (m & (SEQ - 1)) != 0;
        const v4u yu = *(const v4u*)(YB + (size_t)m * 512 + j);
        const bf16* pv = PROJ + (size_t)m * IN_COLS + C_RW + RW_V + j;
        const v4u vc = *(const v4u*)pv; v4u vp = (v4u){0u, 0u, 0u, 0u}; if (has_prev) vp = *(const v4u*)(pv - IN_COLS);
        const v4u gu = *(const v4u*)(RWG + (size_t)m * 512 + j);
        const float dot = DOTRK[(size_t)m * 8 + (F.lane >> 3)];
        float y[8], vc8[8], vp8[8], g8[8];
        unpack8(yu, y); unpack8(vc, vc8); unpack8(vp, vp8); unpack8(gu, g8);
        float sum = 0.f; float vv[8];
#pragma unroll
        for (int e = 0; e < 8; ++e) { vv[e] = vc8[e] + (vp8[e] - vc8[e]) * mv[e]; sum += y[e]; }
        sum = red8(sum);
        const float mean = sum * (1.f / 64.f); float q = 0.f;
#pragma unroll
        for (int e = 0; e < 8; ++e) { y[e] -= mean; q += y[e] * y[e]; }
        q = red8(q);
        const float rstd = rsqrtf(q * (1.f / 64.f) + GN_EPS);
        float o[8];
#pragma unroll
        for (int e = 0; e < 8; ++e) o[e] = ((y[e] * rstd) * lg[e] + lb[e] + dot * vv[e]) * g8[e];
        v4u w; w.x = pk2(o[0], o[1]); w.y = pk2(o[2], o[3]); w.z = pk2(o[4], o[5]); w.w = pk2(o[6], o[7]);
        *(v4u*)(MIX + (size_t)m * D + 512 + j) = w;
    }
}

__device__ __forceinline__ void ph_ln1(Frame& F) {
    const int gw = F.vcu * NWAVES + F.wave, NGW = F.G * NWAVES, lane = F.lane;
    const float* modp = (const float*)(F.ws + WS_MOD); const bf16* Y1 = (const bf16*)(F.ws + WS_Y1); bf16* H2 = (bf16*)(F.ws + WS_H);
    unsigned* H8 = (unsigned*)(F.ws + WS_H8); float* HS = (float*)(F.ws + WS_HS);
    const float* lng = F.in[18]; const float* lnb = F.in[19];
    const int rpw = M / NGW, m_begin = gw * rpw, m_end = m_begin + rpw;
    const float* md = modp + (m_begin >> 11) * 6144;
    f32x4 gt[4], sh[4], sc[4], gg[4], bb[4];
#pragma unroll
    for (int j = 0; j < 4; ++j) { const int col = 4 * lane + 256 * j; gt[j] = *(const f32x4*)(md + 2048 + col); sh[j] = *(const f32x4*)(md + 3072 + col); sc[j] = *(const f32x4*)(md + 4096 + col) + 1.0f;
        gg[j] = *(const f32x4*)(lng + col); bb[j] = *(const f32x4*)(lnb + col); }
    f32x4 xn[4]; v2u yn[4];
#define LN1_LOAD(m_) do { const float* x_ = F.in[0] + (size_t)(m_) * D; const bf16* y_ = Y1 + (size_t)(m_) * D; \
        _Pragma("unroll") for (int j = 0; j < 4; ++j) { xn[j] = *(const f32x4*)(x_ + 4 * lane + 256 * j); yn[j] = *(const v2u*)(y_ + 4 * lane + 256 * j); } } while (0)
    LN1_LOAD(m_begin);
    for (int m = m_begin; m < m_end; ++m) {
        f32x4 v[4]; float s = 0.f;
#pragma unroll
        for (int j = 0; j < 4; ++j) { const f32x4 yv = (f32x4){bflo(yn[j].x), bfhi(yn[j].x), bflo(yn[j].y), bfhi(yn[j].y)}; v[j] = xn[j] * ALPHA + gt[j] * yv; s += (v[j].x + v[j].y) + (v[j].z + v[j].w); }
        if (m + 1 < m_end) LN1_LOAD(m + 1);
        const float mean = wave_sum_f(s) * (1.f / D); float s2 = 0.f;
#pragma unroll
        for (int j = 0; j < 4; ++j) { v[j] = v[j] - mean; s2 += (v[j].x * v[j].x + v[j].y * v[j].y) + (v[j].z * v[j].z + v[j].w * v[j].w); }
        const float rstd = rsqrtf(wave_sum_f(s2) * (1.f / D) + LN_EPS);
        f32x4 h[4]; float am = 0.f;
#pragma unroll
        for (int j = 0; j < 4; ++j) { const int col = 4 * lane + 256 * j;
            const f32x4 x1 = (v[j] * rstd) * gg[j] + bb[j]; *(f32x4*)(F.out + (size_t)m * D + col) = x1;
            h[j] = x1 * sc[j] + sh[j];
            v2u o; o.x = pk2(h[j].x, h[j].y); o.y = pk2(h[j].z, h[j].w); *(v2u*)(H2 + (size_t)m * D + col) = o;
            am = fmaxf(am, fmaxf(fmaxf(fabsf(h[j].x), fabsf(h[j].y)), fmaxf(fabsf(h[j].z), fabsf(h[j].w)))); }
        am = fmaxf(wave_max(am), 1e-20f); const float inv = 127.f / am;
#pragma unroll
        for (int j = 0; j < 4; ++j) H8[(size_t)m * 256 + lane + 64 * j] = q4(h[j], inv, 0);
        if (lane == 0) HS[m] = am * (1.f / 127.f);
    }
#undef LN1_LOAD
}

__device__ __forceinline__ unsigned f2key(float f) { const unsigned u = __float_as_uint(f); return u ^ ((u >> 31) ? 0xffffffffu : 0x80000000u); }
__device__ __forceinline__ float key2f(unsigned k) { const unsigned u = (k >> 31) ? (k ^ 0x80000000u) : ~k; return __uint_as_float(u); }
#define TOPK_INSERT(L, key) do { unsigned k_ = (key); _Pragma("unroll") for (int q_ = 0; q_ < 16; ++q_) { const unsigned hi_ = L[q_] > k_ ? L[q_] : k_; k_ = L[q_] > k_ ? k_ : L[q_]; L[q_] = hi_; } } while (0)
__device__ __forceinline__ void ce_desc(unsigned& x, unsigned& y) { const unsigned hi = x > y ? x : y, lo = x > y ? y : x; x = hi; y = lo; }
__device__ __forceinline__ void bitonic_sort16_desc(unsigned (&a)[16]) {
#pragma unroll
    for (int k = 2; k <= 16; k <<= 1)
#pragma unroll
        for (int j = k >> 1; j > 0; j >>= 1)
#pragma unroll
            for (int i = 0; i < 16; ++i) { const int l = i ^ j; if (l > i) { if ((i & k) == 0) ce_desc(a[i], a[l]); else ce_desc(a[l], a[i]); } }
}
__device__ __forceinline__ void bitonic_merge16_desc(unsigned (&a)[16]) {
#pragma unroll
    for (int j = 8; j > 0; j >>= 1)
#pragma unroll
        for (int i = 0; i < 16; ++i) { const int l = i ^ j; if (l > i) ce_desc(a[i], a[l]); }
}
__device__ __forceinline__ void top16_absorb(unsigned (&L)[16], unsigned (&B)[16], bool first) {
    bitonic_sort16_desc(B);
    if (first) {
#pragma unroll
        for (int i = 0; i < 16; ++i) L[i] = B[i];
    } else {
#pragma unroll
        for (int i = 0; i < 16; ++i) L[i] = L[i] > B[15 - i] ? L[i] : B[15 - i];
        bitonic_merge16_desc(L);
    }
}
__device__ __forceinline__ unsigned pick_byte(const unsigned (&P)[4], unsigned i) {
    const unsigned long long lo = (unsigned long long)P[0] | ((unsigned long long)P[1] << 32), hi = (unsigned long long)P[2] | ((unsigned long long)P[3] << 32);
    const unsigned long long w = (i & 8u) ? hi : lo;
    return (unsigned)(w >> ((i & 7u) * 8u)) & 0xffu;
}
__device__ __forceinline__ void ph_topk(Frame& F) {
    const bf16* SC = (const bf16*)(F.ws + WS_SC); int* PIDX = (int*)(F.ws + WS_PIDX); float* PGATE = (float*)(F.ws + WS_PGATE);
    LAS float* scr = (LAS float*)(F.lds + F.wave * 16384);
    const int gw = F.vcu * NWAVES + F.wave, NGW = F.G * NWAVES, lane = F.lane;
    for (int item = gw; item < (M / 64) * 8; item += NGW) {
        const int bt = item >> 3, h = item & 7; const size_t t0 = (size_t)bt * 64;
        unsigned L0[16], L1[16];
#pragma unroll
        for (int q = 0; q < 16; ++q) { L0[q] = 0u; L1[q] = 0u; }
#pragma unroll
        for (int c = 0; c < 2; ++c) {
            for (int sub = 0; sub < 4; ++sub) {
                const bf16* src = SC + t0 * NSC + (h * 2 + c) * 128 + sub * 32;
#pragma unroll
                for (int it = 0; it < 8; ++it) { const int row = it * 8 + (lane >> 3), c4 = (lane & 7) * 4; const v2u v = *(const v2u*)(src + (size_t)row * NSC + c4);
                    LAS float* d = scr + row * 33 + c4; d[0] = bflo(v.x); d[1] = bfhi(v.x); d[2] = bflo(v.y); d[3] = bfhi(v.y); }
                LDS_WAIT(); asm volatile("" ::: "memory");
#pragma unroll
                for (int hb = 0; hb < 2; ++hb) {
                    unsigned Bq[16];
#pragma unroll
                    for (int ci = 0; ci < 16; ++ci) { const float x = scr[lane * 33 + hb * 16 + ci]; Bq[ci] = (f2key(x) & ~127u) | (unsigned)(127 - (sub * 32 + hb * 16 + ci)); }
                    if (c == 0) top16_absorb(L0, Bq, sub == 0 && hb == 0); else top16_absorb(L1, Bq, sub == 0 && hb == 0);
                }
                LDS_WAIT(); asm volatile("" ::: "memory");
            }
        }
        float v0[16], v1[16]; unsigned P0[4] = {0u, 0u, 0u, 0u}, P1[4] = {0u, 0u, 0u, 0u};
#pragma unroll
        for (int q = 0; q < 16; ++q) { v0[q] = key2f(L0[q] & ~127u); v1[q] = key2f(L1[q] & ~127u);
            P0[q >> 2] |= (127u - (L0[q] & 127u)) << ((q & 3) * 8); P1[q >> 2] |= (127u - (L1[q] & 127u)) << ((q & 3) * 8); }
        unsigned Fk[16];
        {
            unsigned Bq[16]; int nq = 0; bool first = true;
#pragma unroll
            for (int i = 0; i < 16; ++i)
#pragma unroll
                for (int j = 0; j < 16; ++j) if ((i + 1) * (j + 1) <= 16) {
                    Bq[nq] = (f2key(v0[i] + v1[j]) & ~255u) | (unsigned)(255 - (i * 16 + j)); ++nq;
                    if (nq == 16) { top16_absorb(Fk, Bq, first); first = false; nq = 0; }
                }
#pragma unroll
            for (int q = 2; q < 16; ++q) Bq[q] = 0u;
            top16_absorb(Fk, Bq, false);
        }
        float fv[16]; const float fmax_ = key2f(Fk[0] & ~255u); float sum = 0.f;
#pragma unroll
        for (int q = 0; q < 16; ++q) { fv[q] = __expf(key2f(Fk[q] & ~255u) - fmax_); sum += fv[q]; }
        const float rs = 1.f / sum;
        int* pi = PIDX + (t0 + lane) * 128 + h * 16; float* pg = PGATE + (t0 + lane) * 128 + h * 16;
#pragma unroll
        for (int q4 = 0; q4 < 4; ++q4) {
            int e[4]; float gg[4];
#pragma unroll
            for (int r = 0; r < 4; ++r) { const int q = q4 * 4 + r; const unsigned code = 255u - (Fk[q] & 255u); const unsigned i = code >> 4, j = code & 15u;
                e[r] = (int)(pick_byte(P0, i) * 128u + pick_byte(P1, j)); gg[r] = fv[q] * rs; }
            *(int4*)(pi + q4 * 4) = make_int4(e[0], e[1], e[2], e[3]); *(f32x4*)(pg + q4 * 4) = (f32x4){gg[0], gg[1], gg[2], gg[3]};
        }
    }
}

__device__ __forceinline__ int dot16(const v4u a, const v4u b) {
    int s = __builtin_amdgcn_sdot4((int)a.x, (int)b.x, 0, false); s = __builtin_amdgcn_sdot4((int)a.y, (int)b.y, s, false);
    s = __builtin_amdgcn_sdot4((int)a.z, (int)b.z, s, false); return __builtin_amdgcn_sdot4((int)a.w, (int)b.w, s, false);
}
constexpr int UD_R = 5;
struct UdTok { v4u u[UD_R][4]; unsigned ent[UD_R]; float us[UD_R], vs[UD_R]; };
__device__ __forceinline__ int ud_compact(LAS unsigned* lst, int e0, int e1, int x, int lane) {
    const bool m0 = (e0 >> 11) == x, m1 = (e1 >> 11) == x;
    const unsigned long long b0 = __ballot(m0), b1 = __ballot(m1);
    const int cnt0 = __popcll(b0), cnt = cnt0 + __popcll(b1);
    const int p0 = __builtin_amdgcn_mbcnt_hi((unsigned)(b0 >> 32), __builtin_amdgcn_mbcnt_lo((unsigned)b0, 0u));
    const int p1 = cnt0 + __builtin_amdgcn_mbcnt_hi((unsigned)(b1 >> 32), __builtin_amdgcn_mbcnt_lo((unsigned)b1, 0u));
    if (m0) lst[p0] = (unsigned)lane | ((unsigned)e0 << 8);
    if (m1) lst[p1] = (unsigned)(lane + 64) | ((unsigned)e1 << 8);
    return cnt;
}
__device__ __forceinline__ void ud_issue(UdTok& S, const LAS unsigned* lst, int base, int cnt, const unsigned char* U8, const float* US, const float* VS, int li, int gg) {
#pragma unroll
    for (int rr = 0; rr < UD_R; ++rr) if (base + 4 * rr < cnt) {
        const int idx = base + 4 * rr + gg; const unsigned en = lst[idx < cnt ? idx : cnt - 1]; S.ent[rr] = en;
        const unsigned char* up = U8 + (size_t)(en >> 8) * 1024 + 16 * li;
#pragma unroll
        for (int c = 0; c < 4; ++c) S.u[rr][c] = *(const v4u*)(up + 256 * c);
        S.us[rr] = US[en >> 8]; S.vs[rr] = VS[en >> 8];
    }
}
__device__ __forceinline__ void ud_compute(const UdTok& S, const LAS unsigned char* hrow, int base, int cnt, float hs, float g0, float g1, float* coefrow, int li, int gg) {
    const v4u h0 = *(const LAS v4u*)(hrow + 16 * li), h1 = *(const LAS v4u*)(hrow + 16 * li + 256), h2 = *(const LAS v4u*)(hrow + 16 * li + 512), h3 = *(const LAS v4u*)(hrow + 16 * li + 768);
    float d[UD_R];
#pragma unroll
    for (int rr = 0; rr < UD_R; ++rr) { d[rr] = 0.f; if (base + 4 * rr < cnt) {
        const int dsum = (dot16(S.u[rr][0], h0) + dot16(S.u[rr][1], h1)) + (dot16(S.u[rr][2], h2) + dot16(S.u[rr][3], h3));
        d[rr] = red16((float)dsum) * (hs * S.us[rr]); } }
    float d0 = d[0], d1 = d[1], d2 = d[2], d3 = d[3], d4 = d[4], v0 = S.vs[0], v1 = S.vs[1], v2 = S.vs[2], v3 = S.vs[3], v4 = S.vs[4]; unsigned n0 = S.ent[0], n1 = S.ent[1], n2 = S.ent[2], n3 = S.ent[3], n4 = S.ent[4];
    asm volatile("" : "+v"(d0), "+v"(d1), "+v"(d2), "+v"(d3), "+v"(d4), "+v"(v0), "+v"(v1), "+v"(v2), "+v"(v3), "+v"(v4), "+v"(n0), "+v"(n1), "+v"(n2), "+v"(n3), "+v"(n4));
    const bool s1 = li == 1, s2 = li == 2, s3 = li == 3, s4 = li == 4;
    float dd = s1 ? d1 : d0; dd = s2 ? d2 : dd; dd = s3 ? d3 : dd; dd = s4 ? d4 : dd;
    float vs = s1 ? v1 : v0; vs = s2 ? v2 : vs; vs = s3 ? v3 : vs; vs = s4 ? v4 : vs;
    unsigned en = s1 ? n1 : n0; en = s2 ? n2 : en; en = s3 ? n3 : en; en = s4 ? n4 : en;
    const float act = 0.5f * dd * (1.f + erff(dd * 0.70710678118654752f));
    const int slot = (int)(en & 255u);
    const float ga = __shfl(g0, slot & 63), gb = __shfl(g1, slot & 63); const float gate = slot < 64 ? ga : gb;
    if (li < UD_R && base + 4 * li + gg < cnt) coefrow[slot] = act * gate * vs;
}
__device__ __forceinline__ void ph_udot(Frame& F) {
    const int lane = F.lane, li = lane & 15, gg = lane >> 4, x = blockIdx.x & 7, jw = (int)(blockIdx.x >> 3) * NWAVES + F.wave, NJW = (F.G >> 3) * NWAVES;
    const int* PIDX = (const int*)(F.ws + WS_PIDX); const float* PGATE = (const float*)(F.ws + WS_PGATE);
    const unsigned char* U8 = (const unsigned char*)(F.ws + WS_U8); const unsigned char* H8 = (const unsigned char*)(F.ws + WS_H8);
    const float* US = (const float*)(F.ws + WS_US); const float* VS = (const float*)(F.ws + WS_VS); const float* HS = (const float*)(F.ws + WS_HS);
    float* COEF = (float*)(F.ws + WS_COEF);
    LAS unsigned* lstA = (LAS unsigned*)(F.lds + F.wave * 16384); LAS unsigned* lstB = lstA + 128;
    LAS unsigned char* hA = F.lds + F.wave * 16384 + 1024; LAS unsigned char* hB = hA + 1024;
    const int tpw = M / NJW, t_begin = jw * tpw, t_end = t_begin + tpw;
    int nA0, nA1, nB0, nB1; float nAg0, nAg1, nBg0, nBg1, nAhs, nBhs;
#define UD_LOAD(t_) do { const size_t o_ = (size_t)(t_) * 128; nA0 = PIDX[o_ + lane]; nA1 = PIDX[o_ + 64 + lane]; nAg0 = PGATE[o_ + lane]; nAg1 = PGATE[o_ + 64 + lane]; nAhs = HS[(t_)]; \
        nB0 = PIDX[o_ + 128 + lane]; nB1 = PIDX[o_ + 192 + lane]; nBg0 = PGATE[o_ + 128 + lane]; nBg1 = PGATE[o_ + 192 + lane]; nBhs = HS[(t_) + 1]; } while (0)
    UD_LOAD(t_begin);
    for (int t = t_begin; t < t_end; t += 2) {
        const int A0 = nA0, A1 = nA1, B0 = nB0, B1 = nB1; const float Ag0 = nAg0, Ag1 = nAg1, Bg0 = nBg0, Bg1 = nBg1, Ahs = nAhs, Bhs = nBhs;
        { const v4u nAh = *(const v4u*)(H8 + (size_t)t * 1024 + 16 * lane), nBh = *(const v4u*)(H8 + (size_t)(t + 1) * 1024 + 16 * lane); *(LAS v4u*)(hA + 16 * lane) = nAh; *(LAS v4u*)(hB + 16 * lane) = nBh; }
        if (t + 2 < t_end) UD_LOAD(t + 2);
        const int cntA = ud_compact(lstA, A0, A1, x, lane), cntB = ud_compact(lstB, B0, B1, x, lane);
        LDS_WAIT(); asm volatile("" ::: "memory");
        const int cmax = cntA > cntB ? cntA : cntB;
        for (int base = 0; base < cmax; base += 4 * UD_R) {
            UdTok SA, SB;
            ud_issue(SA, lstA, base, cntA, U8, US, VS, li, gg);
            ud_issue(SB, lstB, base, cntB, U8, US, VS, li, gg);
            ud_compute(SA, hA, base, cntA, Ahs, Ag0, Ag1, COEF + (size_t)t * 128, li, gg);
            ud_compute(SB, hB, base, cntB, Bhs, Bg0, Bg1, COEF + (size_t)(t + 1) * 128, li, gg);
        }
        LDS_WAIT(); asm volatile("" ::: "memory");
    }
#undef UD_LOAD
}

__device__ __forceinline__ void va_issue(v4u (&v)[16], v4u& cq, const LAS int* sI, const LAS unsigned char* sQ, const unsigned char* V8, int sub, int sg) {
    cq = *(const LAS v4u*)(sQ + sg * 16);
#pragma unroll
    for (int it = 0; it < 16; ++it) { const int e = sI[it * 8 + sg]; v[it] = *(const v4u*)(V8 + (size_t)e * 128 + 16 * sub); }
}
__device__ __forceinline__ void va_compute(const v4u (&v)[16], const v4u cq, float scale, bf16* yrow, int lane) {
    int acc[16];
#pragma unroll
    for (int i = 0; i < 16; ++i) acc[i] = 0;
    const unsigned cqa[4] = {cq.x, cq.y, cq.z, cq.w};
#pragma unroll
    for (int G = 0; G < 4; ++G) {
        const unsigned r0[4] = {v[4 * G].x, v[4 * G].y, v[4 * G].z, v[4 * G].w}, r1[4] = {v[4 * G + 1].x, v[4 * G + 1].y, v[4 * G + 1].z, v[4 * G + 1].w};
        const unsigned r2[4] = {v[4 * G + 2].x, v[4 * G + 2].y, v[4 * G + 2].z, v[4 * G + 2].w}, r3[4] = {v[4 * G + 3].x, v[4 * G + 3].y, v[4 * G + 3].z, v[4 * G + 3].w};
#pragma unroll
        for (int k = 0; k < 4; ++k) {
            const unsigned ablo = __builtin_amdgcn_perm(r1[k], r0[k], 0x05010400u), abhi = __builtin_amdgcn_perm(r1[k], r0[k], 0x07030602u);
            const unsigned cdlo = __builtin_amdgcn_perm(r3[k], r2[k], 0x05010400u), cdhi = __builtin_amdgcn_perm(r3[k], r2[k], 0x07030602u);
            const unsigned t0 = __builtin_amdgcn_perm(cdlo, ablo, 0x05040100u), t1 = __builtin_amdgcn_perm(cdlo, ablo, 0x07060302u);
            const unsigned t2 = __builtin_amdgcn_perm(cdhi, abhi, 0x05040100u), t3 = __builtin_amdgcn_perm(cdhi, abhi, 0x07060302u);
            acc[4 * k] = __builtin_amdgcn_sdot4((int)t0, (int)cqa[G], acc[4 * k], false); acc[4 * k + 1] = __builtin_amdgcn_sdot4((int)t1, (int)cqa[G], acc[4 * k + 1], false);
            acc[4 * k + 2] = __builtin_amdgcn_sdot4((int)t2, (int)cqa[G], acc[4 * k + 2], false); acc[4 * k + 3] = __builtin_amdgcn_sdot4((int)t3, (int)cqa[G], acc[4 * k + 3], false);
        }
    }
    int n8[8], n4[4], n2[2];
#pragma unroll
    for (int i = 0; i < 8; ++i) { auto r = __builtin_amdgcn_permlane32_swap((unsigned)acc[i], (unsigned)acc[i + 8], false, false); n8[i] = (int)r[0] + (int)r[1]; }
#pragma unroll
    for (int i = 0; i < 4; ++i) { auto r = __builtin_amdgcn_permlane16_swap((unsigned)n8[i], (unsigned)n8[i + 4], false, false); n4[i] = (int)r[0] + (int)r[1]; }
    const bool b3 = (lane & 8) != 0;
#pragma unroll
    for (int i = 0; i < 2; ++i) { const int send = b3 ? n4[i] : n4[i + 2], keep = b3 ? n4[i + 2] : n4[i];
        const int recv = __builtin_amdgcn_update_dpp(0, send, 0x128, 0xf, 0xf, false); n2[i] = keep + recv; }
    *(unsigned*)(yrow + 16 * (lane & 7) + 2 * (lane >> 3)) = pk2((float)n2[0] * scale, (float)n2[1] * scale);
}
__device__ __forceinline__ float va_stage(LAS int* sI, LAS unsigned char* sQ, int e0, int e1, float c0, float c1, int lane) {
    const float am = fmaxf(wave_max(fmaxf(fabsf(c0), fabsf(c1))), 1e-30f), inv = 127.f / am;
    sI[lane] = e0; sI[lane + 64] = e1;
    sQ[(lane & 7) * 16 + (lane >> 3)] = (unsigned char)((int)rintf(c0 * inv) & 0xff); sQ[(lane & 7) * 16 + 8 + (lane >> 3)] = (unsigned char)((int)rintf(c1 * inv) & 0xff);
    return am * (1.f / 127.f);
}
__device__ __forceinline__ void ph_vacc(Frame& F) {
    const int lane = F.lane, x = blockIdx.x & 7, jw = (int)(blockIdx.x >> 3) * NWAVES + F.wave, NJW = (F.G >> 3) * NWAVES;
    const int* PIDX = (const int*)(F.ws + WS_PIDX); const float* COEF = (const float*)(F.ws + WS_COEF);
    const unsigned char* V8 = (const unsigned char*)(F.ws + WS_V8) + (size_t)x * 16384 * 128;
    bf16* YS = (bf16*)(F.ws + WS_YS);
    LAS int* sIA = (LAS int*)(F.lds + F.wave * 16384); LAS unsigned char* sQA = (LAS unsigned char*)(F.lds + F.wave * 16384 + 512);
    LAS int* sIB = (LAS int*)(F.lds + F.wave * 16384 + 1024); LAS unsigned char* sQB = (LAS unsigned char*)(F.lds + F.wave * 16384 + 1536);
    const int tpw = M / NJW, t_begin = jw * tpw, t_end = t_begin + tpw;
    const int sub = lane & 7, sg = lane >> 3;
    int nA0, nA1, nB0, nB1; float nAc0, nAc1, nBc0, nBc1;
#define VA_LOAD(t_) do { const size_t o_ = (size_t)(t_) * 128; nA0 = PIDX[o_ + lane]; nA1 = PIDX[o_ + 64 + lane]; nAc0 = COEF[o_ + lane]; nAc1 = COEF[o_ + 64 + lane]; \
        nB0 = PIDX[o_ + 128 + lane]; nB1 = PIDX[o_ + 192 + lane]; nBc0 = COEF[o_ + 128 + lane]; nBc1 = COEF[o_ + 192 + lane]; } while (0)
    VA_LOAD(t_begin);
    for (int t = t_begin; t < t_end; t += 2) {
        const float scA = va_stage(sIA, sQA, nA0, nA1, nAc0, nAc1, lane), scB = va_stage(sIB, sQB, nB0, nB1, nBc0, nBc1, lane);
        if (t + 2 < t_end) VA_LOAD(t + 2);
        LDS_WAIT(); asm volatile("" ::: "memory");
        v4u vA[16], vB[16], qA, qB;
        va_issue(vA, qA, sIA, sQA, V8, sub, sg);
        va_issue(vB, qB, sIB, sQB, V8, sub, sg);
        va_compute(vA, qA, scA, YS + (size_t)t * D + 128 * x, lane);
        va_compute(vB, qB, scB, YS + (size_t)(t + 1) * D + 128 * x, lane);
        LDS_WAIT(); asm volatile("" ::: "memory");
    }
#undef VA_LOAD
}

__device__ __forceinline__ void ph_ln2(Frame& F) {
    const int gw = F.vcu * NWAVES + F.wave, NGW = F.G * NWAVES, lane = F.lane;
    const float* modp = (const float*)(F.ws + WS_MOD); const bf16* YS = (const bf16*)(F.ws + WS_YS);
    const float* lng = F.in[24]; const float* lnb = F.in[25];
    const int rpw = M / NGW, m_begin = gw * rpw, m_end = m_begin + rpw;
    const float* md = modp + (m_begin >> 11) * 6144 + 5120;
    f32x4 gt[4], gg[4], bb[4];
#pragma unroll
    for (int j = 0; j < 4; ++j) { const int col = 4 * lane + 256 * j; gt[j] = *(const f32x4*)(md + col); gg[j] = *(const f32x4*)(lng + col); bb[j] = *(const f32x4*)(lnb + col); }
    f32x4 xn[4]; v2u yn[4];
#define LN2_LOAD(m_) do { const float* x_ = F.out + (size_t)(m_) * D; const bf16* y_ = YS + (size_t)(m_) * D; \
        _Pragma("unroll") for (int j = 0; j < 4; ++j) { xn[j] = *(const f32x4*)(x_ + 4 * lane + 256 * j); yn[j] = *(const v2u*)(y_ + 4 * lane + 256 * j); } } while (0)
    LN2_LOAD(m_begin);
    for (int m = m_begin; m < m_end; ++m) {
        f32x4 v[4]; float s = 0.f;
#pragma unroll
        for (int j = 0; j < 4; ++j) { const f32x4 yv = (f32x4){bflo(yn[j].x), bfhi(yn[j].x), bflo(yn[j].y), bfhi(yn[j].y)}; v[j] = xn[j] * ALPHA + gt[j] * yv; s += (v[j].x + v[j].y) + (v[j].z + v[j].w); }
        if (m + 1 < m_end) LN2_LOAD(m + 1);
        const float mean = wave_sum_f(s) * (1.f / D); float s2 = 0.f;
#pragma unroll
        for (int j = 0; j < 4; ++j) { v[j] = v[j] - mean; s2 += (v[j].x * v[j].x + v[j].y * v[j].y) + (v[j].z * v[j].z + v[j].w * v[j].w); }
        const float rstd = rsqrtf(wave_sum_f(s2) * (1.f / D) + LN_EPS);
#pragma unroll
        for (int j = 0; j < 4; ++j) *(f32x4*)(F.out + (size_t)m * D + 4 * lane + 256 * j) = (v[j] * rstd) * gg[j] + bb[j];
    }
#undef LN2_LOAD
}

struct Args { const float* in[26]; float* out; unsigned char* ws; int ph_lo, ph_hi, li, pad; };
__global__ void __launch_bounds__(NWAVES * 64, 2) hymba_fwd(Args args) {
    extern __shared__ __attribute__((aligned(16))) unsigned char lds[];
    Frame F;
    F.lds = (LAS unsigned char*)lds;
    F.MISC = (volatile LAS unsigned*)(F.lds + MISC_OFF);
    F.tid = threadIdx.x; F.lane = F.tid & 63; F.wave = __builtin_amdgcn_readfirstlane(F.tid >> 6);
    F.G = gridDim.x; { const int bx = blockIdx.x; F.vcu = (F.G % 8 == 0) ? (bx % 8) * (F.G / 8) + bx / 8 : bx; }
    F.ws = args.ws; F.out = args.out; F.ctl = (gu32*)(args.ws + WS_CTL);
#pragma unroll
    for (int i = 0; i < 26; ++i) F.in[i] = args.in[i];
    for (int u = F.tid; u < (LDS_BYTES - LDSCTL_OFF) / 4; u += NWAVES * 64) ((LAS unsigned*)(F.lds + LDSCTL_OFF))[u] = 0u;
    __syncthreads();
    XcdBarrier bar; bar.bar = (unsigned*)(F.ctl + CW_BAR); bar.x = 0; bar.st = nullptr;
    if (N_LAUNCHES == 1) bar = xcd_barrier_post((unsigned*)(F.ctl + CW_BAR), F.MISC + 8);
#define GRID_BAR() do { if (N_LAUNCHES == 1) xcd_barrier(bar); } while (0)
    const int lo = args.ph_lo, hi = args.ph_hi;
#ifndef PHMASK
#define PHMASK 0x1fff
#endif
#define IN(k) (((PHMASK >> (k)) & 1) && lo <= (k) && (k) < hi)
#define REP(k) for (int rep_ = 0; rep_ < 1 + ((DBLMASK >> (k)) & 1); ++rep_)
#define BOTH(k) (IN(k) && IN((k) + 1))
    bf16* WinT = (bf16*)(F.ws + WS_WIN); bf16* WoutT = (bf16*)(F.ws + WS_WOUT); bf16* WpT = (bf16*)(F.ws + WS_WP);
    bf16* HB = (bf16*)(F.ws + WS_H); bf16* PROJ = (bf16*)(F.ws + WS_PROJ); bf16* MIX = (bf16*)F.out; bf16* Y1 = (bf16*)(F.ws + WS_Y1); float* SCp = (float*)(F.ws + WS_SC);

    if (IN(0)) REP(0) { ph_mod(F); if (BOTH(0)) GRID_BAR(); }
    if (IN(1)) REP(1) { ph_prologue(F); if (BOTH(1)) GRID_BAR(); }
    if (IN(2)) REP(2) {
        pg8::Gemm g{HB, WinT, M, IN_COLS, D}; pg8::StaticOrder S; S.init(M, IN_COLS, F.G, (int)blockIdx.x);
        pg8::EpiBf16<0> E{PROJ, IN_COLS, nullptr, 0, 0, 1.f};
        pg8::gemm_phase<pg8::EpiBf16<0>, pg8::StaticOrder, true, true>(F.lds + RING_OFF, g, S, E);
        if (BOTH(2)) GRID_BAR();
    }
    if (IN(3)) {
#ifndef NO_ATTN
        for (int rep_ = 0; rep_ < 1 + ((DBLMASK >> 13) & 1); ++rep_) ph_attn(F);
#endif
        for (int rep_ = 0; rep_ < 1 + ((DBLMASK >> 14) & 1); ++rep_) ph_prep(F);
        if (BOTH(3)) GRID_BAR();
    }
    if (IN(4)) REP(4) { ph_scan(F); if (BOTH(4)) GRID_BAR(); }
    if (IN(5)) REP(5) { ph_post(F); if (BOTH(5)) GRID_BAR(); }
    if (IN(6)) REP(6) {
        pg8::Gemm g{MIX, WoutT, M, D, D}; pg8::StaticOrder S; S.init(M, D, F.G, (int)blockIdx.x);
        pg8::EpiBf16<0> E{Y1, D, nullptr, 0, 0, 1.f};
        pg8::gemm_phase<pg8::EpiBf16<0>, pg8::StaticOrder, true, true>(F.lds + RING_OFF, g, S, E);
        if (BOTH(6)) GRID_BAR();
    }
    if (IN(7)) REP(7) { ph_ln1(F); if (BOTH(7)) GRID_BAR(); }
    if (IN(8)) REP(8) {
        pg8::Gemm g{HB, WpT, M, NSC, D}; pg8::StaticOrder S; S.init(M, NSC, F.G, (int)blockIdx.x);
        pg8::EpiBf16<0> E{(bf16*)SCp, NSC, nullptr, 0, 0, 1.f};
        pg8::gemm_phase<pg8::EpiBf16<0>, pg8::StaticOrder, true, true>(F.lds + RING_OFF, g, S, E);
        if (BOTH(8)) GRID_BAR();
    }
    if (IN(9)) REP(9) { ph_topk(F); if (BOTH(9)) GRID_BAR(); }
    if (IN(10)) REP(10) { ph_udot(F); if (BOTH(10)) GRID_BAR(); }
    if (IN(11)) REP(11) { ph_vacc(F); if (BOTH(11)) GRID_BAR(); }
    if (IN(12)) { ph_ln2(F); }
#undef IN
#undef BOTH
#undef GRID_BAR
}

extern "C" void kernel_launch(void* const* d_in, const int* in_sizes, int n_in, void* d_out, int out_size, void* d_ws, size_t ws_size, hipStream_t stream) {
    static int grid = 0;
    if (grid == 0) {
        if (n_in != 26 || in_sizes[0] != M * D || out_size != M * D || ws_size < WS_END) { fprintf(stderr, "kernel_launch: unexpected shapes (n_in %d, in0 %d, out %d, ws %zu); nothing launched\n", n_in, n_in > 0 ? in_sizes[0] : -1, out_size, ws_size); grid = -1; return; }
        int dev = 0, cus = 0, per_cu = 0;
        if (hipGetDevice(&dev) != hipSuccess || hipDeviceGetAttribute(&cus, hipDeviceAttributeMultiprocessorCount, dev) != hipSuccess) { fprintf(stderr, "kernel_launch: device query failed\n"); grid = -1; return; }
        if (hipFuncSetAttribute((const void*)hymba_fwd, hipFuncAttributeMaxDynamicSharedMemorySize, LDS_BYTES) != hipSuccess) { fprintf(stderr, "kernel_launch: hipFuncSetAttribute failed\n"); grid = -1; return; }
        if (hipOccupancyMaxActiveBlocksPerMultiprocessor(&per_cu, (const void*)hymba_fwd, NWAVES * 64, LDS_BYTES) != hipSuccess || per_cu < 1)
            fprintf(stderr, "kernel_launch: note: occupancy query reports %d workgroups per CU\n", per_cu);
        (void)hipGetLastError();
        grid = cus;
    }
    if (grid < 0) return;
    if (hipMemsetAsync((char*)d_ws + WS_CTL, 0, CTL_ZERO_BYTES, stream) != hipSuccess) { fprintf(stderr, "kernel_launch: memset failed\n"); return; }
    Args a{};
    for (int i = 0; i < 26; ++i) a.in[i] = (const float*)d_in[i];
    a.out = (float*)d_out; a.ws = (unsigned char*)d_ws;
    for (int li = 0; li < N_LAUNCHES; ++li) {
        a.ph_lo = (N_LAUNCHES == 1) ? 0 : li; a.ph_hi = (N_LAUNCHES == 1) ? N_PHASES : li + 1; a.li = li;
        hipLaunchKernelGGL(hymba_fwd, dim3(grid), dim3(NWAVES * 64), LDS_BYTES, stream, a);
        const hipError_t le = hipPeekAtLastError();
        if (le != hipSuccess) { fprintf(stderr, "kernel_launch: launch %d failed: %s\n", li, hipGetErrorName(le)); break; }
    }
}
```

```cpp
#include <hip/hip_runtime.h>
#ifndef DBLMASK
#define DBLMASK 0
#endif
#include <cstdio>
#include <cstdint>
#include <cmath>
namespace pg8 {
#define PG8_LAS __attribute__((address_space(3)))
typedef unsigned short bf16_t;
typedef short bf16x8 __attribute__((ext_vector_type(8)));
typedef float f32x4 __attribute__((ext_vector_type(4)));
typedef unsigned u32x4 __attribute__((ext_vector_type(4)));
constexpr int BM = 256, BK = 64, HALF = 128, HTB = HALF * BK * 2  , STAGE_BYTES = 8 * HTB, NXCD = 8, WGM = 8;

__host__ __device__ __forceinline__ int lds_byte(int r, int c) { const int st = (r >> 4) * 2 + (c >> 5), rr = r & 15, cc = c & 31, ob = rr * 64 + cc * 2; return st * 1024 + (ob ^ (((ob >> 9) & 1) << 5)); }
__host__ __device__ __forceinline__ void stage_rc(int b, int& R, int& C) { const int st = b / 1024, sb = b % 1024, swz = sb ^ (((sb >> 9) & 1) << 5); R = (st >> 1) * 16 + swz / 64; C = (st & 1) * 32 + (swz % 64) / 2; }
__host__ __device__ __forceinline__ int perm32(int rho) { const int n = rho >> 4, i = rho & 15; return 8 * (i >> 2) + 4 * n + (i & 3); }

struct Unit { int pm, pn; };
struct Gemm { const bf16_t* A; const bf16_t* Bt; int M, N, K; };

struct StaticOrder {
    int nM, nN, nwg, G, c;
    __host__ __device__ void init(int M, int N, int G_, int c_) { nM = M / BM; nN = N / BM; nwg = nM * nN; G = G_; c = c_; }
    __host__ __device__ bool next(int i, Unit& u) const {
        const long L = (long)i * G + c; if (L >= nwg) return false;
        int wgid = (int)L; { const int q = nwg / NXCD, r = nwg % NXCD, xcd = wgid % NXCD, off = wgid / NXCD; wgid = (xcd < r ? xcd * (q + 1) : r * (q + 1) + (xcd - r) * q) + off; }
        const int nig = WGM * nN, gid = wgid / nig, fm = gid * WGM, gsz = (nM - fm) < WGM ? (nM - fm) : WGM;
        u.pm = fm + ((wgid % nig) % gsz); u.pn = (wgid % nig) / gsz; return true;
    }
    __device__ __forceinline__ void a_ready(const Unit&) const {}
    __device__ __forceinline__ void done(const Unit&) const {}
};

__device__ __forceinline__ unsigned cvt_pk_bf16(float lo, float hi) { unsigned r; asm volatile("v_cvt_pk_bf16_f32 %0, %1, %2" : "=v"(r) : "v"(lo), "v"(hi)); return r; }
typedef float f32x2 __attribute__((ext_vector_type(2)));
__device__ __forceinline__ f32x2 gelu_pk(f32x2 v) {
    const f32x2 av = __builtin_elementwise_abs(v), d = av * 0.2316418882f + 1.0f;
    f32x2 t; t.x = __builtin_amdgcn_rcpf(d.x); t.y = __builtin_amdgcn_rcpf(d.y);
    f32x2 q = t * 0.5307027145f + (-0.7265760135f); q = q * t + 0.7107068705f; q = q * t + (-0.142248368f); q = q * t + 0.127414796f; q = q * t;
    const f32x2 s = (v * v) * (-0.72134752044f);
    f32x2 e; e.x = __builtin_amdgcn_exp2f(s.x); e.y = __builtin_amdgcn_exp2f(s.y);
    const f32x2 m = v * (q * e), r = v - m;
    f32x2 o; o.x = v.x < 0.f ? m.x : r.x; o.y = v.y < 0.f ? m.y : r.y; return o;
}

template <int ACT  > struct EpiBf16 {
    static constexpr bool PERM = true, AFTER_DRAIN = false; static_assert(ACT == 0 || ACT == 1, "EpiBf16: ACT is 0 (none) or 1 (gelu_pk)");
    bf16_t* O; int ldc; const float* bias; int split_cols; size_t split_stride; float scale0;
    __device__ __forceinline__ void operator()(const f32x4 (&acc)[2][2][4][2], const Unit& u, int wr, int wc, int fr, int fq) const {
        const int row0 = u.pm * BM + wr * 64 + fr; int colt = u.pn * BM; bf16_t* base = O;
        float sc = 1.f; if (split_cols) { const int t = colt / split_cols; base += (size_t)t * split_stride; colt -= t * split_cols; if (t == 0) sc = scale0; }
        const int col0 = colt + wc * 32 + 8 * fq, bcol0 = u.pn * BM + wc * 32 + 8 * fq;
        f32x4 bv[2][2];
#pragma unroll
        for (int bj = 0; bj < 2; ++bj)
#pragma unroll
            for (int n = 0; n < 2; ++n) bv[bj][n] = bias ? *(const f32x4*)(bias + bcol0 + bj * HALF + 4 * n) : (f32x4){0.f, 0.f, 0.f, 0.f};
#pragma unroll
        for (int ai = 0; ai < 2; ++ai)
#pragma unroll
            for (int m = 0; m < 4; ++m) { bf16_t* rowp = base + (size_t)(row0 + ai * HALF + m * 16) * ldc + col0;
#pragma unroll
                for (int bj = 0; bj < 2; ++bj) { f32x4 v0 = acc[ai][bj][m][0] + bv[bj][0], v1 = acc[ai][bj][m][1] + bv[bj][1];
                    if (ACT == 1) { f32x2 a = gelu_pk((f32x2){v0[0], v0[1]}), b = gelu_pk((f32x2){v0[2], v0[3]}), c = gelu_pk((f32x2){v1[0], v1[1]}), d = gelu_pk((f32x2){v1[2], v1[3]});
                        v0 = (f32x4){a.x, a.y, b.x, b.y}; v1 = (f32x4){c.x, c.y, d.x, d.y}; }
                    v0 = v0 * sc; v1 = v1 * sc; u32x4 w; w.x = cvt_pk_bf16(v0[0], v0[1]); w.y = cvt_pk_bf16(v0[2], v0[3]); w.z = cvt_pk_bf16(v1[0], v1[1]); w.w = cvt_pk_bf16(v1[2], v1[3]);
                    *(u32x4*)(rowp + bj * HALF) = w; } }
    }
};
struct EpiF32 {
    static constexpr bool PERM = false, AFTER_DRAIN = false;
    float* C; int ldc; const float* bias;
    __device__ __forceinline__ void operator()(const f32x4 (&acc)[2][2][4][2], const Unit& u, int wr, int wc, int fr, int fq) const {
        const int row0 = u.pm * BM + wr * 64 + fr, col0 = u.pn * BM + wc * 32 + 4 * fq;
        f32x4 bv[2][2];
#pragma unroll
        for (int bj = 0; bj < 2; ++bj)
#pragma unroll
            for (int n = 0; n < 2; ++n) bv[bj][n] = bias ? *(const f32x4*)(bias + col0 + bj * HALF + n * 16) : (f32x4){0.f, 0.f, 0.f, 0.f};
#pragma unroll
        for (int ai = 0; ai < 2; ++ai)
#pragma unroll
            for (int m = 0; m < 4; ++m) { float* rowp = C + (size_t)(row0 + ai * HALF + m * 16) * ldc + col0;
#pragma unroll
                for (int bj = 0; bj < 2; ++bj)
#pragma unroll
                    for (int n = 0; n < 2; ++n) *(f32x4*)(rowp + bj * HALF + n * 16) = acc[ai][bj][m][n] + bv[bj][n]; }
    }
};
template <class Epi, class Sched, bool ALIGN_EPI = false, bool SP2 = false>
__device__ __forceinline__ void gemm_phase(PG8_LAS unsigned char* lds, const Gemm g, const Sched& S, const Epi& E) {
    const int tid = threadIdx.x, wid = __builtin_amdgcn_readfirstlane(tid >> 6), lane = tid & 63, wr = wid >> 2, wc = wid & 3, fr = lane & 15, fq = lane >> 4;
    const int K = g.K, nt = K / BK;
    unsigned voffA[2], voffB[2];
#pragma unroll
    for (int i = 0; i < 2; ++i) { int R, C; stage_rc(tid * 16 + i * 8192, R, C); const int Rb = Epi::PERM ? ((R & ~31) + perm32(R & 31)) : R;
        voffA[i] = (unsigned)(R * K + C) * 2u; voffB[i] = (unsigned)(Rb * K + C) * 2u; }
    const size_t kstep = (size_t)(BK * 2);
    const size_t hstep = (size_t)HALF * K * 2;
    const size_t tstep = 2 * hstep;
    const unsigned ldsw = (unsigned)wid * 1024u;
    const int aoff = lds_byte(wr * 64 + fr, fq * 8), boff = lds_byte(wc * 32 + fr, fq * 8);
#define PG8_SA(b, h) (((b) * 2 + (h)) * HTB)
#define PG8_SB(b, h) ((4 + (b) * 2 + (h)) * HTB)
#define PG8_STAGE(bufoff, gbase, voff) do { _Pragma("unroll") for (int _i = 0; _i < 2; ++_i) \
        __builtin_amdgcn_global_load_lds((const unsigned*)((const char*)(gbase) + (voff)[_i]), (PG8_LAS unsigned*)(lds + (bufoff) + ldsw + _i * 8192), 16, 0, 0); } while (0)
#define PG8_LDA(dst, b, h) do { _Pragma("unroll") for (int m = 0; m < 4; ++m) _Pragma("unroll") for (int k = 0; k < 2; ++k) dst[m][k] = *(const PG8_LAS bf16x8*)(lds + PG8_SA(b, h) + aoff + m * 2048 + k * 1024); } while (0)
#define PG8_LDB(dst, b, h) do { _Pragma("unroll") for (int n = 0; n < 2; ++n) _Pragma("unroll") for (int k = 0; k < 2; ++k) dst[n][k] = *(const PG8_LAS bf16x8*)(lds + PG8_SB(b, h) + boff + n * 2048 + k * 1024); } while (0)
#define PG8_MMA(ai, bj, At, Bt) do { __builtin_amdgcn_s_setprio(1); _Pragma("unroll") for (int m = 0; m < 4; ++m) _Pragma("unroll") for (int n = 0; n < 2; ++n) _Pragma("unroll") for (int k = 0; k < 2; ++k) \
        acc[ai][bj][m][n] = __builtin_amdgcn_mfma_f32_16x16x32_bf16(Bt[n][k], At[m][k], acc[ai][bj][m][n], 0, 0, 0); __builtin_amdgcn_s_setprio(0); } while (0)
#define PG8_WAIT_V(n) asm volatile("s_waitcnt vmcnt(" #n ")" ::: "memory")
#define PG8_WAIT_L(n) asm volatile("s_waitcnt lgkmcnt(" #n ")" ::: "memory")
#define PG8_BAR __builtin_amdgcn_s_barrier()
#define PG8_SCHED __builtin_amdgcn_sched_barrier(0)
    Unit cur, nxt; int ui = 0;
    if (!S.next(0, cur)) return;
    f32x4 acc[2][2][4][2];
#pragma unroll
    for (int a = 0; a < 2; ++a)
#pragma unroll
        for (int b = 0; b < 2; ++b)
#pragma unroll
            for (int m = 0; m < 4; ++m)
#pragma unroll
                for (int n = 0; n < 2; ++n) acc[a][b][m][n] = (f32x4){0.f, 0.f, 0.f, 0.f};
    bf16x8 At[4][2], B0[2][2], B1[2][2];
    const char* cA = (const char*)g.A + (size_t)cur.pm * tstep; const char* cB = (const char*)g.Bt + (size_t)cur.pn * tstep;
    S.a_ready(cur);
    if constexpr (SP2) {
        PG8_STAGE(PG8_SB(0, 0), cB, voffB); PG8_STAGE(PG8_SB(0, 1), cB + hstep, voffB); PG8_STAGE(PG8_SA(0, 0), cA, voffA); PG8_STAGE(PG8_SA(0, 1), cA + hstep, voffA);
        if (wr == 1) PG8_BAR;
        PG8_WAIT_V(2); PG8_BAR;
        PG8_STAGE(PG8_SB(1, 0), cB + kstep, voffB); PG8_STAGE(PG8_SA(1, 0), cA + kstep, voffA); PG8_STAGE(PG8_SB(1, 1), cB + hstep + kstep, voffB);
        PG8_WAIT_V(6); PG8_BAR;
    } else {
        PG8_STAGE(PG8_SB(0, 0), cB, voffB); PG8_STAGE(PG8_SA(0, 0), cA, voffA); PG8_STAGE(PG8_SB(0, 1), cB + hstep, voffB); PG8_STAGE(PG8_SA(0, 1), cA + hstep, voffA);
        if (wr == 1) PG8_BAR;
        PG8_WAIT_V(4); PG8_BAR;
        PG8_STAGE(PG8_SB(1, 0), cB + kstep, voffB); PG8_STAGE(PG8_SA(1, 0), cA + kstep, voffA); PG8_STAGE(PG8_SB(1, 1), cB + hstep + kstep, voffB);
        PG8_WAIT_V(6); PG8_BAR;
    }
    for (;;) {
        const bool has_next = S.next(ui + 1, nxt);
        const char* nA = has_next ? (const char*)g.A + (size_t)nxt.pm * tstep : cA; const char* nB = has_next ? (const char*)g.Bt + (size_t)nxt.pn * tstep : cB;
        for (int t = 0; t < nt; t += 2) {
            const bool last = (t == nt - 2);
            const char* a1 = cA + (size_t)(t + 1) * kstep;
            const char* a2 = last ? nA : cA + (size_t)(t + 2) * kstep; const char* b2 = last ? nB : cB + (size_t)(t + 2) * kstep;
            const char* a3 = a2 + kstep; const char* b3 = b2 + kstep;
            if (last && has_next) S.a_ready(nxt);
            if constexpr (SP2) {
            PG8_LDB(B0, 0, 0); PG8_LDB(B1, 0, 1); PG8_SCHED; PG8_LDA(At, 0, 0); PG8_STAGE(PG8_SA(1, 1), a1 + hstep, voffA);
            PG8_WAIT_V(8); PG8_WAIT_L(0); PG8_BAR; PG8_MMA(0, 0, At, B0); PG8_MMA(0, 1, At, B1); PG8_BAR; PG8_SCHED;
            PG8_LDA(At, 0, 1); PG8_STAGE(PG8_SB(0, 0), b2, voffB); PG8_STAGE(PG8_SB(0, 1), b2 + hstep, voffB); PG8_STAGE(PG8_SA(0, 0), a2, voffA);
            PG8_WAIT_V(8); PG8_WAIT_L(0); PG8_BAR; PG8_MMA(1, 0, At, B0); PG8_MMA(1, 1, At, B1); PG8_BAR; PG8_SCHED;
            PG8_LDB(B0, 1, 0); PG8_LDB(B1, 1, 1); PG8_SCHED; PG8_LDA(At, 1, 0); PG8_STAGE(PG8_SA(0, 1), a2 + hstep, voffA);
            PG8_WAIT_V(8); PG8_WAIT_L(0); PG8_BAR; PG8_MMA(0, 0, At, B0); PG8_MMA(0, 1, At, B1); PG8_BAR; PG8_SCHED;
            PG8_LDA(At, 1, 1); PG8_STAGE(PG8_SB(1, 0), b3, voffB); PG8_STAGE(PG8_SB(1, 1), b3 + hstep, voffB); PG8_STAGE(PG8_SA(1, 0), a3, voffA);
            PG8_WAIT_V(8); PG8_WAIT_L(0); PG8_BAR; PG8_MMA(1, 0, At, B0); PG8_MMA(1, 1, At, B1); PG8_BAR; PG8_SCHED;
            } else {
            PG8_LDB(B0, 0, 0); PG8_SCHED; PG8_LDA(At, 0, 0); PG8_STAGE(PG8_SA(1, 1), a1 + hstep, voffA);
            PG8_WAIT_L(8); PG8_BAR; PG8_WAIT_L(0); PG8_MMA(0, 0, At, B0); PG8_BAR; PG8_SCHED;
            PG8_LDB(B1, 0, 1); PG8_STAGE(PG8_SB(0, 0), b2, voffB);
            PG8_BAR; PG8_WAIT_L(0); PG8_MMA(0, 1, At, B1); PG8_BAR;
            PG8_LDA(At, 0, 1); PG8_STAGE(PG8_SA(0, 0), a2, voffA);
            PG8_BAR; PG8_WAIT_L(0); PG8_MMA(1, 0, At, B0); PG8_BAR; PG8_SCHED;
            PG8_STAGE(PG8_SB(0, 1), b2 + hstep, voffB);
            PG8_WAIT_V(6); PG8_BAR; PG8_MMA(1, 1, At, B1); PG8_BAR;
            PG8_LDB(B0, 1, 0); PG8_SCHED; PG8_LDA(At, 1, 0); PG8_STAGE(PG8_SA(0, 1), a2 + hstep, voffA);
            PG8_WAIT_L(8); PG8_BAR; PG8_WAIT_L(0); PG8_MMA(0, 0, At, B0); PG8_BAR; PG8_SCHED;
            PG8_LDB(B1, 1, 1); PG8_STAGE(PG8_SB(1, 0), b3, voffB);
            PG8_BAR; PG8_WAIT_L(0); PG8_MMA(0, 1, At, B1); PG8_BAR;
            PG8_LDA(At, 1, 1); PG8_STAGE(PG8_SA(1, 0), a3, voffA);
            PG8_BAR; PG8_WAIT_L(0); PG8_MMA(1, 0, At, B0); PG8_BAR; PG8_SCHED;
            PG8_STAGE(PG8_SB(1, 1), b3 + hstep, voffB);
            PG8_WAIT_V(6); PG8_BAR; PG8_MMA(1, 1, At, B1); PG8_BAR;
            }
        }
        if constexpr (ALIGN_EPI) { if (wr == 0) PG8_BAR; }
        if constexpr (!Epi::AFTER_DRAIN) { E(acc, cur, wr, wc, fr, fq); S.done(cur); }
        if (!has_next) break;
#pragma unroll
        for (int a = 0; a < 2; ++a)
#pragma unroll
            for (int b = 0; b < 2; ++b)
#pragma unroll
                for (int m = 0; m < 4; ++m)
#pragma unroll
                    for (int n = 0; n < 2; ++n) acc[a][b][m][n] = (f32x4){0.f, 0.f, 0.f, 0.f};
        cur = nxt; cA = nA; cB = nB; ++ui;
        if constexpr (ALIGN_EPI) { if (wr == 1) PG8_BAR; }
    }
    PG8_WAIT_V(0);
    if constexpr (!ALIGN_EPI) { if (wr == 0) PG8_BAR; }
    PG8_BAR;
    if constexpr (Epi::AFTER_DRAIN) { E.fused(acc, cur, wr, wc, fr, fq, lds, wid, lane); S.done(cur); }
#undef PG8_SA
#undef PG8_SB
#undef PG8_STAGE
#undef PG8_LDA
#undef PG8_LDB
#undef PG8_MMA
#undef PG8_WAIT_V
#undef PG8_WAIT_L
#undef PG8_BAR
#undef PG8_SCHED
}
}

#ifndef PG8_SP2
#define PG8_SP2 true
#endif

constexpr int NWAVES = 8;
#ifndef MK_N_LAUNCHES
#define MK_N_LAUNCHES 1
#endif
constexpr int N_PHASES = 13;
constexpr int N_LAUNCHES = MK_N_LAUNCHES;

constexpr int BATCH = 16, SEQ = 2048, D = 1024, M = BATCH * SEQ;
constexpr int IN_COLS = 2560;
constexpr int C_Q = 0, C_K = 512, C_V = 640, C_RW = 768;
constexpr int RW_R = 0, RW_K = 512, RW_V = 1024, RW_WD = 1536, RW_AD = 1600, RW_GD = 1664;
constexpr int NSC = 2048;
constexpr float LN_EPS = 1e-5f, GN_EPS = 64e-5f;
constexpr float ALPHA = 1.189207115002721f;

constexpr size_t MiB = 1u << 20;
constexpr size_t WS_CTL = 0, CTL_ZERO_BYTES = 1 * MiB;
constexpr size_t WS_WIN = 1 * MiB;
constexpr size_t WS_WOUT = 6 * MiB;
constexpr size_t WS_WP = 8 * MiB;
constexpr size_t WS_MOD = 12 * MiB;
constexpr size_t WS_FRAG = 13 * MiB;
constexpr size_t WS_H = 16 * MiB;
constexpr size_t WS_PROJ = 80 * MiB;
constexpr size_t WS_YB = 16 * MiB;
constexpr size_t WS_G = 48 * MiB;
constexpr size_t WS_DOTRK = 14 * MiB;
constexpr size_t WS_REC = 240 * MiB;
constexpr size_t WS_Y1 = 336 * MiB;
constexpr size_t WS_U8 = 448 * MiB;
constexpr size_t WS_V8 = 464 * MiB;
constexpr size_t WS_H8 = 240 * MiB;
constexpr size_t WS_US = 13 * MiB + 512 * 1024, WS_VS = WS_US + 65536, WS_HS = WS_US + 262144;
constexpr size_t WS_COEF = 304 * MiB;
constexpr size_t WS_YS = 80 * MiB;
constexpr size_t WS_SC = 80 * MiB;
constexpr size_t WS_PIDX = 272 * MiB;
constexpr size_t WS_PGATE = 288 * MiB;
constexpr size_t WS_END = 512 * MiB;

constexpr int CW_TMO = 0, CW_CODE = 1;
constexpr int CW_BAR = 4096;

constexpr int RING_OFF = 0, RING_BYTES = 131072;
constexpr int LDSCTL_OFF = RING_BYTES, MISC_OFF = LDSCTL_OFF + 320;
constexpr int LDS_BYTES = 147456;
#define GAS __attribute__((address_space(1)))
#define LAS __attribute__((address_space(3)))
typedef unsigned short bf16;
typedef unsigned v4u __attribute__((ext_vector_type(4)));
typedef float f32x4 __attribute__((ext_vector_type(4)));
typedef short bf16x8 __attribute__((ext_vector_type(8)));
typedef GAS unsigned gu32;
typedef GAS unsigned long long gu64;
#define RLX_AGENT __ATOMIC_RELAXED, __HIP_MEMORY_SCOPE_AGENT
#define LDS_WAIT() asm volatile("s_waitcnt lgkmcnt(0)" ::: "memory")
#define VM_WAIT() asm volatile("s_waitcnt vmcnt(0)" ::: "memory")
__device__ __forceinline__ unsigned long long rt() { return __builtin_amdgcn_s_memrealtime(); }
typedef float f32x2_t_ __attribute__((ext_vector_type(2))); typedef __bf16 bf16x2_t_ __attribute__((ext_vector_type(2)));
__device__ __forceinline__ unsigned f2bf(float f) { return (unsigned)__builtin_bit_cast(unsigned short, (__bf16)f); }
__device__ __forceinline__ unsigned pk2(float lo, float hi) { const f32x2_t_ v = {lo, hi}; return __builtin_bit_cast(unsigned, __builtin_convertvector(v, bf16x2_t_)); }

#define XB_TMO      128
#define XB_XCNT(j)  (256  + 64 * (j))
#define XB_XSUB(j)  (1280 + 64 * (j))
#define XB_XGEN(j)  (2304 + 64 * (j))
#define XB_TOP      3328
#define XB_TOPGEN   3392
#define XCD_BAR_WORDS 3456
#define XB_SPIN_CAP (1u << 18)

__device__ __forceinline__ unsigned xb_ld(unsigned* p)              { return __hip_atomic_load(p, __ATOMIC_RELAXED, __HIP_MEMORY_SCOPE_AGENT); }
__device__ __forceinline__ unsigned xb_add(unsigned* p, unsigned v) { return __hip_atomic_fetch_add(p, v, __ATOMIC_RELAXED, __HIP_MEMORY_SCOPE_AGENT); }
__device__ __forceinline__ unsigned xb_xcc_id() { return (unsigned)__builtin_amdgcn_s_getreg((3 << 11) | 20) & 0xFu; }
#define XB_SPIN(cond, bar) do { unsigned _sp = 0; while (cond) { __builtin_amdgcn_s_sleep(1); \
    if ((++_sp & 255u) == 0u) { if (xb_ld(&(bar)[XB_TMO])) break; if (_sp > XB_SPIN_CAP) { atomicAdd(&(bar)[XB_TMO], 1u); break; } } } } while (0)

struct XcdBarrier {
    unsigned* bar; unsigned x;
    volatile LAS unsigned* st;
};

__device__ __forceinline__ XcdBarrier xcd_barrier_post(unsigned* bar, volatile LAS unsigned* st) {
    XcdBarrier b; b.bar = bar; b.x = xb_xcc_id(); b.st = st;
    if (threadIdx.x == 0) (void)xb_add(&bar[XB_XCNT(b.x)], 1u);
    return b;
}
__device__ __forceinline__ void xcd_barrier_complete(unsigned* bar, unsigned x, unsigned& nloc, unsigned& nx) {
    const unsigned G = gridDim.x * gridDim.y * gridDim.z;
    unsigned sum, cnt, mine, sp = 0u;
    for (;;) {
        sum = 0u; cnt = 0u; mine = 0u;
#pragma unroll
        for (unsigned j = 0; j < 16; ++j) { const unsigned c = xb_ld(&bar[XB_XCNT(j)]); sum += c; cnt += (c > 0u) ? 1u : 0u; mine = (j == x) ? c : mine; }
        if (sum == G) break;
        __builtin_amdgcn_s_sleep(1);
        if ((++sp & 255u) == 0u) { if (xb_ld(&bar[XB_TMO])) break; if (sp > XB_SPIN_CAP) { atomicAdd(&bar[XB_TMO], 1u); break; } }
    }
    nloc = mine > 0u ? mine : 1u; nx = cnt > 0u ? cnt : 1u;
}

__device__ __forceinline__ void xcd_barrier(const XcdBarrier& b) {
    asm volatile("s_waitcnt vmcnt(0)" ::: "memory");
    __syncthreads();
    if (threadIdx.x == 0) {
        unsigned* bar = b.bar;
        __builtin_amdgcn_s_waitcnt(0);
        unsigned nloc = b.st[0], nx = b.st[1];
        if (nloc == 0u) { xcd_barrier_complete(bar, b.x, nloc, nx); b.st[0] = nloc; b.st[1] = nx; }
        const unsigned old = xb_add(&bar[XB_XSUB(b.x)], 1u);
        const unsigned gen = old / nloc;
        if (old + 1u == (gen + 1u) * nloc) {
            __builtin_amdgcn_fence(__ATOMIC_RELEASE, "agent");
            asm volatile("s_waitcnt vmcnt(0)" ::: "memory");
            const unsigned og = xb_add(&bar[XB_TOP], 1u);
            const unsigned tg = og / nx;
            if (og + 1u == (tg + 1u) * nx) xb_add(&bar[XB_TOPGEN], 1u);
            else XB_SPIN(xb_ld(&bar[XB_TOPGEN]) == tg, bar);
            __builtin_amdgcn_fence(__ATOMIC_ACQUIRE, "agent");
            xb_add(&bar[XB_XGEN(b.x)], 1u);
            asm volatile("s_waitcnt vmcnt(0)" ::: "memory");
        } else {
            XB_SPIN(xb_ld(&bar[XB_XGEN(b.x)]) == gen, bar);
            __builtin_amdgcn_fence(__ATOMIC_ACQUIRE, "agent");
            asm volatile("s_waitcnt vmcnt(0)" ::: "memory");
        }
    }
    __syncthreads();
}

typedef unsigned v2u __attribute__((ext_vector_type(2)));
typedef short s16x4 __attribute__((ext_vector_type(4)));
typedef __bf16 bf16x2_t __attribute__((ext_vector_type(2)));
struct Frame {
    LAS unsigned char* lds;
    volatile LAS unsigned* MISC;
    gu32* ctl;
    int tid, lane, wave;
    int vcu, G;
    const float* in[26]; float* out; unsigned char* ws;
};
__device__ __forceinline__ float bflo(unsigned u) { return __uint_as_float(u << 16); }
__device__ __forceinline__ float bfhi(unsigned u) { return __uint_as_float(u & 0xffff0000u); }
__device__ __forceinline__ float wave_sum(float v) {
#pragma unroll
    for (int o = 1; o < 64; o <<= 1) v += __shfl_xor(v, o);
    return v;
}
__device__ __forceinline__ float dpp_f(float x, const int ctrl_sel) {
    const int xi = __float_as_int(x); int r;
    if (ctrl_sel == 0) r = __builtin_amdgcn_update_dpp(0, xi, 0xB1, 0xf, 0xf, true);
    else if (ctrl_sel == 1) r = __builtin_amdgcn_update_dpp(0, xi, 0x4E, 0xf, 0xf, true);
    else if (ctrl_sel == 2) r = __builtin_amdgcn_update_dpp(0, xi, 0x141, 0xf, 0xf, true);
    else r = __builtin_amdgcn_update_dpp(0, xi, 0x140, 0xf, 0xf, true);
    return __int_as_float(r);
}
__device__ __forceinline__ float red8(float x) { x += dpp_f(x, 0); x += dpp_f(x, 1); x += dpp_f(x, 2); return x; }
__device__ __forceinline__ float red16(float x) { x += dpp_f(x, 0); x += dpp_f(x, 1); x += dpp_f(x, 2); x += dpp_f(x, 3); return x; }

__device__ __forceinline__ void ph_mod(Frame& F) {
    const float* c = F.in[1]; const float* W = F.in[2]; const float* bias = F.in[3];
    float* mod = (float*)(F.ws + WS_MOD);
    LAS float* scr = (LAS float*)(F.lds + F.wave * 16384);
    for (int it = blockIdx.x; it < 96; it += F.G) {
        const int col = it * 64 + F.lane, k0 = F.wave * 128;
        for (int i = F.lane; i < 2048; i += 64) { const int b = i >> 7, k = i & 127; const float v = c[b * 1024 + k0 + k]; scr[i] = v / (1.f + __expf(-v)); }
        LDS_WAIT();
        float acc[16];
#pragma unroll
        for (int b = 0; b < 16; ++b) acc[b] = 0.f;
        for (int k = 0; k < 128; k += 16) {
            const float* wp = W + (size_t)(k0 + k) * 6144 + col;
            float wv[16];
#pragma unroll
            for (int q = 0; q < 16; ++q) wv[q] = wp[(size_t)q * 6144];
#pragma unroll
            for (int q4_ = 0; q4_ < 4; ++q4_)
#pragma unroll
                for (int b = 0; b < 16; ++b) { const f32x4 cs = *(const LAS f32x4*)(scr + b * 128 + k + 4 * q4_); acc[b] += (cs.x * wv[4 * q4_] + cs.y * wv[4 * q4_ + 1]) + (cs.z * wv[4 * q4_ + 2] + cs.w * wv[4 * q4_ + 3]); }
        }
#pragma unroll
        for (int b = 0; b < 16; ++b) scr[2048 + b * 64 + F.lane] = acc[b];
        __syncthreads();
        for (int o = F.tid; o < 1024; o += 512) {
            const int b = o >> 6, cc = o & 63; float s = bias[it * 64 + cc];
#pragma unroll
            for (int w = 0; w < 8; ++w) s += ((const LAS float*)(F.lds + w * 16384))[2048 + b * 64 + cc];
            mod[b * 6144 + it * 64 + cc] = s;
        }
        __syncthreads();
    }
}

__device__ __forceinline__ void p0_transpose_item(const float* W, int K, int N, bf16* WT, int row_off, LAS float* scr, int item, int lane) {
    const int nblk = N / 32, kb = item / nblk, nb = item % nblk, k0 = 64 * kb, n0 = 32 * nb;
#pragma unroll 8
    for (int i = 0; i < 32; ++i) { const int kk = 2 * i + (lane >> 5); scr[kk * 33 + (lane & 31)] = W[(size_t)(k0 + kk) * N + n0 + (lane & 31)]; }
    LDS_WAIT(); asm volatile("" ::: "memory");
    const int c = lane & 7;
#pragma unroll
    for (int j = 0; j < 4; ++j) { const int n = (lane >> 3) + 8 * j; const LAS float* s = scr + (8 * c) * 33 + n;
        v4u o; o.x = pk2(s[0 * 33], s[1 * 33]); o.y = pk2(s[2 * 33], s[3 * 33]); o.z = pk2(s[4 * 33], s[5 * 33]); o.w = pk2(s[6 * 33], s[7 * 33]);
        *(GAS v4u*)(WT + (size_t)(row_off + n0 + n) * K + k0 + 8 * c) = o; }
    LDS_WAIT(); asm volatile("" ::: "memory");
}
__device__ __forceinline__ void p0_wp_item(const float* wq, const float* sk, bf16* WpT, LAS float* scr, int item, int lane) {
    const int nq = item & 3, kb = (item >> 2) & 15, hc = item >> 6;
    const int k = kb * 64 + lane, n0 = nq * 32;
    const float* skb = sk + (size_t)(hc * 128 + n0) * 128;
    for (int i = lane; i < 1024; i += 64) ((LAS f32x4*)scr)[i] = ((const f32x4*)skb)[i];
    LDS_WAIT(); asm volatile("" ::: "memory");
    float acc[32];
#pragma unroll
    for (int n = 0; n < 32; ++n) acc[n] = 0.f;
    const float* wrow = wq + (size_t)k * 2048 + hc * 128;
    for (int d4 = 0; d4 < 32; ++d4) {
        const f32x4 w = *(const f32x4*)(wrow + 4 * d4);
#pragma unroll
        for (int n = 0; n < 32; ++n) { const f32x4 s = *(const LAS f32x4*)(scr + n * 128 + 4 * d4); acc[n] += (w.x * s.x + w.y * s.y) + (w.z * s.z + w.w * s.w); }
    }
#pragma unroll
    for (int n = 0; n < 32; ++n) WpT[(size_t)(hc * 128 + n0 + n) * 1024 + k] = (bf16)f2bf(acc[n]);
    LDS_WAIT(); asm volatile("" ::: "memory");
}
__device__ __forceinline__ void ph_weights(Frame& F, int gw, int NGW) {
    LAS float* scr = (LAS float*)(F.lds + F.wave * 16384);
    constexpr int I_WP = 16 * 16 * 4, I_IN = (D / 64) * (IN_COLS / 32), I_OUT = (D / 64) * (D / 32);
    constexpr int NITEMS = I_WP + I_IN + I_OUT;
    bf16* WinT = (bf16*)(F.ws + WS_WIN); bf16* WoutT = (bf16*)(F.ws + WS_WOUT); bf16* WpT = (bf16*)(F.ws + WS_WP);
    for (int it = gw; it < NITEMS; it += NGW) {
        int r = it;
        if (r < I_WP) { p0_wp_item(F.in[20], F.in[21], WpT, scr, r, F.lane); continue; } r -= I_WP;
        if (r < I_IN) { p0_transpose_item(F.in[4], D, IN_COLS, WinT, 0, scr, r, F.lane); continue; } r -= I_IN;
        p0_transpose_item(F.in[17], D, D, WoutT, 0, scr, r, F.lane);
    }
    for (int it = gw; it < 256; it += NGW) {
        const float* W; int rel, KS;
        if (it < 64) { W = F.in[8]; rel = it; KS = 2; } else if (it < 128) { W = F.in[10]; rel = it - 64; KS = 2; } else { W = F.in[11]; rel = it - 128; KS = 4; }
        const int nb = rel & 3, ks = (rel >> 2) % KS, head = (rel >> 2) / KS, tq = F.lane & 15, g = F.lane >> 4;
        float wv[8];
#pragma unroll
        for (int j = 0; j < 8; ++j) wv[j] = W[(size_t)(32 * ks + 8 * g + j) * 512 + head * 64 + nb * 16 + tq];
        v4u o; o.x = pk2(wv[0], wv[1]); o.y = pk2(wv[2], wv[3]); o.z = pk2(wv[4], wv[5]); o.w = pk2(wv[6], wv[7]);
        *(v4u*)(F.ws + WS_FRAG + ((size_t)it * 64 + F.lane) * 16) = o;
    }
}
__device__ __forceinline__ void ph_prologue(Frame& F) {
    const int gw = F.vcu * NWAVES + F.wave, NGW = F.G * NWAVES;
    const float* modp = (const float*)(F.ws + WS_MOD);
    const int rpw = M / NGW, m_begin = gw * rpw, m_end = m_begin + rpw;
    const float* md = modp + (m_begin >> 11) * 6144;
    f32x4 sh[4], sc[4];
#pragma unroll
    for (int j = 0; j < 4; ++j) { const int col = 4 * F.lane + 256 * j; sh[j] = *(const f32x4*)(md + col); sc[j] = *(const f32x4*)(md + 1024 + col) + 1.0f; }
    f32x4 xn[4];
#define MOD_LOAD(m_) do { const float* x_ = F.in[0] + (size_t)(m_) * D; _Pragma("unroll") for (int j = 0; j < 4; ++j) xn[j] = *(const f32x4*)(x_ + 4 * F.lane + 256 * j); } while (0)
    MOD_LOAD(m_begin);
    for (int m = m_begin; m < m_end; ++m) {
        f32x4 xv[4];
#pragma unroll
        for (int j = 0; j < 4; ++j) xv[j] = xn[j];
        if (m + 1 < m_end) MOD_LOAD(m + 1);
        bf16* h = (bf16*)(F.ws + WS_H) + (size_t)m * D;
#pragma unroll
        for (int j = 0; j < 4; ++j) { const f32x4 v = xv[j] * sc[j] + sh[j]; v2u o; o.x = pk2(v.x, v.y); o.y = pk2(v.z, v.w); *(v2u*)(h + 4 * F.lane + 256 * j) = o; }
    }
#undef MOD_LOAD
}

constexpr int ACT_PITCH = 264;
constexpr int REC_BYTES = 12544, REC_AT = 0, REC_RT = 2048, REC_BK = 4096, REC_TM = 8192, REC_QB = 8704, REC_NKA = 9216, REC_QK = 9728, REC_VT = 10240, REC_P15 = 12288;
__device__ __forceinline__ bf16x8 pk8(const float (&lo)[4], const float (&hi)[4]) {
    const unsigned a = pk2(lo[0], lo[1]), b = pk2(lo[2], lo[3]), c = pk2(hi[0], hi[1]), d = pk2(hi[2], hi[3]);
    return __builtin_bit_cast(bf16x8, (v4u){a, b, c, d});
}
__device__ __forceinline__ bf16x8 pk4lo(const f32x4 a) {
    return __builtin_bit_cast(bf16x8, (v4u){pk2(a[0], a[1]), pk2(a[2], a[3]), 0u, 0u});
}
__device__ __forceinline__ f32x4 mm16(const bf16x8 x, const bf16x8 y, const f32x4 c) { return __builtin_amdgcn_mfma_f32_16x16x32_bf16(x, y, c, 0, 0, 0); }
__device__ __forceinline__ float row_shr_f(float x, const int d) {
    int r; const int xi = __float_as_int(x);
    if (d == 1) r = __builtin_amdgcn_update_dpp(0, xi, 0x111, 0xf, 0xf, true); else if (d == 2) r = __builtin_amdgcn_update_dpp(0, xi, 0x112, 0xf, 0xf, true);
    else if (d == 4) r = __builtin_amdgcn_update_dpp(0, xi, 0x114, 0xf, 0xf, true); else r = __builtin_amdgcn_update_dpp(0, xi, 0x118, 0xf, 0xf, true);
    return __int_as_float(r);
}
__device__ __forceinline__ void ph_prep(Frame& F) {
    const bf16* PROJ = (const bf16*)(F.ws + WS_PROJ);
    const float* mu_ = F.in[6]; const float* w0_ = F.in[7]; const float* a0_ = F.in[9];
    const float* k_k_ = F.in[12]; const float* k_a_ = F.in[13]; const float* r_k_ = F.in[14];
    bf16* RWG = (bf16*)(F.ws + WS_G); float* DOTRK = (float*)(F.ws + WS_DOTRK); unsigned char* REC = F.ws + WS_REC;
    LAS bf16* act0 = (LAS bf16*)(F.lds);
    int par = 0;
    const int lane = F.lane, tq = lane & 15, g = lane >> 4, head = F.wave;
    const bf16x8* FR = (const bf16x8*)(F.ws + WS_FRAG);
    bf16x8 Sel0, Sel1;
#pragma unroll
    for (int j = 0; j < 8; ++j) { Sel0[j] = (short)((j < 4 && 4 * g + j == tq) ? 0x3F80 : 0); Sel1[j] = (short)((j >= 4 && 4 * g + j - 4 == tq) ? 0x3F80 : 0); }
    const f32x4 Z4 = (f32x4){0.f, 0.f, 0.f, 0.f};
    LAS float* cst = (LAS float*)(F.lds + 32768);
    { const int t_ = F.tid; cst[t_] = mu_[RW_K + t_]; cst[512 + t_] = mu_[RW_R + t_]; cst[1024 + t_] = mu_[RW_V + t_]; cst[1536 + t_] = k_k_[t_]; cst[2048 + t_] = k_a_[t_]; cst[2560 + t_] = r_k_[t_]; cst[3072 + t_] = w0_[t_]; cst[3584 + t_] = a0_[t_]; }
    __syncthreads();
    v4u st_cur, st_prv;
#define ST_LOAD(tile_) do { const int row_ = (tile_) * 16 + (F.tid >> 5); const bf16* p_ = PROJ + (size_t)row_ * IN_COLS + C_RW + RW_WD + 8 * (F.tid & 31); \
        st_cur = *(const v4u*)p_; st_prv = (v4u){0u, 0u, 0u, 0u}; if ((row_ & (SEQ - 1)) != 0) st_prv = *(const v4u*)(p_ - IN_COLS); } while (0)
#define PREP_BAR() do { asm volatile("s_waitcnt lgkmcnt(0)" ::: "memory"); __builtin_amdgcn_s_barrier(); asm volatile("" ::: "memory"); } while (0)
    if (F.vcu < M / 16) ST_LOAD(F.vcu);
#pragma unroll 1
    for (int tile = F.vcu; tile < M / 16; tile += F.G) {
        const int t0 = tile * 16;
        LAS bf16* act = act0 + par * (16 * ACT_PITCH); par ^= 1;
        {
            const int token = F.tid >> 5, cg = F.tid & 31;
            const v4u cur = st_cur, prv = st_prv;
            if (tile + F.G < M / 16) ST_LOAD(tile + F.G);
            const f32x4 m0 = *(const f32x4*)(mu_ + RW_WD + 8 * cg), m1 = *(const f32x4*)(mu_ + RW_WD + 8 * cg + 4);
            float v[8];
            { const unsigned cu[4] = {cur.x, cur.y, cur.z, cur.w}, pu[4] = {prv.x, prv.y, prv.z, prv.w}; const float mm[8] = {m0.x, m0.y, m0.z, m0.w, m1.x, m1.y, m1.z, m1.w};
#pragma unroll
              for (int e = 0; e < 4; ++e) { const float c0 = bflo(cu[e]), c1 = bfhi(cu[e]), p0 = bflo(pu[e]), p1 = bfhi(pu[e]);
                  v[2 * e] = c0 + (p0 - c0) * mm[2 * e]; v[2 * e + 1] = c1 + (p1 - c1) * mm[2 * e + 1]; } }
            if (cg < 8) {
#pragma unroll
                for (int e = 0; e < 8; ++e) v[e] = 1.f - 2.f / (1.f + __expf(2.f * v[e]));
            } else if (cg >= 16) {
#pragma unroll
                for (int e = 0; e < 8; ++e) v[e] = 1.f / (1.f + __expf(-v[e]));
            }
            v4u o; o.x = pk2(v[0], v[1]); o.y = pk2(v[2], v[3]); o.z = pk2(v[4], v[5]); o.w = pk2(v[6], v[7]);
            *(LAS v4u*)(act + token * ACT_PITCH + 8 * cg) = o;
        }
        const int row = t0 + tq; const bool has_prev = (row & (SEQ - 1)) != 0;
        v2u kcA[4], kpA[4], rcA[4], rpA[4], vcA[4], vpA[4];
#pragma unroll
        for (int nb = 0; nb < 4; ++nb) { const int col = head * 64 + nb * 16 + 4 * g; const bf16* pb = PROJ + (size_t)row * IN_COLS + C_RW + col;
            kcA[nb] = *(const v2u*)(pb + RW_K); rcA[nb] = *(const v2u*)(pb + RW_R); vcA[nb] = *(const v2u*)(pb + RW_V);
            kpA[nb] = (v2u){0u, 0u}; rpA[nb] = kpA[nb]; vpA[nb] = kpA[nb];
            if (has_prev) { kpA[nb] = *(const v2u*)(pb + RW_K - IN_COLS); rpA[nb] = *(const v2u*)(pb + RW_R - IN_COLS); vpA[nb] = *(const v2u*)(pb + RW_V - IN_COLS); } }
        PREP_BAR();
        const bf16x8* FRl = FR; asm volatile("" : "+s"(FRl));
        {
            f32x4 accg[4];
#pragma unroll
            for (int nb = 0; nb < 4; ++nb) accg[nb] = Z4;
#pragma unroll
            for (int ks = 0; ks < 4; ++ks) {
                const bf16x8 Ag = *(const LAS bf16x8*)(act + tq * ACT_PITCH + 128 + 32 * ks + 8 * g);
#pragma unroll
                for (int nb = 0; nb < 4; ++nb) { const bf16x8 Bg = FRl[(size_t)(128 + ((head * 4 + ks) * 4 + nb)) * 64 + lane]; accg[nb] = mm16(Bg, Ag, accg[nb]); }
            }
#pragma unroll
            for (int nb = 0; nb < 4; ++nb) { const int col = head * 64 + nb * 16 + 4 * g; v2u o; o.x = pk2(accg[nb][0], accg[nb][1]); o.y = pk2(accg[nb][2], accg[nb][3]); *(v2u*)(RWG + (size_t)row * 512 + col) = o; }
        }
        f32x4 accw[4], acca[4];
#pragma unroll
        for (int nb = 0; nb < 4; ++nb) { accw[nb] = Z4; acca[nb] = Z4; }
#pragma unroll
        for (int ks = 0; ks < 2; ++ks) {
            const bf16x8 Aw = *(const LAS bf16x8*)(act + tq * ACT_PITCH + 32 * ks + 8 * g);
            const bf16x8 Aa = *(const LAS bf16x8*)(act + tq * ACT_PITCH + 64 + 32 * ks + 8 * g);
#pragma unroll
            for (int nb = 0; nb < 4; ++nb) { const bf16x8 Bw = FRl[(size_t)(((head * 2 + ks) * 4 + nb)) * 64 + lane], Ba = FRl[(size_t)(64 + ((head * 2 + ks) * 4 + nb)) * 64 + lane];
                accw[nb] = mm16(Bw, Aw, accw[nb]); acca[nb] = mm16(Ba, Aa, acca[nb]); }
        }
        float ss = 0.f;
#pragma unroll
        for (int nb = 0; nb < 4; ++nb) {
            const int col = head * 64 + nb * 16 + 4 * g;
            const v2u cur = kcA[nb], prv = kpA[nb];
            const f32x4 mk = *(const LAS f32x4*)(cst + col), kk4 = *(const LAS f32x4*)(cst + 1536 + col);
            const float cc[4] = {bflo(cur.x), bfhi(cur.x), bflo(cur.y), bfhi(cur.y)}, pp[4] = {bflo(prv.x), bfhi(prv.x), bflo(prv.y), bfhi(prv.y)};
#pragma unroll
            for (int i = 0; i < 4; ++i) { const float kr = (cc[i] + (pp[i] - cc[i]) * mk[i]) * kk4[i]; ss += kr * kr; }
        }
        ss += __shfl_xor(ss, 16); ss += __shfl_xor(ss, 32);
        const float rn = rsqrtf(fmaxf(ss, 1e-24f));
        float drk = 0.f;
        unsigned char* rec = REC + ((size_t)((row >> 11) * 8 + head) * (SEQ / 16) + (size_t)((t0 & (SEQ - 1)) >> 4)) * REC_BYTES;
        f32x4 N = Z4, NT = Z4, Nka = Z4, Qb = Z4, Qk = Z4;
#pragma unroll
        for (int s2 = 0; s2 < 2; ++s2) {
            v2u dAt[2], dRt[2], dBt[2], dKt[2], dBp[2], dKp[2], dVv[2];
#pragma unroll
            for (int h2 = 0; h2 < 2; ++h2) {
                const int nb = 2 * s2 + h2;
                const int col = head * 64 + nb * 16 + 4 * g;
                const v2u kc = kcA[nb], rc = rcA[nb], vc = vcA[nb], kp_ = kpA[nb], rp = rpA[nb], vp = vpA[nb];
                const f32x4 mk = *(const LAS f32x4*)(cst + col), mr = *(const LAS f32x4*)(cst + 512 + col), mv = *(const LAS f32x4*)(cst + 1024 + col), kk4 = *(const LAS f32x4*)(cst + 1536 + col), ka4 = *(const LAS f32x4*)(cst + 2048 + col), rk4 = *(const LAS f32x4*)(cst + 2560 + col);
                const f32x4 w04 = *(const LAS f32x4*)(cst + 3072 + col), a04 = *(const LAS f32x4*)(cst + 3584 + col);
                const float kcc[4] = {bflo(kc.x), bfhi(kc.x), bflo(kc.y), bfhi(kc.y)}, kpp[4] = {bflo(kp_.x), bfhi(kp_.x), bflo(kp_.y), bfhi(kp_.y)};
                const float rcc[4] = {bflo(rc.x), bfhi(rc.x), bflo(rc.y), bfhi(rc.y)}, rpp[4] = {bflo(rp.x), bfhi(rp.x), bflo(rp.y), bfhi(rp.y)};
                const float vcc[4] = {bflo(vc.x), bfhi(vc.x), bflo(vc.y), bfhi(vc.y)}, vpp[4] = {bflo(vp.x), bfhi(vp.x), bflo(vp.y), bfhi(vp.y)};
                f32x4 p15; float At[4], Rt[4], Bt[4], Kt[4], Bp[4], Kp[4], Vv[4];
#pragma unroll
                for (int i = 0; i < 4; ++i) {
                    const float lw = accw[nb][i] + w04[i], z = -lw;
                    const float sp = fmaxf(z, 0.f) + __logf(1.f + __expf(-fabsf(z)));
                    const float ld = -__expf(-sp - 0.5f);
                    float cs = ld; cs += row_shr_f(cs, 1); cs += row_shr_f(cs, 2); cs += row_shr_f(cs, 4); cs += row_shr_f(cs, 8);
                    const float Pt = __expf(cs), Pinv = __expf(-cs), Pprev = __expf(cs - ld);
                    const float a = 1.f / (1.f + __expf(-(acca[nb][i] + a04[i])));
                    const float k = kcc[i] + (kpp[i] - kcc[i]) * mk[i], r = rcc[i] + (rpp[i] - rcc[i]) * mr[i], v = vcc[i] + (vpp[i] - vcc[i]) * mv[i];
                    const float kkn = k * kk4[i] * rn, bb = kkn * a, kp = k * (1.f + (a - 1.f) * ka4[i]);
                    drk += r * kp * rk4[i];
                    const float P15 = __shfl(Pt, (lane & 48) | 15); p15[i] = P15;
                    const float Pend = P15 * Pinv;
                    At[i] = -kkn * Pprev; Rt[i] = r * Pt; Bt[i] = bb * Pinv; Kt[i] = kp * Pinv; Bp[i] = bb * Pend; Kp[i] = kp * Pend; Vv[i] = v;
                }
                if (tq == 0) *(f32x4*)(rec + REC_P15 + (g * 16 + nb * 4) * 4) = p15;
                dAt[h2] = (v2u){pk2(At[0], At[1]), pk2(At[2], At[3])}; dRt[h2] = (v2u){pk2(Rt[0], Rt[1]), pk2(Rt[2], Rt[3])}; dBt[h2] = (v2u){pk2(Bt[0], Bt[1]), pk2(Bt[2], Bt[3])}; dKt[h2] = (v2u){pk2(Kt[0], Kt[1]), pk2(Kt[2], Kt[3])};
                dBp[h2] = (v2u){pk2(Bp[0], Bp[1]), pk2(Bp[2], Bp[3])}; dKp[h2] = (v2u){pk2(Kp[0], Kp[1]), pk2(Kp[2], Kp[3])}; dVv[h2] = (v2u){pk2(Vv[0], Vv[1]), pk2(Vv[2], Vv[3])};
                __builtin_amdgcn_sched_barrier(0);
            }
#define FR8(d) __builtin_bit_cast(bf16x8, (v4u){d[0].x, d[0].y, d[1].x, d[1].y})
            const bf16x8 AtF = FR8(dAt), RtF = FR8(dRt), BtF = FR8(dBt), KtF = FR8(dKt), BpF = FR8(dBp), KpF = FR8(dKp), VF = FR8(dVv);
#undef FR8
            ((bf16x8*)(rec + REC_AT + s2 * 1024))[lane] = AtF; ((bf16x8*)(rec + REC_RT + s2 * 1024))[lane] = RtF;
            N = mm16(BtF, AtF, N); NT = mm16(AtF, BtF, NT); Nka = mm16(KtF, AtF, Nka); Qb = mm16(BtF, RtF, Qb); Qk = mm16(KtF, RtF, Qk);
#pragma unroll
            for (int h2 = 0; h2 < 2; ++h2) {
                const int kt = 2 * s2 + h2; const bf16x8 sel = h2 ? Sel1 : Sel0;
                const f32x4 bT = mm16(BpF, sel, Z4), kT = mm16(KpF, sel, Z4), vT = mm16(VF, sel, Z4);
                const float bl[4] = {bT[0], bT[1], bT[2], bT[3]}, kl[4] = {kT[0], kT[1], kT[2], kT[3]};
                ((bf16x8*)(rec + REC_BK + kt * 1024))[lane] = pk8(bl, kl);
                v2u o; o.x = pk2(vT[0], vT[1]); o.y = pk2(vT[2], vT[3]); ((v2u*)(rec + REC_VT + kt * 512))[lane] = o;
            }
            __builtin_amdgcn_sched_barrier(0);
        }
        drk += __shfl_xor(drk, 16); drk += __shfl_xor(drk, 32);
        if (g == 0) DOTRK[(size_t)row * 8 + head] = drk;
#pragma unroll
        for (int i = 0; i < 4; ++i) { const int rr = 4 * g + i;
            if (!(rr < tq)) { N[i] = 0.f; Nka[i] = 0.f; }
            if (!(tq < rr)) NT[i] = 0.f;
            if (!(rr <= tq)) { Qb[i] = 0.f; Qk[i] = 0.f; } }
        f32x4 R = N, RT = NT;
#pragma unroll
        for (int i = 0; i < 4; ++i) { if (4 * g + i == tq) { R[i] += 1.f; RT[i] += 1.f; } }
        {
            const f32x4 N2 = mm16(pk4lo(NT), pk4lo(N), Z4), N2T = mm16(pk4lo(N), pk4lo(NT), Z4);
            const f32x4 R1 = mm16(pk4lo(RT), pk4lo(N2), R), RT1 = mm16(pk4lo(N2), pk4lo(RT), RT);
            const f32x4 N4 = mm16(pk4lo(N2T), pk4lo(N2), Z4), N4T = mm16(pk4lo(N2), pk4lo(N2T), Z4);
            const f32x4 R2 = mm16(pk4lo(RT1), pk4lo(N4), R1), RT2 = mm16(pk4lo(N4), pk4lo(RT1), RT1);
            const f32x4 N8 = mm16(pk4lo(N4T), pk4lo(N4), Z4);
            R = mm16(pk4lo(RT2), pk4lo(N8), R2);
        }
        { v2u o; o.x = pk2(R[0], R[1]); o.y = pk2(R[2], R[3]); ((v2u*)(rec + REC_TM))[lane] = o;
          o.x = pk2(Qb[0], Qb[1]); o.y = pk2(Qb[2], Qb[3]); ((v2u*)(rec + REC_QB))[lane] = o;
          o.x = pk2(Nka[0], Nka[1]); o.y = pk2(Nka[2], Nka[3]); ((v2u*)(rec + REC_NKA))[lane] = o;
          o.x = pk2(Qk[0], Qk[1]); o.y = pk2(Qk[2], Qk[3]); ((v2u*)(rec + REC_QK))[lane] = o; }
    }
#undef ST_LOAD
#undef PREP_BAR
}

constexpr int KV_PITCH = 72;
__device__ __forceinline__ s16x4 tr_read(const LAS bf16* p) { typedef short v4i16_t __attribute__((ext_vector_type(4))); return __builtin_bit_cast(s16x4, __builtin_amdgcn_ds_read_tr16_b64_v4i16((LAS v4i16_t*)p)); }
__device__ __forceinline__ void ph_attn(Frame& F) {
    const bf16* PROJ = (const bf16*)(F.ws + WS_PROJ); bf16* MIX = (bf16*)F.out; const float* sink = F.in[5];
    LAS bf16* Ks = (LAS bf16*)(F.lds); LAS bf16* Vs = Ks + 256 * KV_PITCH;
    for (int i = F.tid; i < 16 * KV_PITCH / 2; i += 512) ((LAS unsigned*)(Vs + 256 * KV_PITCH))[i] = 0u;
    const int tq = F.lane & 15, g = F.lane >> 4;
    for (int u = F.vcu; u < 512; u += F.G) {
        const int b = u >> 5, kvh = (u >> 4) & 1, n = u & 15;
        const size_t row0 = (size_t)b * SEQ + (size_t)n * 128;
#pragma unroll
        for (int i = 0; i < 4; ++i) {
            const int c = F.tid + 512 * i, krow = c >> 3, part = c & 7;
            v4u kx = (v4u){0u, 0u, 0u, 0u}, vx = kx;
            if (n > 0 || krow >= 128) { const bf16* src = PROJ + (row0 - 128 + krow) * IN_COLS + kvh * 64 + part * 8; kx = *(const v4u*)(src + C_K); vx = *(const v4u*)(src + C_V); }
            *(LAS v4u*)(Ks + krow * KV_PITCH + part * 8) = kx; *(LAS v4u*)(Vs + krow * KV_PITCH + part * 8) = vx;
        }
        __syncthreads();
        const int gq = F.wave >> 1, qh = F.wave & 1, hq = kvh * 4 + gq; const float sinkv = sink[hq];
        for (int qb = 0; qb < 4; ++qb) {
            const int i0 = 64 * qh + 16 * qb, kb0 = 4 * qh + qb, iq = i0 + tq;
            const bf16* qp = PROJ + (row0 + iq) * IN_COLS + C_Q + hq * 64 + 8 * g;
            const bf16x8 Q0 = *(const bf16x8*)qp, Q1 = *(const bf16x8*)(qp + 32);
            float s[9][4]; float mx = -INFINITY;
#pragma unroll
            for (int kbi = 0; kbi < 9; ++kbi) {
                const LAS bf16* kp = Ks + ((kb0 + kbi) * 16 + tq) * KV_PITCH + 8 * g;
                f32x4 a = (f32x4){0.f, 0.f, 0.f, 0.f};
                a = __builtin_amdgcn_mfma_f32_16x16x32_bf16(*(const LAS bf16x8*)kp, Q0, a, 0, 0, 0);
                a = __builtin_amdgcn_mfma_f32_16x16x32_bf16(*(const LAS bf16x8*)(kp + 32), Q1, a, 0, 0, 0);
#pragma unroll
                for (int i = 0; i < 4; ++i) { const int j = (kb0 + kbi) * 16 + 4 * g + i; const bool ok = (j > iq) && (j <= iq + 128) && (n > 0 || j >= 128);
                    const float sv = ok ? a[i] * 0.125f : -INFINITY; s[kbi][i] = sv; mx = fmaxf(mx, sv); }
            }
            mx = fmaxf(mx, __shfl_xor(mx, 16)); mx = fmaxf(mx, __shfl_xor(mx, 32)); mx = fmaxf(mx, sinkv);
            float l = 0.f;
#pragma unroll
            for (int kbi = 0; kbi < 9; ++kbi)
#pragma unroll
                for (int i = 0; i < 4; ++i) { const float p = __expf(s[kbi][i] - mx); s[kbi][i] = p; l += p; }
            l += __shfl_xor(l, 16); l += __shfl_xor(l, 32); l += __expf(sinkv - mx);
            const float rl = 1.f / l;
            bf16x8 P[5];
#pragma unroll
            for (int pr = 0; pr < 5; ++pr) {
#pragma unroll
                for (int i = 0; i < 4; ++i) { P[pr][i] = (short)f2bf(s[2 * pr][i]); P[pr][4 + i] = (pr < 4) ? (short)f2bf(s[(pr < 4) ? 2 * pr + 1 : 0][i]) : (short)0; }
            }
            bf16* op = MIX + (row0 + iq) * D + hq * 64 + 4 * g;
#pragma unroll
            for (int db = 0; db < 4; ++db) {
                f32x4 o = (f32x4){0.f, 0.f, 0.f, 0.f};
#pragma unroll
                for (int pr = 0; pr < 5; ++pr) {
                    const LAS bf16* vp = Vs + ((kb0 + 2 * pr) * 16 + 4 * g + (tq >> 2)) * KV_PITCH + db * 16 + 4 * (tq & 3);
                    const s16x4 lo = tr_read(vp), hi = tr_read(vp + 16 * KV_PITCH);
                    const bf16x8 Vf = (bf16x8){lo[0], lo[1], lo[2], lo[3], hi[0], hi[1], hi[2], hi[3]};
                    o = __builtin_amdgcn_mfma_f32_16x16x32_bf16(Vf, P[pr], o, 0, 0, 0);
                }
                v2u w; w.x = pk2(o[0] * rl, o[1] * rl); w.y = pk2(o[2] * rl, o[3] * rl);
                *(v2u*)(op + db * 16) = w;
            }
        }
        __syncthreads();
    }
}

struct ScanRec { bf16x8 f[8]; v2u m[4]; v2u vt; f32x4 p[4]; };
__device__ __forceinline__ void scan_load(ScanRec& Rr, const unsigned char* rec, int lane, int vt, int g) {
#pragma unroll
    for (int i = 0; i < 8; ++i) Rr.f[i] = ((const bf16x8*)(rec + i * 1024))[lane];
#pragma unroll
    for (int i = 0; i < 4; ++i) Rr.m[i] = ((const v2u*)(rec + REC_TM + i * 512))[lane];
    Rr.vt = ((const v2u*)(rec + REC_VT + vt * 512))[lane];
#pragma unroll
    for (int i = 0; i < 4; ++i) Rr.p[i] = *(const f32x4*)(rec + REC_P15 + (g * 16 + i * 4) * 4);
}
__device__ __forceinline__ bf16x8 lo8(const v2u a) { return __builtin_bit_cast(bf16x8, (v4u){a.x, a.y, 0u, 0u}); }
__device__ __forceinline__ void scan_chunk(const ScanRec& Rr, f32x4 (&S)[4], bf16* yp) {
    const f32x4 Z4 = (f32x4){0.f, 0.f, 0.f, 0.f};
    const bf16x8 Vlo = lo8(Rr.vt);
    const f32x4 W0 = mm16(lo8(Rr.m[2]), Vlo, Z4), Y0 = mm16(lo8(Rr.m[3]), Vlo, Z4);
    const bf16x8 Sb0 = __builtin_bit_cast(bf16x8, (v4u){pk2(S[0][0], S[0][1]), pk2(S[0][2], S[0][3]), pk2(S[1][0], S[1][1]), pk2(S[1][2], S[1][3])});
    const bf16x8 Sb1 = __builtin_bit_cast(bf16x8, (v4u){pk2(S[2][0], S[2][1]), pk2(S[2][2], S[2][3]), pk2(S[3][0], S[3][1]), pk2(S[3][2], S[3][3])});
    const f32x4 XW = mm16(Rr.f[1], Sb1, mm16(Rr.f[0], Sb0, W0));
    f32x4 YT = mm16(Rr.f[3], Sb1, mm16(Rr.f[2], Sb0, Y0));
    const f32x4 UT = mm16(lo8(Rr.m[0]), pk4lo(XW), Z4);
    const v2u utp = (v2u){pk2(UT[0], UT[1]), pk2(UT[2], UT[3])};
    YT = mm16(lo8(Rr.m[1]), lo8(utp), YT);
    const bf16x8 UV = __builtin_bit_cast(bf16x8, (v4u){utp.x, utp.y, Rr.vt.x, Rr.vt.y});
#pragma unroll
    for (int kt = 0; kt < 4; ++kt) S[kt] = mm16(Rr.f[4 + kt], UV, S[kt] * Rr.p[kt]);
#pragma unroll
    for (int i = 0; i < 4; ++i) yp[(size_t)i * 512] = (bf16)f2bf(YT[i]);
}
__device__ __forceinline__ float wave_sum_f(float v) { v = red16(v); v += __shfl_xor(v, 16); v += __shfl_xor(v, 32); return v; }
__device__ __forceinline__ float wave_max(float v) {
    v = fmaxf(v, dpp_f(v, 0)); v = fmaxf(v, dpp_f(v, 1)); v = fmaxf(v, dpp_f(v, 2)); v = fmaxf(v, dpp_f(v, 3));
    v = fmaxf(v, __shfl_xor(v, 16)); v = fmaxf(v, __shfl_xor(v, 32)); return v;
}
__device__ __forceinline__ unsigned q4(const f32x4 v, float inv, int bias) {
    const int a = (int)rintf(v.x * inv) + bias, b = (int)rintf(v.y * inv) + bias, c = (int)rintf(v.z * inv) + bias, d = (int)rintf(v.w * inv) + bias;
    return (unsigned)(a & 0xff) | ((unsigned)(b & 0xff) << 8) | ((unsigned)(c & 0xff) << 16) | ((unsigned)(d & 0xff) << 24);
}
__device__ __forceinline__ void ph_convert(Frame& F, int gw, int NGW) {
    const int lane = F.lane;
    unsigned* U8 = (unsigned*)(F.ws + WS_U8); unsigned* V8 = (unsigned*)(F.ws + WS_V8); float* US = (float*)(F.ws + WS_US); float* VS = (float*)(F.ws + WS_VS);
    f32x4 rn[4];
#define CV_LOAD(r_) do { const float* s_ = ((r_) < 16384) ? F.in[22] + (size_t)(r_) * D : F.in[23] + (size_t)((r_) - 16384) * D; \
        _Pragma("unroll") for (int j = 0; j < 4; ++j) rn[j] = *(const f32x4*)(s_ + 4 * lane + 256 * j); } while (0)
    if (gw < 32768) CV_LOAD(gw);
    for (int r = gw; r < 32768; r += NGW) {
        f32x4 xv[4];
#pragma unroll
        for (int j = 0; j < 4; ++j) xv[j] = rn[j];
        if (r + NGW < 32768) CV_LOAD(r + NGW);
        float am = 0.f;
#pragma unroll
        for (int j = 0; j < 4; ++j) am = fmaxf(am, fmaxf(fmaxf(fabsf(xv[j].x), fabsf(xv[j].y)), fmaxf(fabsf(xv[j].z), fabsf(xv[j].w))));
        am = fmaxf(wave_max(am), 1e-30f); const float inv = 127.f / am;
        if (r < 16384) {
#pragma unroll
            for (int j = 0; j < 4; ++j) U8[(size_t)r * 256 + lane + 64 * j] = q4(xv[j], inv, 0);
            if (lane == 0) US[r] = am * (1.f / 127.f);
        } else {
            const int e = r - 16384;
#pragma unroll
            for (int j = 0; j < 4; ++j) V8[((size_t)(2 * j + (lane >> 5)) * 16384 + e) * 32 + (lane & 31)] = q4(xv[j], inv, 0);
            if (lane == 0) VS[e] = am * (1.f / 127.f);
        }
    }
#undef CV_LOAD
}
__device__ __forceinline__ void scan_lds_load(ScanRec& Rr, const LAS unsigned char* rec, int lane, int vt, int g) {
#pragma unroll
    for (int i = 0; i < 8; ++i) Rr.f[i] = ((const LAS bf16x8*)(rec + i * 1024))[lane];
#pragma unroll
    for (int i = 0; i < 4; ++i) Rr.m[i] = ((const LAS v2u*)(rec + REC_TM + i * 512))[lane];
    Rr.vt = ((const LAS v2u*)(rec + REC_VT + vt * 512))[lane];
#pragma unroll
    for (int i = 0; i < 4; ++i) Rr.p[i] = *(const LAS f32x4*)(rec + REC_P15 + (g * 16 + i * 4) * 4);
}
__device__ __forceinline__ void ph_scan(Frame& F) {
    const unsigned char* REC = F.ws + WS_REC; bf16* YB = (bf16*)(F.ws + WS_YB);
    const int lane = F.lane, tq = lane & 15, g = lane >> 4;
    constexpr int NCH = SEQ / 16;
#define SC_BAR() do { asm volatile("s_waitcnt lgkmcnt(0)" ::: "memory"); __builtin_amdgcn_s_barrier(); asm volatile("" ::: "memory"); } while (0)
    const bool split = (F.G == 256); const int n_scan = split ? 128 : F.G, sidx = split ? (F.vcu >> 1) : F.vcu; const bool scanner = split ? ((F.vcu & 1) == 0) : true;
    if (scanner) for (int item = sidx; item < 128; item += n_scan) {
        const int bh = item, b = bh >> 3, h = bh & 7;
        const unsigned char* rec = REC + (size_t)bh * NCH * REC_BYTES;
        if (F.wave < 4) {
            const int vt = F.wave;
            bf16* yp = YB + ((size_t)b * SEQ + 4 * g) * 512 + h * 64 + vt * 16 + tq;
            f32x4 S[4];
#pragma unroll
            for (int kt = 0; kt < 4; ++kt) S[kt] = (f32x4){0.f, 0.f, 0.f, 0.f};
            SC_BAR();
            for (int c = 0; c < NCH; ++c) {
                ScanRec Rr; scan_lds_load(Rr, F.lds + (c & 1) * REC_BYTES, lane, vt, g);
                scan_chunk(Rr, S, yp + (size_t)c * 16 * 512);
                SC_BAR();
            }
        } else {
            const int l = F.tid - 256;
            const bool fourth = l < 16;
            v4u bf[4][4];
#define LD_CH(ch_, bi_) do { const unsigned char* r_ = rec + (size_t)(ch_) * REC_BYTES; bf[bi_][0] = *(const v4u*)(r_ + l * 16); bf[bi_][1] = *(const v4u*)(r_ + (l + 256) * 16); bf[bi_][2] = *(const v4u*)(r_ + (l + 512) * 16); if (fourth) bf[bi_][3] = *(const v4u*)(r_ + (768 + l) * 16); } while (0)
#define WR_CH(slot_, bi_) do { LAS unsigned char* s_ = F.lds + (slot_) * REC_BYTES; *(LAS v4u*)(s_ + l * 16) = bf[bi_][0]; *(LAS v4u*)(s_ + (l + 256) * 16) = bf[bi_][1]; *(LAS v4u*)(s_ + (l + 512) * 16) = bf[bi_][2]; if (fourth) *(LAS v4u*)(s_ + (768 + l) * 16) = bf[bi_][3]; } while (0)
            LD_CH(0, 0); WR_CH(0, 0);
            LD_CH(1, 1); LD_CH(2, 2); LD_CH(3, 3); LD_CH(4, 0);
            SC_BAR();
            for (int c = 0; c < NCH; c += 4) {
#define LD_STEP(k_) do { const int cc_ = c + (k_); if (cc_ + 1 < NCH) { WR_CH((cc_ + 1) & 1, ((k_) + 1) & 3); if (cc_ + 5 < NCH) LD_CH(cc_ + 5, ((k_) + 1) & 3); } SC_BAR(); } while (0)
                LD_STEP(0); LD_STEP(1); LD_STEP(2); LD_STEP(3);
#undef LD_STEP
            }
#undef LD_CH
#undef WR_CH
        }
    }
#undef SC_BAR
    if (split) { if (!scanner) ph_convert(F, (F.vcu >> 1) * NWAVES + F.wave, 128 * NWAVES); }
    else ph_convert(F, F.vcu * NWAVES + F.wave, F.G * NWAVES);
}

__device__ __forceinline__ void unpack8(const v4u u, float (&o)[8]) { o[0] = bflo(u.x); o[1] = bfhi(u.x); o[2] = bflo(u.y); o[3] = bfhi(u.y); o[4] = bflo(u.z); o[5] = bfhi(u.z); o[6] = bflo(u.w); o[7] = bfhi(u.w); }
__device__ __forceinline__ void ph_post(Frame& F) {
    const bf16* PROJ = (const bf16*)(F.ws + WS_PROJ); const float* mu = F.in[6]; const float* lnx_g = F.in[15]; const float* lnx_b = F.in[16];
    const bf16* YB = (const bf16*)(F.ws + WS_YB); const float* DOTRK = (const float*)(F.ws + WS_DOTRK); const bf16* RWG = (const bf16*)(F.ws + WS_G); bf16* MIX = (bf16*)F.out;
    const int gw = F.vcu * NWAVES + F.wave, NGW = F.G * NWAVES, j = F.lane * 8;
    float mv[8], lg[8], lb[8];
    { const f32x4 a = *(const f32x4*)(mu + RW_V + j), b = *(const f32x4*)(mu + RW_V + j + 4); mv[0] = a.x; mv[1] = a.y; mv[2] = a.z; mv[3] = a.w; mv[4] = b.x; mv[5] = b.y; mv[6] = b.z; mv[7] = b.w; }
    { const f32x4 a = *(const f32x4*)(lnx_g + j), b = *(const f32x4*)(lnx_g + j + 4); lg[0] = a.x; lg[1] = a.y; lg[2] = a.z; lg[3] = a.w; lg[4] = b.x; lg[5] = b.y; lg[6] = b.z; lg[7] = b.w; }
    { const f32x4 a = *(const f32x4*)(lnx_b + j), b = *(const f32x4*)(lnx_b + j + 4); lb[0] = a.x; lb[1] = a.y; lb[2] = a.z; lb[3] = a.w; lb[4] = b.x; lb[5] = b.y; lb[6] = b.z; lb[7] = b.w; }
    for (int m = gw; m < M; m += NGW) {
        const bool has_prev = (m & (SEQ - 1)) != 0;
        const v4u yu = *(const v4u*)(YB + (size_t)m * 512 + j);
        const bf16* pv = PROJ + (size_t)m * IN_COLS + C_RW + RW_V + j;
        const v4u vc = *(const v4u*)pv; v4u vp = (v4u){0u, 0u, 0u, 0u}; if (has_prev) vp = *(const v4u*)(pv - IN_COLS);
        const v4u gu = *(const v4u*)(RWG + (size_t)m * 512 + j);
        const float dot = DOTRK[(size_t)m * 8 + (F.lane >> 3)];
        float y[8], vc8[8], vp8[8], g8[8];
        unpack8(yu, y); unpack8(vc, vc8); unpack8(vp, vp8); unpack8(gu, g8);
        float sum = 0.f; float vv[8];
#pragma unroll
        for (int e = 0; e < 8; ++e) { vv[e] = vc8[e] + (vp8[e] - vc8[e]) * mv[e]; sum += y[e]; }
        sum = red8(sum);
        const float mean = sum * (1.f / 64.f); float q = 0.f;
#pragma unroll
        for (int e = 0; e < 8; ++e) { y[e] -= mean; q += y[e] * y[e]; }
        q = red8(q);
        const float rstd = rsqrtf(q * (1.f / 64.f) + GN_EPS);
        float o[8];
#pragma unroll
        for (int e = 0; e < 8; ++e) o[e] = ((y[e] * rstd) * lg[e] + lb[e] + dot * vv[e]) * g8[e];
        v4u w; w.x = pk2(o[0], o[1]); w.y = pk2(o[2], o[3]); w.z = pk2(o[4], o[5]); w.w = pk2(o[6], o[7]);
        *(v4u*)(MIX + (size_t)m * D + 512 + j) = w;
    }
}

__device__ __forceinline__ void ph_ln1(Frame& F) {
    const int gw = F.vcu * NWAVES + F.wave, NGW = F.G * NWAVES, lane = F.lane;
    const float* modp = (const float*)(F.ws + WS_MOD); const bf16* Y1 = (const bf16*)(F.ws + WS_Y1); bf16* H2 = (bf16*)(F.ws + WS_H);
    unsigned* H8 = (unsigned*)(F.ws + WS_H8); float* HS = (float*)(F.ws + WS_HS);
    const float* lng = F.in[18]; const float* lnb = F.in[19];
    const int rpw = M / NGW, m_begin = gw * rpw, m_end = m_begin + rpw;
    const float* md = modp + (m_begin >> 11) * 6144;
    f32x4 gt[4], sh[4], sc[4], gg[4], bb[4];
#pragma unroll
    for (int j = 0; j < 4; ++j) { const int col = 4 * lane + 256 * j; gt[j] = *(const f32x4*)(md + 2048 + col); sh[j] = *(const f32x4*)(md + 3072 + col); sc[j] = *(const f32x4*)(md + 4096 + col) + 1.0f;
        gg[j] = *(const f32x4*)(lng + col); bb[j] = *(const f32x4*)(lnb + col); }
    f32x4 xn[4]; v2u yn[4];
#define LN1_LOAD(m_) do { const float* x_ = F.in[0] + (size_t)(m_) * D; const bf16* y_ = Y1 + (size_t)(m_) * D; \
        _Pragma("unroll") for (int j = 0; j < 4; ++j) { xn[j] = *(const f32x4*)(x_ + 4 * lane + 256 * j); yn[j] = *(const v2u*)(y_ + 4 * lane + 256 * j); } } while (0)
    LN1_LOAD(m_begin);
    for (int m = m_begin; m < m_end; ++m) {
        f32x4 v[4]; float s = 0.f;
#pragma unroll
        for (int j = 0; j < 4; ++j) { const f32x4 yv = (f32x4){bflo(yn[j].x), bfhi(yn[j].x), bflo(yn[j].y), bfhi(yn[j].y)}; v[j] = xn[j] * ALPHA + gt[j] * yv; s += (v[j].x + v[j].y) + (v[j].z + v[j].w); }
        if (m + 1 < m_end) LN1_LOAD(m + 1);
        const float mean = wave_sum_f(s) * (1.f / D); float s2 = 0.f;
#pragma unroll
        for (int j = 0; j < 4; ++j) { v[j] = v[j] - mean; s2 += (v[j].x * v[j].x + v[j].y * v[j].y) + (v[j].z * v[j].z + v[j].w * v[j].w); }
        const float rstd = rsqrtf(wave_sum_f(s2) * (1.f / D) + LN_EPS);
        f32x4 h[4]; float am = 0.f;
#pragma unroll
        for (int j = 0; j < 4; ++j) { const int col = 4 * lane + 256 * j;
            const f32x4 x1 = (v[j] * rstd) * gg[j] + bb[j]; *(f32x4*)(F.out + (size_t)m * D + col) = x1;
            h[j] = x1 * sc[j] + sh[j];
            v2u o; o.x = pk2(h[j].x, h[j].y); o.y = pk2(h[j].z, h[j].w); *(v2u*)(H2 + (size_t)m * D + col) = o;
            am = fmaxf(am, fmaxf(fmaxf(fabsf(h[j].x), fabsf(h[j].y)), fmaxf(fabsf(h[j].z), fabsf(h[j].w)))); }
        am = fmaxf(wave_max(am), 1e-20f); const float inv = 127.f / am;
#pragma unroll
        for (int j = 0; j < 4; ++j) H8[(size_t)m * 256 + lane + 64 * j] = q4(h[j], inv, 0);
        if (lane == 0) HS[m] = am * (1.f / 127.f);
    }
#undef LN1_LOAD
}

__device__ __forceinline__ unsigned f2key(float f) { const unsigned u = __float_as_uint(f); return u ^ ((u >> 31) ? 0xffffffffu : 0x80000000u); }
__device__ __forceinline__ float key2f(unsigned k) { const unsigned u = (k >> 31) ? (k ^ 0x80000000u) : ~k; return __uint_as_float(u); }
#define TOPK_INSERT(L, key) do { unsigned k_ = (key); _Pragma("unroll") for (int q_ = 0; q_ < 16; ++q_) { const unsigned hi_ = L[q_] > k_ ? L[q_] : k_; k_ = L[q_] > k_ ? k_ : L[q_]; L[q_] = hi_; } } while (0)
__device__ __forceinline__ void ce_desc(unsigned& x, unsigned& y) { const unsigned hi = x > y ? x : y, lo = x > y ? y : x; x = hi; y = lo; }
__device__ __forceinline__ void bitonic_sort16_desc(unsigned (&a)[16]) {
#pragma unroll
    for (int k = 2; k <= 16; k <<= 1)
#pragma unroll
        for (int j = k >> 1; j > 0; j >>= 1)
#pragma unroll
            for (int i = 0; i < 16; ++i) { const int l = i ^ j; if (l > i) { if ((i & k) == 0) ce_desc(a[i], a[l]); else ce_desc(a[l], a[i]); } }
}
__device__ __forceinline__ void bitonic_merge16_desc(unsigned (&a)[16]) {
#pragma unroll
    for (int j = 8; j > 0; j >>= 1)
#pragma unroll
        for (int i = 0; i < 16; ++i) { const int l = i ^ j; if (l > i) ce_desc(a[i], a[l]); }
}
__device__ __forceinline__ void top16_absorb(unsigned (&L)[16], unsigned (&B)[16], bool first) {
    bitonic_sort16_desc(B);
    if (first) {
#pragma unroll
        for (int i = 0; i < 16; ++i) L[i] = B[i];
    } else {
#pragma unroll
        for (int i = 0; i < 16; ++i) L[i] = L[i] > B[15 - i] ? L[i] : B[15 - i];
        bitonic_merge16_desc(L);
    }
}
__device__ __forceinline__ unsigned pick_byte(const unsigned (&P)[4], unsigned i) {
    const unsigned long long lo = (unsigned long long)P[0] | ((unsigned long long)P[1] << 32), hi = (unsigned long long)P[2] | ((unsigned long long)P[3] << 32);
    const unsigned long long w = (i & 8u) ? hi : lo;
    return (unsigned)(w >> ((i & 7u) * 8u)) & 0xffu;
}
__device__ __forceinline__ void ph_topk(Frame& F) {
    const bf16* SC = (const bf16*)(F.ws + WS_SC); int* PIDX = (int*)(F.ws + WS_PIDX); float* PGATE = (float*)(F.ws + WS_PGATE);
    LAS float* scr = (LAS float*)(F.lds + F.wave * 16384);
    const int gw = F.vcu * NWAVES + F.wave, NGW = F.G * NWAVES, lane = F.lane;
    for (int item = gw; item < (M / 64) * 8; item += NGW) {
        const int bt = item >> 3, h = item & 7; const size_t t0 = (size_t)bt * 64;
        unsigned L0[16], L1[16];
#pragma unroll
        for (int q = 0; q < 16; ++q) { L0[q] = 0u; L1[q] = 0u; }
#pragma unroll
        for (int c = 0; c < 2; ++c) {
            for (int sub = 0; sub < 4; ++sub) {
                const bf16* src = SC + t0 * NSC + (h * 2 + c) * 128 + sub * 32;
#pragma unroll
                for (int it = 0; it < 8; ++it) { const int row = it * 8 + (lane >> 3), c4 = (lane & 7) * 4; const v2u v = *(const v2u*)(src + (size_t)row * NSC + c4);
                    LAS float* d = scr + row * 33 + c4; d[0] = bflo(v.x); d[1] = bfhi(v.x); d[2] = bflo(v.y); d[3] = bfhi(v.y); }
                LDS_WAIT(); asm volatile("" ::: "memory");
#pragma unroll
                for (int hb = 0; hb < 2; ++hb) {
                    unsigned Bq[16];
#pragma unroll
                    for (int ci = 0; ci < 16; ++ci) { const float x = scr[lane * 33 + hb * 16 + ci]; Bq[ci] = (f2key(x) & ~127u) | (unsigned)(127 - (sub * 32 + hb * 16 + ci)); }
                    if (c == 0) top16_absorb(L0, Bq, sub == 0 && hb == 0); else top16_absorb(L1, Bq, sub == 0 && hb == 0);
                }
                LDS_WAIT(); asm volatile("" ::: "memory");
            }
        }
        float v0[16], v1[16]; unsigned P0[4] = {0u, 0u, 0u, 0u}, P1[4] = {0u, 0u, 0u, 0u};
#pragma unroll
        for (int q = 0; q < 16; ++q) { v0[q] = key2f(L0[q] & ~127u); v1[q] = key2f(L1[q] & ~127u);
            P0[q >> 2] |= (127u - (L0[q] & 127u)) << ((q & 3) * 8); P1[q >> 2] |= (127u - (L1[q] & 127u)) << ((q & 3) * 8); }
        unsigned Fk[16];
        {
            unsigned Bq[16]; int nq = 0; bool first = true;
#pragma unroll
            for (int i = 0; i < 16; ++i)
#pragma unroll
                for (int j = 0; j < 16; ++j) if ((i + 1) * (j + 1) <= 16) {
                    Bq[nq] = (f2key(v0[i] + v1[j]) & ~255u) | (unsigned)(255 - (i * 16 + j)); ++nq;
                    if (nq == 16) { top16_absorb(Fk, Bq, first); first = false; nq = 0; }
                }
#pragma unroll
            for (int q = 2; q < 16; ++q) Bq[q] = 0u;
            top16_absorb(Fk, Bq, false);
        }
        float fv[16]; const float fmax_ = key2f(Fk[0] & ~255u); float sum = 0.f;
#pragma unroll
        for (int q = 0; q < 16; ++q) { fv[q] = __expf(key2f(Fk[q] & ~255u) - fmax_); sum += fv[q]; }
        const float rs = 1.f / sum;
        int* pi = PIDX + (t0 + lane) * 128 + h * 16; float* pg = PGATE + (t0 + lane) * 128 + h * 16;
#pragma unroll
        for (int q4 = 0; q4 < 4; ++q4) {
            int e[4]; float gg[4];
#pragma unroll
            for (int r = 0; r < 4; ++r) { const int q = q4 * 4 + r; const unsigned code = 255u - (Fk[q] & 255u); const unsigned i = code >> 4, j = code & 15u;
                e[r] = (int)(pick_byte(P0, i) * 128u + pick_byte(P1, j)); gg[r] = fv[q] * rs; }
            *(int4*)(pi + q4 * 4) = make_int4(e[0], e[1], e[2], e[3]); *(f32x4*)(pg + q4 * 4) = (f32x4){gg[0], gg[1], gg[2], gg[3]};
        }
    }
}

__device__ __forceinline__ int dot16(const v4u a, const v4u b) {
    int s = __builtin_amdgcn_sdot4((int)a.x, (int)b.x, 0, false); s = __builtin_amdgcn_sdot4((int)a.y, (int)b.y, s, false);
    s = __builtin_amdgcn_sdot4((int)a.z, (int)b.z, s, false); return __builtin_amdgcn_sdot4((int)a.w, (int)b.w, s, false);
}
constexpr int UD_R = 5;
struct UdTok { v4u u[UD_R][4]; unsigned ent[UD_R]; float us[UD_R], vs[UD_R]; };
__device__ __forceinline__ int ud_compact(LAS unsigned* lst, int e0, int e1, int x, int lane) {
    const bool m0 = (e0 >> 11) == x, m1 = (e1 >> 11) == x;
    const unsigned long long b0 = __ballot(m0), b1 = __ballot(m1);
    const int cnt0 = __popcll(b0), cnt = cnt0 + __popcll(b1);
    const int p0 = __builtin_amdgcn_mbcnt_hi((unsigned)(b0 >> 32), __builtin_amdgcn_mbcnt_lo((unsigned)b0, 0u));
    const int p1 = cnt0 + __builtin_amdgcn_mbcnt_hi((unsigned)(b1 >> 32), __builtin_amdgcn_mbcnt_lo((unsigned)b1, 0u));
    if (m0) lst[p0] = (unsigned)lane | ((unsigned)e0 << 8);
    if (m1) lst[p1] = (unsigned)(lane + 64) | ((unsigned)e1 << 8);
    return cnt;
}
__device__ __forceinline__ void ud_issue(UdTok& S, const LAS unsigned* lst, int base, int cnt, const unsigned char* U8, const float* US, const float* VS, int li, int gg) {
#pragma unroll
    for (int rr = 0; rr < UD_R; ++rr) if (base + 4 * rr < cnt) {
        const int idx = base + 4 * rr + gg; const unsigned en = lst[idx < cnt ? idx : cnt - 1]; S.ent[rr] = en;
        const unsigned char* up = U8 + (size_t)(en >> 8) * 1024 + 16 * li;
#pragma unroll
        for (int c = 0; c < 4; ++c) S.u[rr][c] = *(const v4u*)(up + 256 * c);
        S.us[rr] = US[en >> 8]; S.vs[rr] = VS[en >> 8];
    }
}
__device__ __forceinline__ void ud_compute(const UdTok& S, const LAS unsigned char* hrow, int base, int cnt, float hs, float g0, float g1, float* coefrow, int li, int gg) {
    const v4u h0 = *(const LAS v4u*)(hrow + 16 * li), h1 = *(const LAS v4u*)(hrow + 16 * li + 256), h2 = *(const LAS v4u*)(hrow + 16 * li + 512), h3 = *(const LAS v4u*)(hrow + 16 * li + 768);
    float d[UD_R];
#pragma unroll
    for (int rr = 0; rr < UD_R; ++rr) { d[rr] = 0.f; if (base + 4 * rr < cnt) {
        const int dsum = (dot16(S.u[rr][0], h0) + dot16(S.u[rr][1], h1)) + (dot16(S.u[rr][2], h2) + dot16(S.u[rr][3], h3));
        d[rr] = red16((float)dsum) * (hs * S.us[rr]); } }
    float d0 = d[0], d1 = d[1], d2 = d[2], d3 = d[3], d4 = d[4], v0 = S.vs[0], v1 = S.vs[1], v2 = S.vs[2], v3 = S.vs[3], v4 = S.vs[4]; unsigned n0 = S.ent[0], n1 = S.ent[1], n2 = S.ent[2], n3 = S.ent[3], n4 = S.ent[4];
    asm volatile("" : "+v"(d0), "+v"(d1), "+v"(d2), "+v"(d3), "+v"(d4), "+v"(v0), "+v"(v1), "+v"(v2), "+v"(v3), "+v"(v4), "+v"(n0), "+v"(n1), "+v"(n2), "+v"(n3), "+v"(n4));
    const bool s1 = li == 1, s2 = li == 2, s3 = li == 3, s4 = li == 4;
    float dd = s1 ? d1 : d0; dd = s2 ? d2 : dd; dd = s3 ? d3 : dd; dd = s4 ? d4 : dd;
    float vs = s1 ? v1 : v0; vs = s2 ? v2 : vs; vs = s3 ? v3 : vs; vs = s4 ? v4 : vs;
    unsigned en = s1 ? n1 : n0; en = s2 ? n2 : en; en = s3 ? n3 : en; en = s4 ? n4 : en;
    const float act = 0.5f * dd * (1.f + erff(dd * 0.70710678118654752f));
    const int slot = (int)(en & 255u);
    const float ga = __shfl(g0, slot & 63), gb = __shfl(g1, slot & 63); const float gate = slot < 64 ? ga : gb;
    if (li < UD_R && base + 4 * li + gg < cnt) coefrow[slot] = act * gate * vs;
}
__device__ __forceinline__ void ph_udot(Frame& F) {
    const int lane = F.lane, li = lane & 15, gg = lane >> 4, x = blockIdx.x & 7, jw = (int)(blockIdx.x >> 3) * NWAVES + F.wave, NJW = (F.G >> 3) * NWAVES;
    const int* PIDX = (const int*)(F.ws + WS_PIDX); const float* PGATE = (const float*)(F.ws + WS_PGATE);
    const unsigned char* U8 = (const unsigned char*)(F.ws + WS_U8); const unsigned char* H8 = (const unsigned char*)(F.ws + WS_H8);
    const float* US = (const float*)(F.ws + WS_US); const float* VS = (const float*)(F.ws + WS_VS); const float* HS = (const float*)(F.ws + WS_HS);
    float* COEF = (float*)(F.ws + WS_COEF);
    LAS unsigned* lstA = (LAS unsigned*)(F.lds + F.wave * 16384); LAS unsigned* lstB = lstA + 128;
    LAS unsigned char* hA = F.lds + F.wave * 16384 + 1024; LAS unsigned char* hB = hA + 1024;
    const int tpw = M / NJW, t_begin = jw * tpw, t_end = t_begin + tpw;
    int nA0, nA1, nB0, nB1; float nAg0, nAg1, nBg0, nBg1, nAhs, nBhs;
#define UD_LOAD(t_) do { const size_t o_ = (size_t)(t_) * 128; nA0 = PIDX[o_ + lane]; nA1 = PIDX[o_ + 64 + lane]; nAg0 = PGATE[o_ + lane]; nAg1 = PGATE[o_ + 64 + lane]; nAhs = HS[(t_)]; \
        nB0 = PIDX[o_ + 128 + lane]; nB1 = PIDX[o_ + 192 + lane]; nBg0 = PGATE[o_ + 128 + lane]; nBg1 = PGATE[o_ + 192 + lane]; nBhs = HS[(t_) + 1]; } while (0)
    UD_LOAD(t_begin);
    for (int t = t_begin; t < t_end; t += 2) {
        const int A0 = nA0, A1 = nA1, B0 = nB0, B1 = nB1; const float Ag0 = nAg0, Ag1 = nAg1, Bg0 = nBg0, Bg1 = nBg1, Ahs = nAhs, Bhs = nBhs;
        { const v4u nAh = *(const v4u*)(H8 + (size_t)t * 1024 + 16 * lane), nBh = *(const v4u*)(H8 + (size_t)(t + 1) * 1024 + 16 * lane); *(LAS v4u*)(hA + 16 * lane) = nAh; *(LAS v4u*)(hB + 16 * lane) = nBh; }
        if (t + 2 < t_end) UD_LOAD(t + 2);
        const int cntA = ud_compact(lstA, A0, A1, x, lane), cntB = ud_compact(lstB, B0, B1, x, lane);
        LDS_WAIT(); asm volatile("" ::: "memory");
        const int cmax = cntA > cntB ? cntA : cntB;
        for (int base = 0; base < cmax; base += 4 * UD_R) {
            UdTok SA, SB;
            ud_issue(SA, lstA, base, cntA, U8, US, VS, li, gg);
            ud_issue(SB, lstB, base, cntB, U8, US, VS, li, gg);
            ud_compute(SA, hA, base, cntA, Ahs, Ag0, Ag1, COEF + (size_t)t * 128, li, gg);
            ud_compute(SB, hB, base, cntB, Bhs, Bg0, Bg1, COEF + (size_t)(t + 1) * 128, li, gg);
        }
        LDS_WAIT(); asm volatile("" ::: "memory");
    }
#undef UD_LOAD
}

__device__ __forceinline__ void va_issue(v4u (&v)[16], v4u& cq, const LAS int* sI, const LAS unsigned char* sQ, const unsigned char* V8, int sub, int sg) {
    cq = *(const LAS v4u*)(sQ + sg * 16);
#pragma unroll
    for (int it = 0; it < 16; ++it) { const int e = sI[it * 8 + sg]; v[it] = *(const v4u*)(V8 + (size_t)e * 128 + 16 * sub); }
}
__device__ __forceinline__ void va_compute(const v4u (&v)[16], const v4u cq, float scale, float* yrow, int lane) {
    int acc[16];
#pragma unroll
    for (int i = 0; i < 16; ++i) acc[i] = 0;
    const unsigned cqa[4] = {cq.x, cq.y, cq.z, cq.w};
#pragma unroll
    for (int G = 0; G < 4; ++G) {
        const unsigned r0[4] = {v[4 * G].x, v[4 * G].y, v[4 * G].z, v[4 * G].w}, r1[4] = {v[4 * G + 1].x, v[4 * G + 1].y, v[4 * G + 1].z, v[4 * G + 1].w};
        const unsigned r2[4] = {v[4 * G + 2].x, v[4 * G + 2].y, v[4 * G + 2].z, v[4 * G + 2].w}, r3[4] = {v[4 * G + 3].x, v[4 * G + 3].y, v[4 * G + 3].z, v[4 * G + 3].w};
#pragma unroll
        for (int k = 0; k < 4; ++k) {
            const unsigned ablo = __builtin_amdgcn_perm(r1[k], r0[k], 0x05010400u), abhi = __builtin_amdgcn_perm(r1[k], r0[k], 0x07030602u);
            const unsigned cdlo = __builtin_amdgcn_perm(r3[k], r2[k], 0x05010400u), cdhi = __builtin_amdgcn_perm(r3[k], r2[k], 0x07030602u);
            const unsigned t0 = __builtin_amdgcn_perm(cdlo, ablo, 0x05040100u), t1 = __builtin_amdgcn_perm(cdlo, ablo, 0x07060302u);
            const unsigned t2 = __builtin_amdgcn_perm(cdhi, abhi, 0x05040100u), t3 = __builtin_amdgcn_perm(cdhi, abhi, 0x07060302u);
            acc[4 * k] = __builtin_amdgcn_sdot4((int)t0, (int)cqa[G], acc[4 * k], false); acc[4 * k + 1] = __builtin_amdgcn_sdot4((int)t1, (int)cqa[G], acc[4 * k + 1], false);
            acc[4 * k + 2] = __builtin_amdgcn_sdot4((int)t2, (int)cqa[G], acc[4 * k + 2], false); acc[4 * k + 3] = __builtin_amdgcn_sdot4((int)t3, (int)cqa[G], acc[4 * k + 3], false);
        }
    }
    int n8[8], n4[4], n2[2];
#pragma unroll
    for (int i = 0; i < 8; ++i) { auto r = __builtin_amdgcn_permlane32_swap((unsigned)acc[i], (unsigned)acc[i + 8], false, false); n8[i] = (int)r[0] + (int)r[1]; }
#pragma unroll
    for (int i = 0; i < 4; ++i) { auto r = __builtin_amdgcn_permlane16_swap((unsigned)n8[i], (unsigned)n8[i + 4], false, false); n4[i] = (int)r[0] + (int)r[1]; }
    const bool b3 = (lane & 8) != 0;
#pragma unroll
    for (int i = 0; i < 2; ++i) { const int send = b3 ? n4[i] : n4[i + 2], keep = b3 ? n4[i + 2] : n4[i];
        const int recv = __builtin_amdgcn_update_dpp(0, send, 0x128, 0xf, 0xf, false); n2[i] = keep + recv; }
    typedef float f32x2v __attribute__((ext_vector_type(2)));
    *(f32x2v*)(yrow + 16 * (lane & 7) + 2 * (lane >> 3)) = (f32x2v){(float)n2[0] * scale, (float)n2[1] * scale};
}
__device__ __forceinline__ float va_stage(LAS int* sI, LAS unsigned char* sQ, int e0, int e1, float c0, float c1, int lane) {
    const float am = fmaxf(wave_max(fmaxf(fabsf(c0), fabsf(c1))), 1e-30f), inv = 127.f / am;
    sI[lane] = e0; sI[lane + 64] = e1;
    sQ[(lane & 7) * 16 + (lane >> 3)] = (unsigned char)((int)rintf(c0 * inv) & 0xff); sQ[(lane & 7) * 16 + 8 + (lane >> 3)] = (unsigned char)((int)rintf(c1 * inv) & 0xff);
    return am * (1.f / 127.f);
}
__device__ __forceinline__ void ph_vacc(Frame& F) {
    const int lane = F.lane, x = blockIdx.x & 7, jw = (int)(blockIdx.x >> 3) * NWAVES + F.wave, NJW = (F.G >> 3) * NWAVES;
    const int* PIDX = (const int*)(F.ws + WS_PIDX); const float* COEF = (const float*)(F.ws + WS_COEF);
    const unsigned char* V8 = (const unsigned char*)(F.ws + WS_V8) + (size_t)x * 16384 * 128;
    float* YS = (float*)(F.ws + WS_YS);
    LAS int* sIA = (LAS int*)(F.lds + F.wave * 16384); LAS unsigned char* sQA = (LAS unsigned char*)(F.lds + F.wave * 16384 + 512);
    LAS int* sIB = (LAS int*)(F.lds + F.wave * 16384 + 1024); LAS unsigned char* sQB = (LAS unsigned char*)(F.lds + F.wave * 16384 + 1536);
    const int tpw = M / NJW, t_begin = jw * tpw, t_end = t_begin + tpw;
    const int sub = lane & 7, sg = lane >> 3;
    int nA0, nA1, nB0, nB1; float nAc0, nAc1, nBc0, nBc1;
#define VA_LOAD(t_) do { const size_t o_ = (size_t)(t_) * 128; nA0 = PIDX[o_ + lane]; nA1 = PIDX[o_ + 64 + lane]; nAc0 = COEF[o_ + lane]; nAc1 = COEF[o_ + 64 + lane]; \
        nB0 = PIDX[o_ + 128 + lane]; nB1 = PIDX[o_ + 192 + lane]; nBc0 = COEF[o_ + 128 + lane]; nBc1 = COEF[o_ + 192 + lane]; } while (0)
    VA_LOAD(t_begin);
    for (int t = t_begin; t < t_end; t += 2) {
        const float scA = va_stage(sIA, sQA, nA0, nA1, nAc0, nAc1, lane), scB = va_stage(sIB, sQB, nB0, nB1, nBc0, nBc1, lane);
        if (t + 2 < t_end) VA_LOAD(t + 2);
        LDS_WAIT(); asm volatile("" ::: "memory");
        v4u vA[16], vB[16], qA, qB;
        va_issue(vA, qA, sIA, sQA, V8, sub, sg);
        va_issue(vB, qB, sIB, sQB, V8, sub, sg);
        va_compute(vA, qA, scA, YS + (size_t)t * D + 128 * x, lane);
        va_compute(vB, qB, scB, YS + (size_t)(t + 1) * D + 128 * x, lane);
        LDS_WAIT(); asm volatile("" ::: "memory");
    }
#undef VA_LOAD
}

__device__ __forceinline__ void ph_ln2(Frame& F) {
    const int gw = F.vcu * NWAVES + F.wave, NGW = F.G * NWAVES, lane = F.lane;
    const float* modp = (const float*)(F.ws + WS_MOD); const float* YS = (const float*)(F.ws + WS_YS);
    const float* lng = F.in[24]; const float* lnb = F.in[25];
    const int rpw = M / NGW, m_begin = gw * rpw, m_end = m_begin + rpw;
    const float* md = modp + (m_begin >> 11) * 6144 + 5120;
    f32x4 gt[4], gg[4], bb[4];
#pragma unroll
    for (int j = 0; j < 4; ++j) { const int col = 4 * lane + 256 * j; gt[j] = *(const f32x4*)(md + col); gg[j] = *(const f32x4*)(lng + col); bb[j] = *(const f32x4*)(lnb + col); }
    f32x4 xn[4], yn[4];
#define LN2_LOAD(m_) do { const float* x_ = F.out + (size_t)(m_) * D; const float* y_ = YS + (size_t)(m_) * D; \
        _Pragma("unroll") for (int j = 0; j < 4; ++j) { xn[j] = *(const f32x4*)(x_ + 4 * lane + 256 * j); yn[j] = *(const f32x4*)(y_ + 4 * lane + 256 * j); } } while (0)
    LN2_LOAD(m_begin);
    for (int m = m_begin; m < m_end; ++m) {
        f32x4 v[4]; float s = 0.f;
#pragma unroll
        for (int j = 0; j < 4; ++j) { v[j] = xn[j] * ALPHA + gt[j] * yn[j]; s += (v[j].x + v[j].y) + (v[j].z + v[j].w); }
        if (m + 1 < m_end) LN2_LOAD(m + 1);
        const float mean = wave_sum_f(s) * (1.f / D); float s2 = 0.f;
#pragma unroll
        for (int j = 0; j < 4; ++j) { v[j] = v[j] - mean; s2 += (v[j].x * v[j].x + v[j].y * v[j].y) + (v[j].z * v[j].z + v[j].w * v[j].w); }
        const float rstd = rsqrtf(wave_sum_f(s2) * (1.f / D) + LN_EPS);
#pragma unroll
        for (int j = 0; j < 4; ++j) *(f32x4*)(F.out + (size_t)m * D + 4 * lane + 256 * j) = (v[j] * rstd) * gg[j] + bb[j];
    }
#undef LN2_LOAD
}

struct Args { const float* in[26]; float* out; unsigned char* ws; int ph_lo, ph_hi, li, pad; };
__global__ void __launch_bounds__(NWAVES * 64, 2) hymba_fwd(Args args) {
    extern __shared__ __attribute__((aligned(16))) unsigned char lds[];
    Frame F;
    F.lds = (LAS unsigned char*)lds;
    F.MISC = (volatile LAS unsigned*)(F.lds + MISC_OFF);
    F.tid = threadIdx.x; F.lane = F.tid & 63; F.wave = __builtin_amdgcn_readfirstlane(F.tid >> 6);
    F.G = gridDim.x; { const int bx = blockIdx.x; F.vcu = (F.G % 8 == 0) ? (bx % 8) * (F.G / 8) + bx / 8 : bx; }
    F.ws = args.ws; F.out = args.out; F.ctl = (gu32*)(args.ws + WS_CTL);
#pragma unroll
    for (int i = 0; i < 26; ++i) F.in[i] = args.in[i];
    for (int u = F.tid; u < (LDS_BYTES - LDSCTL_OFF) / 4; u += NWAVES * 64) ((LAS unsigned*)(F.lds + LDSCTL_OFF))[u] = 0u;
    __syncthreads();
    XcdBarrier bar; bar.bar = (unsigned*)(F.ctl + CW_BAR); bar.x = 0; bar.st = nullptr;
    if (N_LAUNCHES == 1) bar = xcd_barrier_post((unsigned*)(F.ctl + CW_BAR), F.MISC + 8);
#define GRID_BAR() do { if (N_LAUNCHES == 1) xcd_barrier(bar); } while (0)
    const int lo = args.ph_lo, hi = args.ph_hi;
#ifndef PHMASK
#define PHMASK 0x1fff
#endif
#define IN(k) (((PHMASK >> (k)) & 1) && lo <= (k) && (k) < hi)
#define REP(k) for (int rep_ = 0; rep_ < 1 + ((DBLMASK >> (k)) & 1); ++rep_)
#define BOTH(k) (IN(k) && IN((k) + 1))
    bf16* WinT = (bf16*)(F.ws + WS_WIN); bf16* WoutT = (bf16*)(F.ws + WS_WOUT); bf16* WpT = (bf16*)(F.ws + WS_WP);
    bf16* HB = (bf16*)(F.ws + WS_H); bf16* PROJ = (bf16*)(F.ws + WS_PROJ); bf16* MIX = (bf16*)F.out; bf16* Y1 = (bf16*)(F.ws + WS_Y1); float* SCp = (float*)(F.ws + WS_SC);

    if (IN(0)) REP(0) { ph_mod(F); if (F.G > 96) { if ((int)blockIdx.x >= 96) ph_weights(F, ((int)blockIdx.x - 96) * NWAVES + F.wave, (F.G - 96) * NWAVES); } else ph_weights(F, F.vcu * NWAVES + F.wave, F.G * NWAVES); if (BOTH(0)) GRID_BAR(); }
    if (IN(1)) REP(1) { ph_prologue(F); if (BOTH(1)) GRID_BAR(); }
    if (IN(2)) REP(2) {
        pg8::Gemm g{HB, WinT, M, IN_COLS, D}; pg8::StaticOrder S; S.init(M, IN_COLS, F.G, (int)blockIdx.x);
        pg8::EpiBf16<0> E{PROJ, IN_COLS, nullptr, 0, 0, 1.f};
        pg8::gemm_phase<pg8::EpiBf16<0>, pg8::StaticOrder, true, true>(F.lds + RING_OFF, g, S, E);
        if (BOTH(2)) GRID_BAR();
    }
    if (IN(3)) {
#ifndef NO_ATTN
        for (int rep_ = 0; rep_ < 1 + ((DBLMASK >> 13) & 1); ++rep_) ph_attn(F);
#endif
        for (int rep_ = 0; rep_ < 1 + ((DBLMASK >> 14) & 1); ++rep_) ph_prep(F);
        if (BOTH(3)) GRID_BAR();
    }
    if (IN(4)) REP(4) { ph_scan(F); if (BOTH(4)) GRID_BAR(); }
    if (IN(5)) REP(5) { ph_post(F); if (BOTH(5)) GRID_BAR(); }
    if (IN(6)) REP(6) {
        pg8::Gemm g{MIX, WoutT, M, D, D}; pg8::StaticOrder S; S.init(M, D, F.G, (int)blockIdx.x);
        pg8::EpiBf16<0> E{Y1, D, nullptr, 0, 0, 1.f};
        pg8::gemm_phase<pg8::EpiBf16<0>, pg8::StaticOrder, true, true>(F.lds + RING_OFF, g, S, E);
        if (BOTH(6)) GRID_BAR();
    }
    if (IN(7)) REP(7) { ph_ln1(F); if (BOTH(7)) GRID_BAR(); }
    if (IN(8)) REP(8) {
        pg8::Gemm g{HB, WpT, M, NSC, D}; pg8::StaticOrder S; S.init(M, NSC, F.G, (int)blockIdx.x);
        pg8::EpiBf16<0> E{(bf16*)SCp, NSC, nullptr, 0, 0, 1.f};
        pg8::gemm_phase<pg8::EpiBf16<0>, pg8::StaticOrder, true, true>(F.lds + RING_OFF, g, S, E);
        if (BOTH(8)) GRID_BAR();
    }
    if (IN(9)) REP(9) { ph_topk(F); if (BOTH(9)) GRID_BAR(); }
    if (IN(10)) REP(10) { ph_udot(F); if (BOTH(10)) GRID_BAR(); }
    if (IN(11)) REP(11) { ph_vacc(F); if (BOTH(11)) GRID_BAR(); }
    if (IN(12)) { ph_ln2(F); }
#undef IN
#undef BOTH
#undef GRID_BAR
}

extern "C" void kernel_launch(void* const* d_in, const int* in_sizes, int n_in, void* d_out, int out_size, void* d_ws, size_t ws_size, hipStream_t stream) {
    static int grid = 0;
    if (grid == 0) {
        if (n_in != 26 || in_sizes[0] != M * D || out_size != M * D || ws_size < WS_END) { fprintf(stderr, "kernel_launch: unexpected shapes (n_in %d, in0 %d, out %d, ws %zu); nothing launched\n", n_in, n_in > 0 ? in_sizes[0] : -1, out_size, ws_size); grid = -1; return; }
        int dev = 0, cus = 0, per_cu = 0;
        if (hipGetDevice(&dev) != hipSuccess || hipDeviceGetAttribute(&cus, hipDeviceAttributeMultiprocessorCount, dev) != hipSuccess) { fprintf(stderr, "kernel_launch: device query failed\n"); grid = -1; return; }
        if (hipFuncSetAttribute((const void*)hymba_fwd, hipFuncAttributeMaxDynamicSharedMemorySize, LDS_BYTES) != hipSuccess) { fprintf(stderr, "kernel_launch: hipFuncSetAttribute failed\n"); grid = -1; return; }
        if (hipOccupancyMaxActiveBlocksPerMultiprocessor(&per_cu, (const void*)hymba_fwd, NWAVES * 64, LDS_BYTES) != hipSuccess || per_cu < 1)
            fprintf(stderr, "kernel_launch: note: occupancy query reports %d workgroups per CU\n", per_cu);
        (void)hipGetLastError();
        grid = cus;
    }
    if (grid < 0) return;
    if (hipMemsetAsync((char*)d_ws + WS_CTL, 0, CTL_ZERO_BYTES, stream) != hipSuccess) { fprintf(stderr, "kernel_launch: memset failed\n"); return; }
    Args a{};
    for (int i = 0; i < 26; ++i) a.in[i] = (const float*)d_in[i];
    a.out = (float*)d_out; a.ws = (unsigned char*)d_ws;
    for (int li = 0; li < N_LAUNCHES; ++li) {
        a.ph_lo = (N_LAUNCHES == 1) ? 0 : li; a.ph_hi = (N_LAUNCHES == 1) ? N_PHASES : li + 1; a.li = li;
        hipLaunchKernelGGL(hymba_fwd, dim3(grid), dim3(NWAVES * 64), LDS_BYTES, stream, a);
        const hipError_t le = hipPeekAtLastError();
        if (le != hipSuccess) { fprintf(stderr, "kernel_launch: launch %d failed: %s\n", li, hipGetErrorName(le)); break; }
    }
}
```

```cpp
#include <hip/hip_runtime.h>
#ifndef DBLMASK
#define DBLMASK 0
#endif
#include <cstdio>
#include <cstdint>
#include <cmath>
namespace pg8 {
#define PG8_LAS __attribute__((address_space(3)))
typedef unsigned short bf16_t;
typedef short bf16x8 __attribute__((ext_vector_type(8)));
typedef float f32x4 __attribute__((ext_vector_type(4)));
typedef int i32x4_ __attribute__((ext_vector_type(4)));
typedef unsigned u32x4 __attribute__((ext_vector_type(4)));
constexpr int BM = 256, BK = 64, HALF = 128, HTB = HALF * BK * 2  , STAGE_BYTES = 8 * HTB, NXCD = 8, WGM = 8;

__host__ __device__ __forceinline__ int lds_byte(int r, int c) { const int st = (r >> 4) * 2 + (c >> 5), rr = r & 15, cc = c & 31, ob = rr * 64 + cc * 2; return st * 1024 + (ob ^ (((ob >> 9) & 1) << 5)); }
__host__ __device__ __forceinline__ void stage_rc(int b, int& R, int& C) { const int st = b / 1024, sb = b % 1024, swz = sb ^ (((sb >> 9) & 1) << 5); R = (st >> 1) * 16 + swz / 64; C = (st & 1) * 32 + (swz % 64) / 2; }
__host__ __device__ __forceinline__ int perm32(int rho) { const int n = rho >> 4, i = rho & 15; return 8 * (i >> 2) + 4 * n + (i & 3); }

struct Unit { int pm, pn; };
struct Gemm { const bf16_t* A; const bf16_t* Bt; int M, N, K; };

struct StaticOrder {
    int nM, nN, nwg, G, c;
    __host__ __device__ void init(int M, int N, int G_, int c_) { nM = M / BM; nN = N / BM; nwg = nM * nN; G = G_; c = c_; }
    __host__ __device__ bool next(int i, Unit& u) const {
        const long L = (long)i * G + c; if (L >= nwg) return false;
        int wgid = (int)L; { const int q = nwg / NXCD, r = nwg % NXCD, xcd = wgid % NXCD, off = wgid / NXCD; wgid = (xcd < r ? xcd * (q + 1) : r * (q + 1) + (xcd - r) * q) + off; }
        const int nig = WGM * nN, gid = wgid / nig, fm = gid * WGM, gsz = (nM - fm) < WGM ? (nM - fm) : WGM;
        u.pm = fm + ((wgid % nig) % gsz); u.pn = (wgid % nig) / gsz; return true;
    }
    __device__ __forceinline__ void a_ready(const Unit&) const {}
    __device__ __forceinline__ void done(const Unit&) const {}
};

__device__ __forceinline__ unsigned cvt_pk_bf16(float lo, float hi) { unsigned r; asm volatile("v_cvt_pk_bf16_f32 %0, %1, %2" : "=v"(r) : "v"(lo), "v"(hi)); return r; }
typedef float f32x2 __attribute__((ext_vector_type(2)));
__device__ __forceinline__ f32x2 gelu_pk(f32x2 v) {
    const f32x2 av = __builtin_elementwise_abs(v), d = av * 0.2316418882f + 1.0f;
    f32x2 t; t.x = __builtin_amdgcn_rcpf(d.x); t.y = __builtin_amdgcn_rcpf(d.y);
    f32x2 q = t * 0.5307027145f + (-0.7265760135f); q = q * t + 0.7107068705f; q = q * t + (-0.142248368f); q = q * t + 0.127414796f; q = q * t;
    const f32x2 s = (v * v) * (-0.72134752044f);
    f32x2 e; e.x = __builtin_amdgcn_exp2f(s.x); e.y = __builtin_amdgcn_exp2f(s.y);
    const f32x2 m = v * (q * e), r = v - m;
    f32x2 o; o.x = v.x < 0.f ? m.x : r.x; o.y = v.y < 0.f ? m.y : r.y; return o;
}

typedef short s16x2_ __attribute__((ext_vector_type(2)));
__device__ __forceinline__ unsigned key16x2(unsigned w) {
    const unsigned m = __builtin_bit_cast(unsigned, (s16x2_)(__builtin_bit_cast(s16x2_, w) >> (short)15));
    return w ^ (m | 0x80008000u);
}
template <int ACT  , bool KEY = false  > struct EpiBf16 {
    static constexpr bool PERM = true, AFTER_DRAIN = false; static_assert(ACT == 0 || ACT == 1, "EpiBf16: ACT is 0 (none) or 1 (gelu_pk)");
    bf16_t* O; int ldc; const float* bias; int split_cols; size_t split_stride; float scale0;
    __device__ __forceinline__ void operator()(const f32x4 (&acc)[2][2][4][2], const Unit& u, int wr, int wc, int fr, int fq) const {
        const int row0 = u.pm * BM + wr * 64 + fr; int colt = u.pn * BM; bf16_t* base = O;
        float sc = 1.f; if (split_cols) { const int t = colt / split_cols; base += (size_t)t * split_stride; colt -= t * split_cols; if (t == 0) sc = scale0; }
        const int col0 = colt + wc * 32 + 8 * fq, bcol0 = u.pn * BM + wc * 32 + 8 * fq;
        f32x4 bv[2][2];
#pragma unroll
        for (int bj = 0; bj < 2; ++bj)
#pragma unroll
            for (int n = 0; n < 2; ++n) bv[bj][n] = bias ? *(const f32x4*)(bias + bcol0 + bj * HALF + 4 * n) : (f32x4){0.f, 0.f, 0.f, 0.f};
#pragma unroll
        for (int ai = 0; ai < 2; ++ai)
#pragma unroll
            for (int m = 0; m < 4; ++m) { bf16_t* rowp = base + (size_t)(row0 + ai * HALF + m * 16) * ldc + col0;
#pragma unroll
                for (int bj = 0; bj < 2; ++bj) { f32x4 v0 = acc[ai][bj][m][0] + bv[bj][0], v1 = acc[ai][bj][m][1] + bv[bj][1];
                    if (ACT == 1) { f32x2 a = gelu_pk((f32x2){v0[0], v0[1]}), b = gelu_pk((f32x2){v0[2], v0[3]}), c = gelu_pk((f32x2){v1[0], v1[1]}), d = gelu_pk((f32x2){v1[2], v1[3]});
                        v0 = (f32x4){a.x, a.y, b.x, b.y}; v1 = (f32x4){c.x, c.y, d.x, d.y}; }
                    v0 = v0 * sc; v1 = v1 * sc; u32x4 w; w.x = cvt_pk_bf16(v0[0], v0[1]); w.y = cvt_pk_bf16(v0[2], v0[3]); w.z = cvt_pk_bf16(v1[0], v1[1]); w.w = cvt_pk_bf16(v1[2], v1[3]);
                    if (KEY) { w.x = key16x2(w.x); w.y = key16x2(w.y); w.z = key16x2(w.z); w.w = key16x2(w.w); }
                    *(u32x4*)(rowp + bj * HALF) = w; } }
    }
};
template <bool KEY> struct EpiI8 {
    static constexpr bool PERM = true, AFTER_DRAIN = false;
    bf16_t* O; int ldc; const float* rs; const float* cmax;
    __device__ __forceinline__ void operator()(const f32x4 (&acc)[2][2][4][2], const Unit& u, int wr, int wc, int fr, int fq) const {
        const int row0 = u.pm * BM + wr * 64 + fr, col0 = u.pn * BM + wc * 32 + 8 * fq;
        f32x4 cv[2][2];
#pragma unroll
        for (int bj = 0; bj < 2; ++bj)
#pragma unroll
            for (int n = 0; n < 2; ++n) cv[bj][n] = *(const f32x4*)(cmax + col0 + bj * HALF + 4 * n) * (1.f / 127.f);
#pragma unroll
        for (int ai = 0; ai < 2; ++ai)
#pragma unroll
            for (int m = 0; m < 4; ++m) { const int row = row0 + ai * HALF + m * 16; const float r = rs[row]; bf16_t* rowp = O + (size_t)row * ldc + col0;
#pragma unroll
                for (int bj = 0; bj < 2; ++bj) { const i32x4_ a0 = __builtin_bit_cast(i32x4_, acc[ai][bj][m][0]), a1 = __builtin_bit_cast(i32x4_, acc[ai][bj][m][1]);
                    const f32x4 v0 = (f32x4){(float)a0[0], (float)a0[1], (float)a0[2], (float)a0[3]} * cv[bj][0] * r, v1 = (f32x4){(float)a1[0], (float)a1[1], (float)a1[2], (float)a1[3]} * cv[bj][1] * r;
                    u32x4 w; w.x = cvt_pk_bf16(v0[0], v0[1]); w.y = cvt_pk_bf16(v0[2], v0[3]); w.z = cvt_pk_bf16(v1[0], v1[1]); w.w = cvt_pk_bf16(v1[2], v1[3]);
                    if (KEY) { w.x = key16x2(w.x); w.y = key16x2(w.y); w.z = key16x2(w.z); w.w = key16x2(w.w); }
                    *(u32x4*)(rowp + bj * HALF) = w; } }
    }
};
struct EpiF32 {
    static constexpr bool PERM = false, AFTER_DRAIN = false;
    float* C; int ldc; const float* bias;
    __device__ __forceinline__ void operator()(const f32x4 (&acc)[2][2][4][2], const Unit& u, int wr, int wc, int fr, int fq) const {
        const int row0 = u.pm * BM + wr * 64 + fr, col0 = u.pn * BM + wc * 32 + 4 * fq;
        f32x4 bv[2][2];
#pragma unroll
        for (int bj = 0; bj < 2; ++bj)
#pragma unroll
            for (int n = 0; n < 2; ++n) bv[bj][n] = bias ? *(const f32x4*)(bias + col0 + bj * HALF + n * 16) : (f32x4){0.f, 0.f, 0.f, 0.f};
#pragma unroll
        for (int ai = 0; ai < 2; ++ai)
#pragma unroll
            for (int m = 0; m < 4; ++m) { float* rowp = C + (size_t)(row0 + ai * HALF + m * 16) * ldc + col0;
#pragma unroll
                for (int bj = 0; bj < 2; ++bj)
#pragma unroll
                    for (int n = 0; n < 2; ++n) *(f32x4*)(rowp + bj * HALF + n * 16) = acc[ai][bj][m][n] + bv[bj][n]; }
    }
};
template <class Epi, class Sched, bool ALIGN_EPI = false, bool SP2 = false, bool I8 = false  >
__device__ __forceinline__ void gemm_phase(PG8_LAS unsigned char* lds, const Gemm g, const Sched& S, const Epi& E) {
    const int tid = threadIdx.x, wid = __builtin_amdgcn_readfirstlane(tid >> 6), lane = tid & 63, wr = wid >> 2, wc = wid & 3, fr = lane & 15, fq = lane >> 4;
    const int K = g.K, nt = K / BK;
    unsigned voffA[2], voffB[2];
#pragma unroll
    for (int i = 0; i < 2; ++i) { int R, C; stage_rc(tid * 16 + i * 8192, R, C); const int Rb = Epi::PERM ? ((R & ~31) + perm32(R & 31)) : R;
        voffA[i] = (unsigned)(R * K + C) * 2u; voffB[i] = (unsigned)(Rb * K + C) * 2u; }
    const size_t kstep = (size_t)(BK * 2);
    const size_t hstep = (size_t)HALF * K * 2;
    const size_t tstep = 2 * hstep;
    const unsigned ldsw = (unsigned)wid * 1024u;
    const int aoff = lds_byte(wr * 64 + fr, fq * 8), boff = lds_byte(wc * 32 + fr, fq * 8);
#define PG8_SA(b, h) (((b) * 2 + (h)) * HTB)
#define PG8_SB(b, h) ((4 + (b) * 2 + (h)) * HTB)
#define PG8_STAGE(bufoff, gbase, voff) do { _Pragma("unroll") for (int _i = 0; _i < 2; ++_i) \
        __builtin_amdgcn_global_load_lds((const unsigned*)((const char*)(gbase) + (voff)[_i]), (PG8_LAS unsigned*)(lds + (bufoff) + ldsw + _i * 8192), 16, 0, 0); } while (0)
#define PG8_LDA(dst, b, h) do { _Pragma("unroll") for (int m = 0; m < 4; ++m) _Pragma("unroll") for (int k = 0; k < 2; ++k) dst[m][k] = *(const PG8_LAS bf16x8*)(lds + PG8_SA(b, h) + aoff + m * 2048 + k * 1024); } while (0)
#define PG8_LDB(dst, b, h) do { _Pragma("unroll") for (int n = 0; n < 2; ++n) _Pragma("unroll") for (int k = 0; k < 2; ++k) dst[n][k] = *(const PG8_LAS bf16x8*)(lds + PG8_SB(b, h) + boff + n * 2048 + k * 1024); } while (0)
#define PG8_MMA(ai, bj, At, Bt) do { __builtin_amdgcn_s_setprio(1); _Pragma("unroll") for (int m = 0; m < 4; ++m) _Pragma("unroll") for (int n = 0; n < 2; ++n) _Pragma("unroll") for (int k = 0; k < 2; ++k) \
        { if constexpr (I8) acc[ai][bj][m][n] = __builtin_bit_cast(f32x4, __builtin_amdgcn_mfma_i32_16x16x64_i8(__builtin_bit_cast(i32x4_, Bt[n][k]), __builtin_bit_cast(i32x4_, At[m][k]), __builtin_bit_cast(i32x4_, acc[ai][bj][m][n]), 0, 0, 0)); \
          else acc[ai][bj][m][n] = __builtin_amdgcn_mfma_f32_16x16x32_bf16(Bt[n][k], At[m][k], acc[ai][bj][m][n], 0, 0, 0); } __builtin_amdgcn_s_setprio(0); } while (0)
#define PG8_WAIT_V(n) asm volatile("s_waitcnt vmcnt(" #n ")" ::: "memory")
#define PG8_WAIT_L(n) asm volatile("s_waitcnt lgkmcnt(" #n ")" ::: "memory")
#define PG8_BAR __builtin_amdgcn_s_barrier()
#define PG8_SCHED __builtin_amdgcn_sched_barrier(0)
    Unit cur, nxt; int ui = 0;
    if (!S.next(0, cur)) return;
    f32x4 acc[2][2][4][2];
#pragma unroll
    for (int a = 0; a < 2; ++a)
#pragma unroll
        for (int b = 0; b < 2; ++b)
#pragma unroll
            for (int m = 0; m < 4; ++m)
#pragma unroll
                for (int n = 0; n < 2; ++n) acc[a][b][m][n] = (f32x4){0.f, 0.f, 0.f, 0.f};
    bf16x8 At[4][2], B0[2][2], B1[2][2];
    const char* cA = (const char*)g.A + (size_t)cur.pm * tstep; const char* cB = (const char*)g.Bt + (size_t)cur.pn * tstep;
    S.a_ready(cur);
    if constexpr (SP2) {
        PG8_STAGE(PG8_SB(0, 0), cB, voffB); PG8_STAGE(PG8_SB(0, 1), cB + hstep, voffB); PG8_STAGE(PG8_SA(0, 0), cA, voffA); PG8_STAGE(PG8_SA(0, 1), cA + hstep, voffA);
        if (wr == 1) PG8_BAR;
        PG8_WAIT_V(2); PG8_BAR;
        PG8_STAGE(PG8_SB(1, 0), cB + kstep, voffB); PG8_STAGE(PG8_SA(1, 0), cA + kstep, voffA); PG8_STAGE(PG8_SB(1, 1), cB + hstep + kstep, voffB);
        PG8_WAIT_V(6); PG8_BAR;
    } else {
        PG8_STAGE(PG8_SB(0, 0), cB, voffB); PG8_STAGE(PG8_SA(0, 0), cA, voffA); PG8_STAGE(PG8_SB(0, 1), cB + hstep, voffB); PG8_STAGE(PG8_SA(0, 1), cA + hstep, voffA);
        if (wr == 1) PG8_BAR;
        PG8_WAIT_V(4); PG8_BAR;
        PG8_STAGE(PG8_SB(1, 0), cB + kstep, voffB); PG8_STAGE(PG8_SA(1, 0), cA + kstep, voffA); PG8_STAGE(PG8_SB(1, 1), cB + hstep + kstep, voffB);
        PG8_WAIT_V(6); PG8_BAR;
    }
    for (;;) {
        const bool has_next = S.next(ui + 1, nxt);
        const char* nA = has_next ? (const char*)g.A + (size_t)nxt.pm * tstep : cA; const char* nB = has_next ? (const char*)g.Bt + (size_t)nxt.pn * tstep : cB;
        for (int t = 0; t < nt; t += 2) {
            const bool last = (t == nt - 2);
            const char* a1 = cA + (size_t)(t + 1) * kstep;
            const char* a2 = last ? nA : cA + (size_t)(t + 2) * kstep; const char* b2 = last ? nB : cB + (size_t)(t + 2) * kstep;
            const char* a3 = a2 + kstep; const char* b3 = b2 + kstep;
            if (last && has_next) S.a_ready(nxt);
            if constexpr (SP2) {
            PG8_LDB(B0, 0, 0); PG8_LDB(B1, 0, 1); PG8_SCHED; PG8_LDA(At, 0, 0); PG8_STAGE(PG8_SA(1, 1), a1 + hstep, voffA);
            PG8_WAIT_V(8); PG8_WAIT_L(0); PG8_BAR; PG8_MMA(0, 0, At, B0); PG8_MMA(0, 1, At, B1); PG8_BAR; PG8_SCHED;
            PG8_LDA(At, 0, 1); PG8_STAGE(PG8_SB(0, 0), b2, voffB); PG8_STAGE(PG8_SB(0, 1), b2 + hstep, voffB); PG8_STAGE(PG8_SA(0, 0), a2, voffA);
            PG8_WAIT_V(8); PG8_WAIT_L(0); PG8_BAR; PG8_MMA(1, 0, At, B0); PG8_MMA(1, 1, At, B1); PG8_BAR; PG8_SCHED;
            PG8_LDB(B0, 1, 0); PG8_LDB(B1, 1, 1); PG8_SCHED; PG8_LDA(At, 1, 0); PG8_STAGE(PG8_SA(0, 1), a2 + hstep, voffA);
            PG8_WAIT_V(8); PG8_WAIT_L(0); PG8_BAR; PG8_MMA(0, 0, At, B0); PG8_MMA(0, 1, At, B1); PG8_BAR; PG8_SCHED;
            PG8_LDA(At, 1, 1); PG8_STAGE(PG8_SB(1, 0), b3, voffB); PG8_STAGE(PG8_SB(1, 1), b3 + hstep, voffB); PG8_STAGE(PG8_SA(1, 0), a3, voffA);
            PG8_WAIT_V(8); PG8_WAIT_L(0); PG8_BAR; PG8_MMA(1, 0, At, B0); PG8_MMA(1, 1, At, B1); PG8_BAR; PG8_SCHED;
            } else {
            PG8_LDB(B0, 0, 0); PG8_SCHED; PG8_LDA(At, 0, 0); PG8_STAGE(PG8_SA(1, 1), a1 + hstep, voffA);
            PG8_WAIT_L(8); PG8_BAR; PG8_WAIT_L(0); PG8_MMA(0, 0, At, B0); PG8_BAR; PG8_SCHED;
            PG8_LDB(B1, 0, 1); PG8_STAGE(PG8_SB(0, 0), b2, voffB);
            PG8_BAR; PG8_WAIT_L(0); PG8_MMA(0, 1, At, B1); PG8_BAR;
            PG8_LDA(At, 0, 1); PG8_STAGE(PG8_SA(0, 0), a2, voffA);
            PG8_BAR; PG8_WAIT_L(0); PG8_MMA(1, 0, At, B0); PG8_BAR; PG8_SCHED;
            PG8_STAGE(PG8_SB(0, 1), b2 + hstep, voffB);
            PG8_WAIT_V(6); PG8_BAR; PG8_MMA(1, 1, At, B1); PG8_BAR;
            PG8_LDB(B0, 1, 0); PG8_SCHED; PG8_LDA(At, 1, 0); PG8_STAGE(PG8_SA(0, 1), a2 + hstep, voffA);
            PG8_WAIT_L(8); PG8_BAR; PG8_WAIT_L(0); PG8_MMA(0, 0, At, B0); PG8_BAR; PG8_SCHED;
            PG8_LDB(B1, 1, 1); PG8_STAGE(PG8_SB(1, 0), b3, voffB);
            PG8_BAR; PG8_WAIT_L(0); PG8_MMA(0, 1, At, B1); PG8_BAR;
            PG8_LDA(At, 1, 1); PG8_STAGE(PG8_SA(1, 0), a3, voffA);
            PG8_BAR; PG8_WAIT_L(0); PG8_MMA(1, 0, At, B0); PG8_BAR; PG8_SCHED;
            PG8_STAGE(PG8_SB(1, 1), b3 + hstep, voffB);
            PG8_WAIT_V(6); PG8_BAR; PG8_MMA(1, 1, At, B1); PG8_BAR;
            }
        }
        if constexpr (ALIGN_EPI) { if (wr == 0) PG8_BAR; }
        if constexpr (!Epi::AFTER_DRAIN) { E(acc, cur, wr, wc, fr, fq); S.done(cur); }
        if (!has_next) break;
#pragma unroll
        for (int a = 0; a < 2; ++a)
#pragma unroll
            for (int b = 0; b < 2; ++b)
#pragma unroll
                for (int m = 0; m < 4; ++m)
#pragma unroll
                    for (int n = 0; n < 2; ++n) acc[a][b][m][n] = (f32x4){0.f, 0.f, 0.f, 0.f};
        cur = nxt; cA = nA; cB = nB; ++ui;
        if constexpr (ALIGN_EPI) { if (wr == 1) PG8_BAR; }
    }
    PG8_WAIT_V(0);
    if constexpr (!ALIGN_EPI) { if (wr == 0) PG8_BAR; }
    PG8_BAR;
    if constexpr (Epi::AFTER_DRAIN) { E.fused(acc, cur, wr, wc, fr, fq, lds, wid, lane); S.done(cur); }
#undef PG8_SA
#undef PG8_SB
#undef PG8_STAGE
#undef PG8_LDA
#undef PG8_LDB
#undef PG8_MMA
#undef PG8_WAIT_V
#undef PG8_WAIT_L
#undef PG8_BAR
#undef PG8_SCHED
}
}

#ifndef PG8_SP2
#define PG8_SP2 true
#endif

constexpr int NWAVES = 8;
#ifndef MK_N_LAUNCHES
#define MK_N_LAUNCHES 1
#endif
constexpr int N_PHASES = 14;
constexpr int N_LAUNCHES = MK_N_LAUNCHES;

constexpr int BATCH = 16, SEQ = 2048, D = 1024, M = BATCH * SEQ;
constexpr int IN_COLS = 2560;
constexpr int C_Q = 0, C_K = 512, C_V = 640, C_RW = 768;
constexpr int RW_R = 0, RW_K = 512, RW_V = 1024, RW_WD = 1536, RW_AD = 1600, RW_GD = 1664;
constexpr int NSC = 2048;
constexpr float LN_EPS = 1e-5f, GN_EPS = 64e-5f;
constexpr float ALPHA = 1.189207115002721f;

constexpr size_t MiB = 1u << 20;
constexpr size_t WS_CTL = 0, CTL_ZERO_BYTES = 1 * MiB;
constexpr size_t WS_WIN = 1 * MiB;
constexpr size_t WS_WOUT = 6 * MiB;
constexpr size_t WS_WP = 8 * MiB;
constexpr size_t WS_WCMAX = 896 * 1024;
constexpr size_t WS_W1CMAX = 904 * 1024;
constexpr size_t WS_W1Q = 240 * MiB;
constexpr size_t WS_RS1 = 13 * MiB + 512 * 1024 + 393216;
constexpr size_t WS_W2CMAX = 916 * 1024;
constexpr size_t WS_W2Q = 12 * MiB;
constexpr size_t WS_MIXQ = 240 * MiB;
constexpr size_t WS_RS2 = WS_RS1;
constexpr size_t WS_WP8 = 1 * MiB;
constexpr size_t WS_MOD = 512 * 1024;
constexpr size_t WS_FRAG = 13 * MiB;
constexpr size_t WS_H = 16 * MiB;
constexpr size_t WS_PROJ = 80 * MiB;
constexpr size_t WS_YB = 16 * MiB;
constexpr size_t WS_G = 48 * MiB;
constexpr size_t WS_DOTRK = 14 * MiB;
constexpr size_t WS_REC = 240 * MiB;
constexpr size_t WS_Y1 = 336 * MiB;
constexpr size_t WS_U8 = 448 * MiB;
constexpr size_t WS_PART = WS_H;
constexpr size_t WS_V8 = 464 * MiB;
constexpr size_t WS_H8 = 240 * MiB;
constexpr size_t WS_US = 13 * MiB + 512 * 1024, WS_VS = WS_US + 65536, WS_HS = WS_US + 262144;
constexpr size_t WS_COEF = 304 * MiB;
constexpr size_t WS_YS = 80 * MiB;
constexpr size_t WS_SC = 80 * MiB;
constexpr size_t WS_PIDX = 272 * MiB;
constexpr size_t WS_PGATE = 288 * MiB;
constexpr size_t WS_END = 512 * MiB;

constexpr int CW_TMO = 0, CW_CODE = 1;
constexpr int CW_BAR = 4096;

constexpr int RING_OFF = 0, RING_BYTES = 131072;
constexpr int LDSCTL_OFF = RING_BYTES, MISC_OFF = LDSCTL_OFF + 320;
constexpr int LDS_BYTES = 147456;
#define GAS __attribute__((address_space(1)))
#define LAS __attribute__((address_space(3)))
typedef unsigned short bf16;
typedef unsigned v4u __attribute__((ext_vector_type(4)));
typedef float f32x4 __attribute__((ext_vector_type(4)));
typedef short bf16x8 __attribute__((ext_vector_type(8)));
typedef GAS unsigned gu32;
typedef GAS unsigned long long gu64;
#define RLX_AGENT __ATOMIC_RELAXED, __HIP_MEMORY_SCOPE_AGENT
#define LDS_WAIT() asm volatile("s_waitcnt lgkmcnt(0)" ::: "memory")
#define VM_WAIT() asm volatile("s_waitcnt vmcnt(0)" ::: "memory")
__device__ __forceinline__ unsigned long long rt() { return __builtin_amdgcn_s_memrealtime(); }
typedef float f32x2_t_ __attribute__((ext_vector_type(2))); typedef __bf16 bf16x2_t_ __attribute__((ext_vector_type(2)));
__device__ __forceinline__ unsigned f2bf(float f) { return (unsigned)__builtin_bit_cast(unsigned short, (__bf16)f); }
__device__ __forceinline__ unsigned pk2(float lo, float hi) { const f32x2_t_ v = {lo, hi}; return __builtin_bit_cast(unsigned, __builtin_convertvector(v, bf16x2_t_)); }

#define XB_TMO      128
#define XB_XCNT(j)  (256  + 64 * (j))
#define XB_XSUB(j)  (1280 + 64 * (j))
#define XB_XGEN(j)  (2304 + 64 * (j))
#define XB_TOP      3328
#define XB_TOPGEN   3392
#define XCD_BAR_WORDS 3456
#define XB_SPIN_CAP (1u << 18)

__device__ __forceinline__ unsigned xb_ld(unsigned* p)              { return __hip_atomic_load(p, __ATOMIC_RELAXED, __HIP_MEMORY_SCOPE_AGENT); }
__device__ __forceinline__ unsigned xb_add(unsigned* p, unsigned v) { return __hip_atomic_fetch_add(p, v, __ATOMIC_RELAXED, __HIP_MEMORY_SCOPE_AGENT); }
__device__ __forceinline__ unsigned xb_xcc_id() { return (unsigned)__builtin_amdgcn_s_getreg((3 << 11) | 20) & 0xFu; }
#define XB_SPIN(cond, bar) do { unsigned _sp = 0; while (cond) { __builtin_amdgcn_s_sleep(1); \
    if ((++_sp & 255u) == 0u) { if (xb_ld(&(bar)[XB_TMO])) break; if (_sp > XB_SPIN_CAP) { atomicAdd(&(bar)[XB_TMO], 1u); break; } } } } while (0)

struct XcdBarrier {
    unsigned* bar; unsigned x;
    volatile LAS unsigned* st;
};

__device__ __forceinline__ XcdBarrier xcd_barrier_post(unsigned* bar, volatile LAS unsigned* st) {
    XcdBarrier b; b.bar = bar; b.x = xb_xcc_id(); b.st = st;
    if (threadIdx.x == 0) (void)xb_add(&bar[XB_XCNT(b.x)], 1u);
    return b;
}
__device__ __forceinline__ void xcd_barrier_complete(unsigned* bar, unsigned x, unsigned& nloc, unsigned& nx) {
    const unsigned G = gridDim.x * gridDim.y * gridDim.z;
    unsigned sum, cnt, mine, sp = 0u;
    for (;;) {
        sum = 0u; cnt = 0u; mine = 0u;
#pragma unroll
        for (unsigned j = 0; j < 16; ++j) { const unsigned c = xb_ld(&bar[XB_XCNT(j)]); sum += c; cnt += (c > 0u) ? 1u : 0u; mine = (j == x) ? c : mine; }
        if (sum == G) break;
        __builtin_amdgcn_s_sleep(1);
        if ((++sp & 255u) == 0u) { if (xb_ld(&bar[XB_TMO])) break; if (sp > XB_SPIN_CAP) { atomicAdd(&bar[XB_TMO], 1u); break; } }
    }
    nloc = mine > 0u ? mine : 1u; nx = cnt > 0u ? cnt : 1u;
}

__device__ __forceinline__ void xcd_barrier(const XcdBarrier& b) {
    asm volatile("s_waitcnt vmcnt(0)" ::: "memory");
    __syncthreads();
    if (threadIdx.x == 0) {
        unsigned* bar = b.bar;
        __builtin_amdgcn_s_waitcnt(0);
        unsigned nloc = b.st[0], nx = b.st[1];
        if (nloc == 0u) { xcd_barrier_complete(bar, b.x, nloc, nx); b.st[0] = nloc; b.st[1] = nx; }
        const unsigned old = xb_add(&bar[XB_XSUB(b.x)], 1u);
        const unsigned gen = old / nloc;
        if (old + 1u == (gen + 1u) * nloc) {
            __builtin_amdgcn_fence(__ATOMIC_RELEASE, "agent");
            asm volatile("s_waitcnt vmcnt(0)" ::: "memory");
            const unsigned og = xb_add(&bar[XB_TOP], 1u);
            const unsigned tg = og / nx;
            if (og + 1u == (tg + 1u) * nx) xb_add(&bar[XB_TOPGEN], 1u);
            else XB_SPIN(xb_ld(&bar[XB_TOPGEN]) == tg, bar);
            __builtin_amdgcn_fence(__ATOMIC_ACQUIRE, "agent");
            xb_add(&bar[XB_XGEN(b.x)], 1u);
            asm volatile("s_waitcnt vmcnt(0)" ::: "memory");
        } else {
            XB_SPIN(xb_ld(&bar[XB_XGEN(b.x)]) == gen, bar);
            __builtin_amdgcn_fence(__ATOMIC_ACQUIRE, "agent");
            asm volatile("s_waitcnt vmcnt(0)" ::: "memory");
        }
    }
    __syncthreads();
}

typedef unsigned v2u __attribute__((ext_vector_type(2)));
typedef short s16x4 __attribute__((ext_vector_type(4)));
typedef __bf16 bf16x2_t __attribute__((ext_vector_type(2)));
struct Frame {
    LAS unsigned char* lds;
    volatile LAS unsigned* MISC;
    gu32* ctl;
    int tid, lane, wave;
    int vcu, G;
    const float* in[26]; float* out; unsigned char* ws;
};
__device__ __forceinline__ float bflo(unsigned u) { return __uint_as_float(u << 16); }
__device__ __forceinline__ float bfhi(unsigned u) { return __uint_as_float(u & 0xffff0000u); }
__device__ __forceinline__ float wave_sum(float v) {
#pragma unroll
    for (int o = 1; o < 64; o <<= 1) v += __shfl_xor(v, o);
    return v;
}
__device__ __forceinline__ float dpp_f(float x, const int ctrl_sel) {
    const int xi = __float_as_int(x); int r;
    if (ctrl_sel == 0) r = __builtin_amdgcn_update_dpp(0, xi, 0xB1, 0xf, 0xf, true);
    else if (ctrl_sel == 1) r = __builtin_amdgcn_update_dpp(0, xi, 0x4E, 0xf, 0xf, true);
    else if (ctrl_sel == 2) r = __builtin_amdgcn_update_dpp(0, xi, 0x141, 0xf, 0xf, true);
    else r = __builtin_amdgcn_update_dpp(0, xi, 0x140, 0xf, 0xf, true);
    return __int_as_float(r);
}
__device__ __forceinline__ float red8(float x) { x += dpp_f(x, 0); x += dpp_f(x, 1); x += dpp_f(x, 2); return x; }
__device__ __forceinline__ float red16(float x) { x += dpp_f(x, 0); x += dpp_f(x, 1); x += dpp_f(x, 2); x += dpp_f(x, 3); return x; }

__device__ __forceinline__ void ph_mod2(Frame& F) {
    const float* c = F.in[1]; const float* W = F.in[2]; const float* bias = F.in[3];
    float* mod = (float*)(F.ws + WS_MOD);
    LAS float* scr = (LAS float*)(F.lds + F.wave * 16384);
    const int it = (int)blockIdx.x; if (it >= 192) return;
    const int ch = it % 96, sl = it / 96, col = ch * 64 + F.lane, k0 = sl * 512 + F.wave * 64;
    float wn[16];
    const float* wp = W + (size_t)k0 * 6144 + col;
#pragma unroll
    for (int q = 0; q < 16; ++q) wn[q] = wp[(size_t)q * 6144];
    for (int i = F.lane; i < 1024; i += 64) { const int b = i >> 6, k = i & 63; const float v = c[b * 1024 + k0 + k]; scr[i] = v / (1.f + __expf(-v)); }
    LDS_WAIT();
    float acc[16];
#pragma unroll
    for (int b = 0; b < 16; ++b) acc[b] = 0.f;
    for (int k = 0; k < 64; k += 16) {
        float wv[16];
#pragma unroll
        for (int q = 0; q < 16; ++q) wv[q] = wn[q];
        if (k + 16 < 64) {
#pragma unroll
            for (int q = 0; q < 16; ++q) wn[q] = wp[(size_t)(k + 16 + q) * 6144];
        }
#pragma unroll
        for (int q4_ = 0; q4_ < 4; ++q4_)
#pragma unroll
            for (int b = 0; b < 16; ++b) { const f32x4 cs = *(const LAS f32x4*)(scr + b * 64 + k + 4 * q4_); acc[b] += (cs.x * wv[4 * q4_] + cs.y * wv[4 * q4_ + 1]) + (cs.z * wv[4 * q4_ + 2] + cs.w * wv[4 * q4_ + 3]); }
    }
#pragma unroll
    for (int b = 0; b < 16; ++b) scr[1024 + b * 64 + F.lane] = acc[b];
    __syncthreads();
    for (int o = F.tid; o < 1024; o += 512) {
        const int b = o >> 6, cc = o & 63; float s = sl == 0 ? bias[ch * 64 + cc] : 0.f;
#pragma unroll
        for (int w = 0; w < 8; ++w) s += ((const LAS float*)(F.lds + w * 16384))[1024 + b * 64 + cc];
        __hip_atomic_fetch_add(mod + b * 6144 + ch * 64 + cc, s, __ATOMIC_RELAXED, __HIP_MEMORY_SCOPE_AGENT);
    }
    __syncthreads();
}
__device__ __forceinline__ void ph_mod(Frame& F) {
    const float* c = F.in[1]; const float* W = F.in[2]; const float* bias = F.in[3];
    float* mod = (float*)(F.ws + WS_MOD);
    LAS float* scr = (LAS float*)(F.lds + F.wave * 16384);
    for (int it = blockIdx.x; it < 96; it += F.G) {
        const int col = it * 64 + F.lane, k0 = F.wave * 128;
        for (int i = F.lane; i < 2048; i += 64) { const int b = i >> 7, k = i & 127; const float v = c[b * 1024 + k0 + k]; scr[i] = v / (1.f + __expf(-v)); }
        LDS_WAIT();
        float acc[16];
#pragma unroll
        for (int b = 0; b < 16; ++b) acc[b] = 0.f;
        for (int k = 0; k < 128; k += 16) {
            const float* wp = W + (size_t)(k0 + k) * 6144 + col;
            float wv[16];
#pragma unroll
            for (int q = 0; q < 16; ++q) wv[q] = wp[(size_t)q * 6144];
#pragma unroll
            for (int q4_ = 0; q4_ < 4; ++q4_)
#pragma unroll
                for (int b = 0; b < 16; ++b) { const f32x4 cs = *(const LAS f32x4*)(scr + b * 128 + k + 4 * q4_); acc[b] += (cs.x * wv[4 * q4_] + cs.y * wv[4 * q4_ + 1]) + (cs.z * wv[4 * q4_ + 2] + cs.w * wv[4 * q4_ + 3]); }
        }
#pragma unroll
        for (int b = 0; b < 16; ++b) scr[2048 + b * 64 + F.lane] = acc[b];
        __syncthreads();
        for (int o = F.tid; o < 1024; o += 512) {
            const int b = o >> 6, cc = o & 63; float s = bias[it * 64 + cc];
#pragma unroll
            for (int w = 0; w < 8; ++w) s += ((const LAS float*)(F.lds + w * 16384))[2048 + b * 64 + cc];
            mod[b * 6144 + it * 64 + cc] = s;
        }
        __syncthreads();
    }
}

__device__ __forceinline__ void p0_transpose_item(const float* W, int K, int N, bf16* WT, int row_off, LAS float* scr, int item, int lane, unsigned* cmax = nullptr) {
    const int nblk = N / 32, kb = item / nblk, nb = item % nblk, k0 = 64 * kb, n0 = 32 * nb;
    f32x4 tv[8];
#pragma unroll
    for (int i = 0; i < 8; ++i) { const int idx = lane + 64 * i; tv[i] = *(const f32x4*)(W + (size_t)(k0 + (idx >> 3)) * N + n0 + (idx & 7) * 4); }
#pragma unroll
    for (int i = 0; i < 8; ++i) { const int idx = lane + 64 * i; LAS float* d = scr + (idx >> 3) * 33 + (idx & 7) * 4; d[0] = tv[i].x; d[1] = tv[i].y; d[2] = tv[i].z; d[3] = tv[i].w; }
    LDS_WAIT(); asm volatile("" ::: "memory");
    const int c = lane & 7;
#pragma unroll
    for (int j = 0; j < 4; ++j) { const int n = (lane >> 3) + 8 * j; const LAS float* s = scr + (8 * c) * 33 + n;
        v4u o; o.x = pk2(s[0 * 33], s[1 * 33]); o.y = pk2(s[2 * 33], s[3 * 33]); o.z = pk2(s[4 * 33], s[5 * 33]); o.w = pk2(s[6 * 33], s[7 * 33]);
        *(GAS v4u*)(WT + (size_t)(row_off + n0 + n) * K + k0 + 8 * c) = o;
        if (cmax) {
            float am = fmaxf(fmaxf(fmaxf(fabsf(s[0 * 33]), fabsf(s[1 * 33])), fmaxf(fabsf(s[2 * 33]), fabsf(s[3 * 33]))), fmaxf(fmaxf(fabsf(s[4 * 33]), fabsf(s[5 * 33])), fmaxf(fabsf(s[6 * 33]), fabsf(s[7 * 33]))));
            am = fmaxf(am, __shfl_xor(am, 1)); am = fmaxf(am, __shfl_xor(am, 2)); am = fmaxf(am, __shfl_xor(am, 4));
            if (c == 0) __hip_atomic_fetch_max(cmax + row_off + n0 + n, __float_as_uint(am), __ATOMIC_RELAXED, __HIP_MEMORY_SCOPE_AGENT); } }
    LDS_WAIT(); asm volatile("" ::: "memory");
}
__device__ __forceinline__ bf16x8 ld8bf(const float* p) {
    const f32x4 a = *(const f32x4*)p, b = *(const f32x4*)(p + 4);
    return __builtin_bit_cast(bf16x8, (v4u){pk2(a.x, a.y), pk2(a.z, a.w), pk2(b.x, b.y), pk2(b.z, b.w)});
}
__device__ __forceinline__ void p0_wp_item(const float* wq, const float* sk, bf16* WpT, unsigned* cmax, LAS float* scr, int item, int lane) {
    (void)scr;
    const int kt = item & 63, hc = item >> 6, tq = lane & 15, g = lane >> 4, k0 = kt * 16;
    bf16x8 X[4];
#pragma unroll
    for (int st = 0; st < 4; ++st) X[st] = ld8bf(wq + (size_t)(k0 + tq) * 2048 + hc * 128 + 32 * st + 8 * g);
#pragma unroll
    for (int nt = 0; nt < 8; ++nt) {
        f32x4 acc = (f32x4){0.f, 0.f, 0.f, 0.f};
#pragma unroll
        for (int st = 0; st < 4; ++st) { const bf16x8 Y = ld8bf(sk + (size_t)(hc * 128 + nt * 16 + tq) * 128 + 32 * st + 8 * g); acc = __builtin_amdgcn_mfma_f32_16x16x32_bf16(X[st], Y, acc, 0, 0, 0); }
        *(v2u*)(WpT + (size_t)(hc * 128 + nt * 16 + tq) * 1024 + k0 + 4 * g) = (v2u){pk2(acc[0], acc[1]), pk2(acc[2], acc[3])};
        float am = fmaxf(fmaxf(fabsf(acc[0]), fabsf(acc[1])), fmaxf(fabsf(acc[2]), fabsf(acc[3])));
        am = fmaxf(am, __shfl_xor(am, 16)); am = fmaxf(am, __shfl_xor(am, 32));
        if (g == 0) __hip_atomic_fetch_max(cmax + hc * 128 + nt * 16 + tq, __float_as_uint(am), __ATOMIC_RELAXED, __HIP_MEMORY_SCOPE_AGENT);
    }
}
__device__ __forceinline__ unsigned p7_q2(unsigned w, float inv) {
    int i0 = (int)rintf(bflo(w) * inv), i1 = (int)rintf(bfhi(w) * inv);
    i0 = i0 > 127 ? 127 : (i0 < -127 ? -127 : i0); i1 = i1 > 127 ? 127 : (i1 < -127 ? -127 : i1);
    return ((unsigned)i0 & 0xffu) | (((unsigned)i1 & 0xffu) << 8);
}
__device__ __forceinline__ void p7_wq8_row(const bf16* WpT, const unsigned* cmax, unsigned char* WP8, int n, int lane) {
    const v4u a = *(const v4u*)(WpT + (size_t)n * 1024 + 16 * lane), b = *(const v4u*)(WpT + (size_t)n * 1024 + 16 * lane + 8);
    const float inv = 127.f / fmaxf(__uint_as_float(cmax[n]), 1e-30f);
    v4u o; o.x = p7_q2(a.x, inv) | (p7_q2(a.y, inv) << 16); o.y = p7_q2(a.z, inv) | (p7_q2(a.w, inv) << 16); o.z = p7_q2(b.x, inv) | (p7_q2(b.y, inv) << 16); o.w = p7_q2(b.z, inv) | (p7_q2(b.w, inv) << 16);
    *(v4u*)(WP8 + (size_t)n * 1024 + 16 * lane) = o;
}
__device__ __forceinline__ void ph_weights(Frame& F, int gw, int NGW, int i_lo, int i_hi, int f_gw) {
    LAS float* scr = (LAS float*)(F.lds + F.wave * 16384);
    constexpr int I_WP = 16 * 16 * 4, I_IN = (D / 64) * (IN_COLS / 32), I_OUT = (D / 64) * (D / 32);
    constexpr int NITEMS = I_WP + I_IN + I_OUT;
    bf16* WinT = (bf16*)(F.ws + WS_WIN); bf16* WoutT = (bf16*)(F.ws + WS_WOUT); bf16* WpT = (bf16*)(F.ws + WS_WP);
    (void)NITEMS;
    for (int it = i_lo + gw; it < i_hi; it += NGW) {
        int r = it;
        if (r < I_WP) { p0_wp_item(F.in[20], F.in[21], WpT, (unsigned*)(F.ws + WS_WCMAX), scr, r, F.lane); continue; } r -= I_WP;
        if (r < I_IN) { p0_transpose_item(F.in[4], D, IN_COLS, WinT, 0, scr, r, F.lane, (unsigned*)(F.ws + WS_W1CMAX)); continue; } r -= I_IN;
        p0_transpose_item(F.in[17], D, D, WoutT, 0, scr, r, F.lane, (unsigned*)(F.ws + WS_W2CMAX));
    }
    for (int it = f_gw; it >= 0 && it < 256; it += 1 << 30) {
        const float* W; int rel, KS;
        if (it < 64) { W = F.in[8]; rel = it; KS = 2; } else if (it < 128) { W = F.in[10]; rel = it - 64; KS = 2; } else { W = F.in[11]; rel = it - 128; KS = 4; }
        const int nb = rel & 3, ks = (rel >> 2) % KS, head = (rel >> 2) / KS, tq = F.lane & 15, g = F.lane >> 4;
        float wv[8];
#pragma unroll
        for (int j = 0; j < 8; ++j) wv[j] = W[(size_t)(32 * ks + 8 * g + j) * 512 + head * 64 + nb * 16 + tq];
        v4u o; o.x = pk2(wv[0], wv[1]); o.y = pk2(wv[2], wv[3]); o.z = pk2(wv[4], wv[5]); o.w = pk2(wv[6], wv[7]);
        *(v4u*)(F.ws + WS_FRAG + ((size_t)it * 64 + F.lane) * 16) = o;
    }
}

constexpr int ACT_PITCH = 264;
constexpr int REC_BYTES = 12544, REC_AT = 0, REC_RT = 2048, REC_BK = 4096, REC_TM = 8192, REC_QB = 8704, REC_NKA = 9216, REC_QK = 9728, REC_VT = 10240, REC_P15 = 12288;
__device__ __forceinline__ bf16x8 pk8(const float (&lo)[4], const float (&hi)[4]) {
    const unsigned a = pk2(lo[0], lo[1]), b = pk2(lo[2], lo[3]), c = pk2(hi[0], hi[1]), d = pk2(hi[2], hi[3]);
    return __builtin_bit_cast(bf16x8, (v4u){a, b, c, d});
}
__device__ __forceinline__ bf16x8 pk4lo(const f32x4 a) {
    return __builtin_bit_cast(bf16x8, (v4u){pk2(a[0], a[1]), pk2(a[2], a[3]), 0u, 0u});
}
__device__ __forceinline__ f32x4 mm16(const bf16x8 x, const bf16x8 y, const f32x4 c) { return __builtin_amdgcn_mfma_f32_16x16x32_bf16(x, y, c, 0, 0, 0); }
__device__ __forceinline__ float row_shr_f(float x, const int d) {
    int r; const int xi = __float_as_int(x);
    if (d == 1) r = __builtin_amdgcn_update_dpp(0, xi, 0x111, 0xf, 0xf, true); else if (d == 2) r = __builtin_amdgcn_update_dpp(0, xi, 0x112, 0xf, 0xf, true);
    else if (d == 4) r = __builtin_amdgcn_update_dpp(0, xi, 0x114, 0xf, 0xf, true); else r = __builtin_amdgcn_update_dpp(0, xi, 0x118, 0xf, 0xf, true);
    return __int_as_float(r);
}
__device__ __forceinline__ void ph_prep(Frame& F) {
    const bf16* PROJ = (const bf16*)(F.ws + WS_PROJ);
    const float* mu_ = F.in[6]; const float* w0_ = F.in[7]; const float* a0_ = F.in[9];
    const float* k_k_ = F.in[12]; const float* k_a_ = F.in[13]; const float* r_k_ = F.in[14];
    bf16* RWG = (bf16*)(F.ws + WS_G); float* DOTRK = (float*)(F.ws + WS_DOTRK); unsigned char* REC = F.ws + WS_REC;
    LAS bf16* act0 = (LAS bf16*)(F.lds);
    int par = 0;
    const int lane = F.lane, tq = lane & 15, g = lane >> 4, head = F.wave;
    const bf16x8* FR = (const bf16x8*)(F.ws + WS_FRAG);
    bf16x8 Sel0, Sel1;
#pragma unroll
    for (int j = 0; j < 8; ++j) { Sel0[j] = (short)((j < 4 && 4 * g + j == tq) ? 0x3F80 : 0); Sel1[j] = (short)((j >= 4 && 4 * g + j - 4 == tq) ? 0x3F80 : 0); }
    const f32x4 Z4 = (f32x4){0.f, 0.f, 0.f, 0.f};
    LAS float* cst = (LAS float*)(F.lds + 32768);
    { const int t_ = F.tid; cst[t_] = mu_[RW_K + t_]; cst[512 + t_] = mu_[RW_R + t_]; cst[1024 + t_] = mu_[RW_V + t_]; cst[1536 + t_] = k_k_[t_]; cst[2048 + t_] = k_a_[t_]; cst[2560 + t_] = r_k_[t_]; cst[3072 + t_] = w0_[t_]; cst[3584 + t_] = a0_[t_]; }
    __syncthreads();
    v4u st_cur, st_prv;
#define ST_LOAD(tile_) do { const int row_ = (tile_) * 16 + (F.tid >> 5); const bf16* p_ = PROJ + (size_t)row_ * IN_COLS + C_RW + RW_WD + 8 * (F.tid & 31); \
        st_cur = *(const v4u*)p_; st_prv = (v4u){0u, 0u, 0u, 0u}; if ((row_ & (SEQ - 1)) != 0) st_prv = *(const v4u*)(p_ - IN_COLS); } while (0)
#define PREP_BAR() do { asm volatile("s_waitcnt lgkmcnt(0)" ::: "memory"); __builtin_amdgcn_s_barrier(); asm volatile("" ::: "memory"); } while (0)
    if (F.vcu < M / 16) ST_LOAD(F.vcu);
#pragma unroll 1
    for (int tile = F.vcu; tile < M / 16; tile += F.G) {
        const int t0 = tile * 16;
        LAS bf16* act = act0 + par * (16 * ACT_PITCH); par ^= 1;
        const bf16x8* FRl = FR; asm volatile("" : "+s"(FRl));
        bf16x8 Bgf[4][4], Bwf[2][4], Baf[2][4];
#pragma unroll
        for (int ks = 0; ks < 4; ++ks)
#pragma unroll
            for (int nb = 0; nb < 4; ++nb) Bgf[ks][nb] = FRl[(size_t)(128 + ((head * 4 + ks) * 4 + nb)) * 64 + lane];
#pragma unroll
        for (int ks = 0; ks < 2; ++ks)
#pragma unroll
            for (int nb = 0; nb < 4; ++nb) { Bwf[ks][nb] = FRl[(size_t)(((head * 2 + ks) * 4 + nb)) * 64 + lane]; Baf[ks][nb] = FRl[(size_t)(64 + ((head * 2 + ks) * 4 + nb)) * 64 + lane]; }
        {
            const int token = F.tid >> 5, cg = F.tid & 31;
            const v4u cur = st_cur, prv = st_prv;
            if (tile + F.G < M / 16) ST_LOAD(tile + F.G);
            const f32x4 m0 = *(const f32x4*)(mu_ + RW_WD + 8 * cg), m1 = *(const f32x4*)(mu_ + RW_WD + 8 * cg + 4);
            float v[8];
            { const unsigned cu[4] = {cur.x, cur.y, cur.z, cur.w}, pu[4] = {prv.x, prv.y, prv.z, prv.w}; const float mm[8] = {m0.x, m0.y, m0.z, m0.w, m1.x, m1.y, m1.z, m1.w};
#pragma unroll
              for (int e = 0; e < 4; ++e) { const float c0 = bflo(cu[e]), c1 = bfhi(cu[e]), p0 = bflo(pu[e]), p1 = bfhi(pu[e]);
                  v[2 * e] = c0 + (p0 - c0) * mm[2 * e]; v[2 * e + 1] = c1 + (p1 - c1) * mm[2 * e + 1]; } }
            if (cg < 8) {
#pragma unroll
                for (int e = 0; e < 8; ++e) v[e] = 1.f - 2.f / (1.f + __expf(2.f * v[e]));
            } else if (cg >= 16) {
#pragma unroll
                for (int e = 0; e < 8; ++e) v[e] = 1.f / (1.f + __expf(-v[e]));
            }
            v4u o; o.x = pk2(v[0], v[1]); o.y = pk2(v[2], v[3]); o.z = pk2(v[4], v[5]); o.w = pk2(v[6], v[7]);
            *(LAS v4u*)(act + token * ACT_PITCH + 8 * cg) = o;
        }
        const int row = t0 + tq; const bool has_prev = (row & (SEQ - 1)) != 0;
        v2u kcA[4], kpA[4], rcA[4], rpA[4], vcA[4], vpA[4];
#pragma unroll
        for (int nb = 0; nb < 4; ++nb) { const int col = head * 64 + nb * 16 + 4 * g; const bf16* pb = PROJ + (size_t)row * IN_COLS + C_RW + col;
            kcA[nb] = *(const v2u*)(pb + RW_K); rcA[nb] = *(const v2u*)(pb + RW_R); vcA[nb] = *(const v2u*)(pb + RW_V);
            kpA[nb] = (v2u){0u, 0u}; rpA[nb] = kpA[nb]; vpA[nb] = kpA[nb];
            if (tq == 0 && has_prev) { kpA[nb] = *(const v2u*)(pb + RW_K - IN_COLS); rpA[nb] = *(const v2u*)(pb + RW_R - IN_COLS); vpA[nb] = *(const v2u*)(pb + RW_V - IN_COLS); } }
        PREP_BAR();
#pragma unroll
        for (int nb = 0; nb < 4; ++nb) {
#define SHR1(x_) (unsigned)__builtin_amdgcn_update_dpp(0, (int)(x_), 0x111, 0xf, 0xf, true)
            const v2u kd = (v2u){SHR1(kcA[nb].x), SHR1(kcA[nb].y)}, rd = (v2u){SHR1(rcA[nb].x), SHR1(rcA[nb].y)}, vd = (v2u){SHR1(vcA[nb].x), SHR1(vcA[nb].y)};
#undef SHR1
            if (tq != 0) { kpA[nb] = kd; rpA[nb] = rd; vpA[nb] = vd; } }
        {
            f32x4 accg[4];
#pragma unroll
            for (int nb = 0; nb < 4; ++nb) accg[nb] = Z4;
#pragma unroll
            for (int ks = 0; ks < 4; ++ks) {
                const bf16x8 Ag = *(const LAS bf16x8*)(act + tq * ACT_PITCH + 128 + 32 * ks + 8 * g);
#pragma unroll
                for (int nb = 0; nb < 4; ++nb) accg[nb] = mm16(Bgf[ks][nb], Ag, accg[nb]);
            }
#pragma unroll
            for (int nb = 0; nb < 4; ++nb) { const int col = head * 64 + nb * 16 + 4 * g; v2u o; o.x = pk2(accg[nb][0], accg[nb][1]); o.y = pk2(accg[nb][2], accg[nb][3]); *(v2u*)(RWG + (size_t)row * 512 + col) = o; }
        }
        f32x4 accw[4], acca[4];
#pragma unroll
        for (int nb = 0; nb < 4; ++nb) { accw[nb] = Z4; acca[nb] = Z4; }
#pragma unroll
        for (int ks = 0; ks < 2; ++ks) {
            const bf16x8 Aw = *(const LAS bf16x8*)(act + tq * ACT_PITCH + 32 * ks + 8 * g);
            const bf16x8 Aa = *(const LAS bf16x8*)(act + tq * ACT_PITCH + 64 + 32 * ks + 8 * g);
#pragma unroll
            for (int nb = 0; nb < 4; ++nb) { accw[nb] = mm16(Bwf[ks][nb], Aw, accw[nb]); acca[nb] = mm16(Baf[ks][nb], Aa, acca[nb]); }
        }
        float ss = 0.f;
#pragma unroll
        for (int nb = 0; nb < 4; ++nb) {
            const int col = head * 64 + nb * 16 + 4 * g;
            const v2u cur = kcA[nb], prv = kpA[nb];
            const f32x4 mk = *(const LAS f32x4*)(cst + col), kk4 = *(const LAS f32x4*)(cst + 1536 + col);
            const float cc[4] = {bflo(cur.x), bfhi(cur.x), bflo(cur.y), bfhi(cur.y)}, pp[4] = {bflo(prv.x), bfhi(prv.x), bflo(prv.y), bfhi(prv.y)};
#pragma unroll
            for (int i = 0; i < 4; ++i) { const float kr = (cc[i] + (pp[i] - cc[i]) * mk[i]) * kk4[i]; ss += kr * kr; }
        }
        ss += __shfl_xor(ss, 16); ss += __shfl_xor(ss, 32);
        const float rn = rsqrtf(fmaxf(ss, 1e-24f));
        float drk = 0.f;
        unsigned char* rec = REC + ((size_t)((row >> 11) * 8 + head) * (SEQ / 16) + (size_t)((t0 & (SEQ - 1)) >> 4)) * REC_BYTES;
        f32x4 N = Z4, NT = Z4, Nka = Z4, Qb = Z4, Qk = Z4;
#pragma unroll
        for (int s2 = 0; s2 < 2; ++s2) {
            v2u dAt[2], dRt[2], dBt[2], dKt[2], dBp[2], dKp[2], dVv[2];
#pragma unroll
            for (int h2 = 0; h2 < 2; ++h2) {
                const int nb = 2 * s2 + h2;
                const int col = head * 64 + nb * 16 + 4 * g;
                const v2u kc = kcA[nb], rc = rcA[nb], vc = vcA[nb], kp_ = kpA[nb], rp = rpA[nb], vp = vpA[nb];
                const f32x4 mk = *(const LAS f32x4*)(cst + col), mr = *(const LAS f32x4*)(cst + 512 + col), mv = *(const LAS f32x4*)(cst + 1024 + col), kk4 = *(const LAS f32x4*)(cst + 1536 + col), ka4 = *(const LAS f32x4*)(cst + 2048 + col), rk4 = *(const LAS f32x4*)(cst + 2560 + col);
                const f32x4 w04 = *(const LAS f32x4*)(cst + 3072 + col), a04 = *(const LAS f32x4*)(cst + 3584 + col);
                const float kcc[4] = {bflo(kc.x), bfhi(kc.x), bflo(kc.y), bfhi(kc.y)}, kpp[4] = {bflo(kp_.x), bfhi(kp_.x), bflo(kp_.y), bfhi(kp_.y)};
                const float rcc[4] = {bflo(rc.x), bfhi(rc.x), bflo(rc.y), bfhi(rc.y)}, rpp[4] = {bflo(rp.x), bfhi(rp.x), bflo(rp.y), bfhi(rp.y)};
                const float vcc[4] = {bflo(vc.x), bfhi(vc.x), bflo(vc.y), bfhi(vc.y)}, vpp[4] = {bflo(vp.x), bfhi(vp.x), bflo(vp.y), bfhi(vp.y)};
                f32x4 p15; float At[4], Rt[4], Bt[4], Kt[4], Bp[4], Kp[4], Vv[4];
#pragma unroll
                for (int i = 0; i < 4; ++i) {
                    const float lw = accw[nb][i] + w04[i], z = -lw;
                    const float sp = fmaxf(z, 0.f) + __logf(1.f + __expf(-fabsf(z)));
                    const float ld = -__expf(-sp - 0.5f);
                    float cs = ld; cs += row_shr_f(cs, 1); cs += row_shr_f(cs, 2); cs += row_shr_f(cs, 4); cs += row_shr_f(cs, 8);
                    const float Pt = __expf(cs), Pinv = __expf(-cs), Pprev = __expf(cs - ld);
                    const float a = 1.f / (1.f + __expf(-(acca[nb][i] + a04[i])));
                    const float k = kcc[i] + (kpp[i] - kcc[i]) * mk[i], r = rcc[i] + (rpp[i] - rcc[i]) * mr[i], v = vcc[i] + (vpp[i] - vcc[i]) * mv[i];
                    const float kkn = k * kk4[i] * rn, bb = kkn * a, kp = k * (1.f + (a - 1.f) * ka4[i]);
                    drk += r * kp * rk4[i];
                    const float P15 = __shfl(Pt, (lane & 48) | 15); p15[i] = P15;
                    const float Pend = P15 * Pinv;
                    At[i] = -kkn * Pprev; Rt[i] = r * Pt; Bt[i] = bb * Pinv; Kt[i] = kp * Pinv; Bp[i] = bb * Pend; Kp[i] = kp * Pend; Vv[i] = v;
                }
                if (tq == 0) *(f32x4*)(rec + REC_P15 + (g * 16 + nb * 4) * 4) = p15;
                dAt[h2] = (v2u){pk2(At[0], At[1]), pk2(At[2], At[3])}; dRt[h2] = (v2u){pk2(Rt[0], Rt[1]), pk2(Rt[2], Rt[3])}; dBt[h2] = (v2u){pk2(Bt[0], Bt[1]), pk2(Bt[2], Bt[3])}; dKt[h2] = (v2u){pk2(Kt[0], Kt[1]), pk2(Kt[2], Kt[3])};
                dBp[h2] = (v2u){pk2(Bp[0], Bp[1]), pk2(Bp[2], Bp[3])}; dKp[h2] = (v2u){pk2(Kp[0], Kp[1]), pk2(Kp[2], Kp[3])}; dVv[h2] = (v2u){pk2(Vv[0], Vv[1]), pk2(Vv[2], Vv[3])};
                __builtin_amdgcn_sched_barrier(0);
            }
#define FR8(d) __builtin_bit_cast(bf16x8, (v4u){d[0].x, d[0].y, d[1].x, d[1].y})
            const bf16x8 AtF = FR8(dAt), RtF = FR8(dRt), BtF = FR8(dBt), KtF = FR8(dKt), BpF = FR8(dBp), KpF = FR8(dKp), VF = FR8(dVv);
#undef FR8
            ((bf16x8*)(rec + REC_AT + s2 * 1024))[lane] = AtF; ((bf16x8*)(rec + REC_RT + s2 * 1024))[lane] = RtF;
            N = mm16(BtF, AtF, N); NT = mm16(AtF, BtF, NT); Nka = mm16(KtF, AtF, Nka); Qb = mm16(BtF, RtF, Qb); Qk = mm16(KtF, RtF, Qk);
#pragma unroll
            for (int h2 = 0; h2 < 2; ++h2) {
                const int kt = 2 * s2 + h2; const bf16x8 sel = h2 ? Sel1 : Sel0;
                const f32x4 bT = mm16(BpF, sel, Z4), kT = mm16(KpF, sel, Z4), vT = mm16(VF, sel, Z4);
                const float bl[4] = {bT[0], bT[1], bT[2], bT[3]}, kl[4] = {kT[0], kT[1], kT[2], kT[3]};
                ((bf16x8*)(rec + REC_BK + kt * 1024))[lane] = pk8(bl, kl);
                v2u o; o.x = pk2(vT[0], vT[1]); o.y = pk2(vT[2], vT[3]); ((v2u*)(rec + REC_VT + kt * 512))[lane] = o;
            }
            __builtin_amdgcn_sched_barrier(0);
        }
        drk += __shfl_xor(drk, 16); drk += __shfl_xor(drk, 32);
        if (g == 0) DOTRK[(size_t)row * 8 + head] = drk;
#pragma unroll
        for (int i = 0; i < 4; ++i) { const int rr = 4 * g + i;
            if (!(rr < tq)) { N[i] = 0.f; Nka[i] = 0.f; }
            if (!(tq < rr)) NT[i] = 0.f;
            if (!(rr <= tq)) { Qb[i] = 0.f; Qk[i] = 0.f; } }
        f32x4 R = N, RT = NT;
#pragma unroll
        for (int i = 0; i < 4; ++i) { if (4 * g + i == tq) { R[i] += 1.f; RT[i] += 1.f; } }
        {
            const f32x4 N2 = mm16(pk4lo(NT), pk4lo(N), Z4), N2T = mm16(pk4lo(N), pk4lo(NT), Z4);
            const f32x4 R1 = mm16(pk4lo(RT), pk4lo(N2), R), RT1 = mm16(pk4lo(N2), pk4lo(RT), RT);
            const f32x4 N4 = mm16(pk4lo(N2T), pk4lo(N2), Z4), N4T = mm16(pk4lo(N2), pk4lo(N2T), Z4);
            const f32x4 R2 = mm16(pk4lo(RT1), pk4lo(N4), R1), RT2 = mm16(pk4lo(N4), pk4lo(RT1), RT1);
            const f32x4 N8 = mm16(pk4lo(N4T), pk4lo(N4), Z4);
            R = mm16(pk4lo(RT2), pk4lo(N8), R2);
        }
        { v2u o; o.x = pk2(R[0], R[1]); o.y = pk2(R[2], R[3]); ((v2u*)(rec + REC_TM))[lane] = o;
          o.x = pk2(Qb[0], Qb[1]); o.y = pk2(Qb[2], Qb[3]); ((v2u*)(rec + REC_QB))[lane] = o;
          o.x = pk2(Nka[0], Nka[1]); o.y = pk2(Nka[2], Nka[3]); ((v2u*)(rec + REC_NKA))[lane] = o;
          o.x = pk2(Qk[0], Qk[1]); o.y = pk2(Qk[2], Qk[3]); ((v2u*)(rec + REC_QK))[lane] = o; }
    }
#undef ST_LOAD
#undef PREP_BAR
}

constexpr int KV_PITCH = 72;
__device__ __forceinline__ s16x4 tr_read(const LAS bf16* p) { typedef short v4i16_t __attribute__((ext_vector_type(4))); return __builtin_bit_cast(s16x4, __builtin_amdgcn_ds_read_tr16_b64_v4i16((LAS v4i16_t*)p)); }
__device__ __forceinline__ void ph_attn(Frame& F, int w0, int nw) {
    const bf16* PROJ = (const bf16*)(F.ws + WS_PROJ); bf16* MIX = (bf16*)F.out; const float* sink = F.in[5];
    LAS bf16* Ks = (LAS bf16*)(F.lds); LAS bf16* Vs = Ks + 256 * KV_PITCH;
    for (int i = F.tid; i < 16 * KV_PITCH / 2; i += 512) ((LAS unsigned*)(Vs + 256 * KV_PITCH))[i] = 0u;
    const int tq = F.lane & 15, g = F.lane >> 4;
    v4u kxr[4], vxr[4];
#define AT_LOAD(u_) do { const int b_ = (u_) >> 5, kvh_ = ((u_) >> 4) & 1, n_ = (u_) & 15; const size_t r0_ = (size_t)b_ * SEQ + (size_t)n_ * 128; \
        _Pragma("unroll") for (int i = 0; i < 4; ++i) { const int c = F.tid + 512 * i, krow = c >> 3, part = c & 7; kxr[i] = (v4u){0u, 0u, 0u, 0u}; vxr[i] = kxr[i]; \
            if (n_ > 0 || krow >= 128) { const bf16* src = PROJ + (r0_ - 128 + krow) * IN_COLS + kvh_ * 64 + part * 8; kxr[i] = *(const v4u*)(src + C_K); vxr[i] = *(const v4u*)(src + C_V); } } } while (0)
    if (w0 < 512) AT_LOAD(w0);
    for (int u = w0; u < 512; u += nw) {
        const int b = u >> 5, kvh = (u >> 4) & 1, n = u & 15;
        const size_t row0 = (size_t)b * SEQ + (size_t)n * 128;
        const int gq = F.wave >> 1, qh = F.wave & 1, hq = kvh * 4 + gq;
        const bf16* qp0 = PROJ + (row0 + 64 * qh + tq) * IN_COLS + C_Q + hq * 64 + 8 * g;
        bf16x8 Qn0 = *(const bf16x8*)qp0, Qn1 = *(const bf16x8*)(qp0 + 32);
#pragma unroll
        for (int i = 0; i < 4; ++i) { const int c = F.tid + 512 * i, krow = c >> 3, part = c & 7;
            *(LAS v4u*)(Ks + krow * KV_PITCH + part * 8) = kxr[i]; *(LAS v4u*)(Vs + krow * KV_PITCH + part * 8) = vxr[i]; }
        if (u + nw < 512) AT_LOAD(u + nw);
        asm volatile("s_waitcnt lgkmcnt(0)" ::: "memory"); __builtin_amdgcn_s_barrier(); asm volatile("" ::: "memory");
        const float sinkv = sink[hq];
        for (int qb = 0; qb < 4; ++qb) {
            const int i0 = 64 * qh + 16 * qb, kb0 = 4 * qh + qb, iq = i0 + tq;
            const bf16x8 Q0 = Qn0, Q1 = Qn1;
            if (qb < 3) { const bf16* qpn = qp0 + (size_t)(16 * (qb + 1)) * IN_COLS; Qn0 = *(const bf16x8*)qpn; Qn1 = *(const bf16x8*)(qpn + 32); }
            float s[9][4]; float mx = -INFINITY;
#pragma unroll
            for (int kbi = 0; kbi < 9; ++kbi) {
                const LAS bf16* kp = Ks + ((kb0 + kbi) * 16 + tq) * KV_PITCH + 8 * g;
                f32x4 a = (f32x4){0.f, 0.f, 0.f, 0.f};
                a = __builtin_amdgcn_mfma_f32_16x16x32_bf16(*(const LAS bf16x8*)kp, Q0, a, 0, 0, 0);
                a = __builtin_amdgcn_mfma_f32_16x16x32_bf16(*(const LAS bf16x8*)(kp + 32), Q1, a, 0, 0, 0);
#pragma unroll
                for (int i = 0; i < 4; ++i) { const int j = (kb0 + kbi) * 16 + 4 * g + i; const bool ok = (j > iq) && (j <= iq + 128) && (n > 0 || j >= 128);
                    const float sv = ok ? a[i] * 0.125f : -INFINITY; s[kbi][i] = sv; mx = fmaxf(mx, sv); }
            }
            mx = fmaxf(mx, __shfl_xor(mx, 16)); mx = fmaxf(mx, __shfl_xor(mx, 32)); mx = fmaxf(mx, sinkv);
            float l = 0.f;
#pragma unroll
            for (int kbi = 0; kbi < 9; ++kbi)
#pragma unroll
                for (int i = 0; i < 4; ++i) { const float p = __expf(s[kbi][i] - mx); s[kbi][i] = p; l += p; }
            l += __shfl_xor(l, 16); l += __shfl_xor(l, 32); l += __expf(sinkv - mx);
            const float rl = 1.f / l;
            bf16x8 P[5];
#pragma unroll
            for (int pr = 0; pr < 5; ++pr) {
#pragma unroll
                for (int i = 0; i < 4; ++i) { P[pr][i] = (short)f2bf(s[2 * pr][i]); P[pr][4 + i] = (pr < 4) ? (short)f2bf(s[(pr < 4) ? 2 * pr + 1 : 0][i]) : (short)0; }
            }
            bf16* op = MIX + (row0 + iq) * D + hq * 64 + 4 * g;
#pragma unroll
            for (int db = 0; db < 4; ++db) {
                f32x4 o = (f32x4){0.f, 0.f, 0.f, 0.f};
#pragma unroll
                for (int pr = 0; pr < 5; ++pr) {
                    const LAS bf16* vp = Vs + ((kb0 + 2 * pr) * 16 + 4 * g + (tq >> 2)) * KV_PITCH + db * 16 + 4 * (tq & 3);
                    const s16x4 lo = tr_read(vp), hi = tr_read(vp + 16 * KV_PITCH);
                    const bf16x8 Vf = (bf16x8){lo[0], lo[1], lo[2], lo[3], hi[0], hi[1], hi[2], hi[3]};
                    o = __builtin_amdgcn_mfma_f32_16x16x32_bf16(Vf, P[pr], o, 0, 0, 0);
                }
                v2u w; w.x = pk2(o[0] * rl, o[1] * rl); w.y = pk2(o[2] * rl, o[3] * rl);
                *(v2u*)(op + db * 16) = w;
            }
        }
        asm volatile("s_waitcnt lgkmcnt(0)" ::: "memory"); __builtin_amdgcn_s_barrier(); asm volatile("" ::: "memory");
    }
#undef AT_LOAD
}

struct ScanRec { bf16x8 f[8]; v2u m[4]; v2u vt; f32x4 p[4]; };
__device__ __forceinline__ void scan_load(ScanRec& Rr, const unsigned char* rec, int lane, int vt, int g) {
#pragma unroll
    for (int i = 0; i < 8; ++i) Rr.f[i] = ((const bf16x8*)(rec + i * 1024))[lane];
#pragma unroll
    for (int i = 0; i < 4; ++i) Rr.m[i] = ((const v2u*)(rec + REC_TM + i * 512))[lane];
    Rr.vt = ((const v2u*)(rec + REC_VT + vt * 512))[lane];
#pragma unroll
    for (int i = 0; i < 4; ++i) Rr.p[i] = *(const f32x4*)(rec + REC_P15 + (g * 16 + i * 4) * 4);
}
__device__ __forceinline__ bf16x8 lo8(const v2u a) { return __builtin_bit_cast(bf16x8, (v4u){a.x, a.y, 0u, 0u}); }
__device__ __forceinline__ void scan_chunk(const ScanRec& Rr, f32x4 (&S)[4], bf16* yp) {
    const f32x4 Z4 = (f32x4){0.f, 0.f, 0.f, 0.f};
    const bf16x8 Vlo = lo8(Rr.vt);
    const f32x4 W0 = mm16(lo8(Rr.m[2]), Vlo, Z4), Y0 = mm16(lo8(Rr.m[3]), Vlo, Z4);
    const bf16x8 Sb0 = __builtin_bit_cast(bf16x8, (v4u){pk2(S[0][0], S[0][1]), pk2(S[0][2], S[0][3]), pk2(S[1][0], S[1][1]), pk2(S[1][2], S[1][3])});
    const bf16x8 Sb1 = __builtin_bit_cast(bf16x8, (v4u){pk2(S[2][0], S[2][1]), pk2(S[2][2], S[2][3]), pk2(S[3][0], S[3][1]), pk2(S[3][2], S[3][3])});
    const f32x4 XW = mm16(Rr.f[1], Sb1, mm16(Rr.f[0], Sb0, W0));
    f32x4 YT = mm16(Rr.f[3], Sb1, mm16(Rr.f[2], Sb0, Y0));
    const f32x4 UT = mm16(lo8(Rr.m[0]), pk4lo(XW), Z4);
    const v2u utp = (v2u){pk2(UT[0], UT[1]), pk2(UT[2], UT[3])};
    YT = mm16(lo8(Rr.m[1]), lo8(utp), YT);
    const bf16x8 UV = __builtin_bit_cast(bf16x8, (v4u){utp.x, utp.y, Rr.vt.x, Rr.vt.y});
#pragma unroll
    for (int kt = 0; kt < 4; ++kt) S[kt] = mm16(Rr.f[4 + kt], UV, S[kt] * Rr.p[kt]);
#pragma unroll
    for (int i = 0; i < 4; ++i) yp[(size_t)i * 512] = (bf16)f2bf(YT[i]);
}
__device__ __forceinline__ float wave_sum_f(float v) { v = red16(v); v += __shfl_xor(v, 16); v += __shfl_xor(v, 32); return v; }
__device__ __forceinline__ float wave_max(float v) {
    v = fmaxf(v, dpp_f(v, 0)); v = fmaxf(v, dpp_f(v, 1)); v = fmaxf(v, dpp_f(v, 2)); v = fmaxf(v, dpp_f(v, 3));
    v = fmaxf(v, __shfl_xor(v, 16)); v = fmaxf(v, __shfl_xor(v, 32)); return v;
}
__device__ __forceinline__ unsigned q4(const f32x4 v, float inv, int bias) {
    const int a = (int)rintf(v.x * inv) + bias, b = (int)rintf(v.y * inv) + bias, c = (int)rintf(v.z * inv) + bias, d = (int)rintf(v.w * inv) + bias;
    return (unsigned)(a & 0xff) | ((unsigned)(b & 0xff) << 8) | ((unsigned)(c & 0xff) << 16) | ((unsigned)(d & 0xff) << 24);
}
__device__ __forceinline__ void cv_row(Frame& F, int r, const f32x4 (&xv)[4], int lane) {
    unsigned* U8 = (unsigned*)(F.ws + WS_U8); unsigned* V8 = (unsigned*)(F.ws + WS_V8); float* US = (float*)(F.ws + WS_US); float* VS = (float*)(F.ws + WS_VS);
    float am = 0.f;
#pragma unroll
    for (int j = 0; j < 4; ++j) am = fmaxf(am, fmaxf(fmaxf(fabsf(xv[j].x), fabsf(xv[j].y)), fmaxf(fabsf(xv[j].z), fabsf(xv[j].w))));
    am = fmaxf(wave_max(am), 1e-30f); const float inv = 127.f / am;
    unsigned* T8 = r < 16384 ? U8 : V8; const int e = r < 16384 ? r : r - 16384;
#pragma unroll
    for (int j = 0; j < 4; ++j) T8[((size_t)(2 * j + (lane >> 5)) * 16384 + e) * 32 + (lane & 31)] = q4(xv[j], inv, 0);
    if (lane == 0) { if (r < 16384) US[e] = am * (1.f / 127.f); else VS[e] = am * (1.f / 127.f); }
}
__device__ __forceinline__ void ph_convert(Frame& F, int gw, int NGW, int r_lo = 0) {
    const int lane = F.lane;
    unsigned* U8 = (unsigned*)(F.ws + WS_U8); unsigned* V8 = (unsigned*)(F.ws + WS_V8); float* US = (float*)(F.ws + WS_US); float* VS = (float*)(F.ws + WS_VS);
    f32x4 rn[4];
#define CV_LOAD(r_) do { const float* s_ = ((r_) < 16384) ? F.in[22] + (size_t)(r_) * D : F.in[23] + (size_t)((r_) - 16384) * D; \
        _Pragma("unroll") for (int j = 0; j < 4; ++j) rn[j] = *(const f32x4*)(s_ + 4 * lane + 256 * j); } while (0)
    if (r_lo + gw < 32768) CV_LOAD(r_lo + gw);
    for (int r = r_lo + gw; r < 32768; r += NGW) {
        f32x4 xv[4];
#pragma unroll
        for (int j = 0; j < 4; ++j) xv[j] = rn[j];
        if (r + NGW < 32768) CV_LOAD(r + NGW);
        float am = 0.f;
#pragma unroll
        for (int j = 0; j < 4; ++j) am = fmaxf(am, fmaxf(fmaxf(fabsf(xv[j].x), fabsf(xv[j].y)), fmaxf(fabsf(xv[j].z), fabsf(xv[j].w))));
        am = fmaxf(wave_max(am), 1e-30f); const float inv = 127.f / am;
        if (r < 16384) {
#pragma unroll
            for (int j = 0; j < 4; ++j) U8[((size_t)(2 * j + (lane >> 5)) * 16384 + r) * 32 + (lane & 31)] = q4(xv[j], inv, 0);
            if (lane == 0) US[r] = am * (1.f / 127.f);
        } else {
            const int e = r - 16384;
#pragma unroll
            for (int j = 0; j < 4; ++j) V8[((size_t)(2 * j + (lane >> 5)) * 16384 + e) * 32 + (lane & 31)] = q4(xv[j], inv, 0);
            if (lane == 0) VS[e] = am * (1.f / 127.f);
        }
    }
#undef CV_LOAD
}
__device__ __forceinline__ void scan_lds_load(ScanRec& Rr, const LAS unsigned char* rec, int lane, int vt, int g) {
#pragma unroll
    for (int i = 0; i < 8; ++i) Rr.f[i] = ((const LAS bf16x8*)(rec + i * 1024))[lane];
#pragma unroll
    for (int i = 0; i < 4; ++i) Rr.m[i] = ((const LAS v2u*)(rec + REC_TM + i * 512))[lane];
    Rr.vt = ((const LAS v2u*)(rec + REC_VT + vt * 512))[lane];
#pragma unroll
    for (int i = 0; i < 4; ++i) Rr.p[i] = *(const LAS f32x4*)(rec + REC_P15 + (g * 16 + i * 4) * 4);
}
__device__ __forceinline__ void ph_scan(Frame& F) {
    const unsigned char* REC = F.ws + WS_REC; bf16* YB = (bf16*)(F.ws + WS_YB);
    const int lane = F.lane, tq = lane & 15, g = lane >> 4;
    constexpr int NCH = SEQ / 16;
#define SC_BAR() do { asm volatile("s_waitcnt lgkmcnt(0)" ::: "memory"); __builtin_amdgcn_s_barrier(); asm volatile("" ::: "memory"); } while (0)
    const bool split = (F.G == 256); const int n_scan = split ? 128 : F.G, sidx = split ? (F.vcu >> 1) : F.vcu; const bool scanner = split ? ((F.vcu & 1) == 0) : true;
    if (scanner) for (int item = sidx; item < 128; item += n_scan) {
        const int bh = item, b = bh >> 3, h = bh & 7;
        const unsigned char* rec = REC + (size_t)bh * NCH * REC_BYTES;
        if (F.wave < 4) {
            const int vt = F.wave;
            bf16* yp = YB + ((size_t)b * SEQ + 4 * g) * 512 + h * 64 + vt * 16 + tq;
            f32x4 S[4];
#pragma unroll
            for (int kt = 0; kt < 4; ++kt) S[kt] = (f32x4){0.f, 0.f, 0.f, 0.f};
            SC_BAR();
            for (int c = 0; c < NCH; ++c) {
                ScanRec Rr; scan_lds_load(Rr, F.lds + (c & 1) * REC_BYTES, lane, vt, g);
                scan_chunk(Rr, S, yp + (size_t)c * 16 * 512);
                SC_BAR();
            }
        } else {
            const int l = F.tid - 256;
            const bool fourth = l < 16;
            v4u bf[4][4];
#define LD_CH(ch_, bi_) do { const unsigned char* r_ = rec + (size_t)(ch_) * REC_BYTES; bf[bi_][0] = *(const v4u*)(r_ + l * 16); bf[bi_][1] = *(const v4u*)(r_ + (l + 256) * 16); bf[bi_][2] = *(const v4u*)(r_ + (l + 512) * 16); if (fourth) bf[bi_][3] = *(const v4u*)(r_ + (768 + l) * 16); } while (0)
#define WR_CH(slot_, bi_) do { LAS unsigned char* s_ = F.lds + (slot_) * REC_BYTES; *(LAS v4u*)(s_ + l * 16) = bf[bi_][0]; *(LAS v4u*)(s_ + (l + 256) * 16) = bf[bi_][1]; *(LAS v4u*)(s_ + (l + 512) * 16) = bf[bi_][2]; if (fourth) *(LAS v4u*)(s_ + (768 + l) * 16) = bf[bi_][3]; } while (0)
            LD_CH(0, 0); WR_CH(0, 0);
            LD_CH(1, 1); LD_CH(2, 2); LD_CH(3, 3); LD_CH(4, 0);
            SC_BAR();
            for (int c = 0; c < NCH; c += 4) {
#define LD_STEP(k_) do { const int cc_ = c + (k_); if (cc_ + 1 < NCH) { WR_CH((cc_ + 1) & 1, ((k_) + 1) & 3); if (cc_ + 5 < NCH) LD_CH(cc_ + 5, ((k_) + 1) & 3); } SC_BAR(); } while (0)
                LD_STEP(0); LD_STEP(1); LD_STEP(2); LD_STEP(3);
#undef LD_STEP
            }
#undef LD_CH
#undef WR_CH
        }
    }
#undef SC_BAR
    if (split) { if (!scanner) { const int w_ = (F.vcu >> 1) * NWAVES + F.wave; ph_convert(F, w_, 128 * NWAVES, 16384); ph_attn(F, F.vcu >> 1, 128);
                                 ph_weights(F, w_, 128 * NWAVES, 0, 1024, -1); ph_weights(F, w_, 128 * NWAVES, 2304, 2816, -1); } }
    else ph_convert(F, F.vcu * NWAVES + F.wave, F.G * NWAVES);
}

__device__ __forceinline__ void unpack8(const v4u u, float (&o)[8]) { o[0] = bflo(u.x); o[1] = bfhi(u.x); o[2] = bflo(u.y); o[3] = bfhi(u.y); o[4] = bflo(u.z); o[5] = bfhi(u.z); o[6] = bflo(u.w); o[7] = bfhi(u.w); }
__device__ __forceinline__ void ph_post(Frame& F) {
    const bf16* PROJ = (const bf16*)(F.ws + WS_PROJ); const float* mu = F.in[6]; const float* lnx_g = F.in[15]; const float* lnx_b = F.in[16];
    const bf16* YB = (const bf16*)(F.ws + WS_YB); const float* DOTRK = (const float*)(F.ws + WS_DOTRK); const bf16* RWG = (const bf16*)(F.ws + WS_G); bf16* MIX = (bf16*)F.out;
    const int gw = F.vcu * NWAVES + F.wave, NGW = F.G * NWAVES, j = F.lane * 8;
    float mv[8], lg[8], lb[8];
    { const f32x4 a = *(const f32x4*)(mu + RW_V + j), b = *(const f32x4*)(mu + RW_V + j + 4); mv[0] = a.x; mv[1] = a.y; mv[2] = a.z; mv[3] = a.w; mv[4] = b.x; mv[5] = b.y; mv[6] = b.z; mv[7] = b.w; }
    { const f32x4 a = *(const f32x4*)(lnx_g + j), b = *(const f32x4*)(lnx_g + j + 4); lg[0] = a.x; lg[1] = a.y; lg[2] = a.z; lg[3] = a.w; lg[4] = b.x; lg[5] = b.y; lg[6] = b.z; lg[7] = b.w; }
    { const f32x4 a = *(const f32x4*)(lnx_b + j), b = *(const f32x4*)(lnx_b + j + 4); lb[0] = a.x; lb[1] = a.y; lb[2] = a.z; lb[3] = a.w; lb[4] = b.x; lb[5] = b.y; lb[6] = b.z; lb[7] = b.w; }
    for (int n = gw; n < D; n += NGW) p7_wq8_row((const bf16*)(F.ws + WS_WOUT), (const unsigned*)(F.ws + WS_W2CMAX), F.ws + WS_W2Q, n, F.lane);
    unsigned char* MIXQ = F.ws + WS_MIXQ; float* RS2 = (float*)(F.ws + WS_RS2);
    v4u n_yu, n_vc, n_vp, n_gu, n_au; float n_dot;
#define PO_LOAD(m_) do { const bf16* pv_ = PROJ + (size_t)(m_) * IN_COLS + C_RW + RW_V + j; n_yu = *(const v4u*)(YB + (size_t)(m_) * 512 + j); n_vc = *(const v4u*)pv_; \
        n_vp = *(const v4u*)(pv_ - (((m_) & (SEQ - 1)) != 0 ? IN_COLS : 0)); n_gu = *(const v4u*)(RWG + (size_t)(m_) * 512 + j); n_dot = DOTRK[(size_t)(m_) * 8 + (F.lane >> 3)]; n_au = *(const v4u*)(MIX + (size_t)(m_) * D + j); } while (0)
    if (gw < M) PO_LOAD(gw);
    for (int m = gw; m < M; m += NGW) {
        const bool has_prev = (m & (SEQ - 1)) != 0;
        const v4u yu = n_yu, vc = n_vc, gu = n_gu, au = n_au; const v4u vp = has_prev ? n_vp : (v4u){0u, 0u, 0u, 0u}; const float dot = n_dot;
        { const int mn = m + NGW < M ? m + NGW : m; PO_LOAD(mn); }
        float y[8], vc8[8], vp8[8], g8[8];
        unpack8(yu, y); unpack8(vc, vc8); unpack8(vp, vp8); unpack8(gu, g8);
        float sum = 0.f; float vv[8];
#pragma unroll
        for (int e = 0; e < 8; ++e) { vv[e] = vc8[e] + (vp8[e] - vc8[e]) * mv[e]; sum += y[e]; }
        sum = red8(sum);
        const float mean = sum * (1.f / 64.f); float q = 0.f;
#pragma unroll
        for (int e = 0; e < 8; ++e) { y[e] -= mean; q += y[e] * y[e]; }
        q = red8(q);
        const float rstd = rsqrtf(q * (1.f / 64.f) + GN_EPS);
        float o[8];
#pragma unroll
        for (int e = 0; e < 8; ++e) o[e] = ((y[e] * rstd) * lg[e] + lb[e] + dot * vv[e]) * g8[e];
        float a8[8]; unpack8(au, a8); float am = 0.f;
#pragma unroll
        for (int e = 0; e < 8; ++e) am = fmaxf(am, fmaxf(fabsf(o[e]), fabsf(a8[e])));
        am = fmaxf(wave_max(am), 1e-20f); const float inv = 127.f / am;
        *(v2u*)(MIXQ + (size_t)m * D + j) = (v2u){q4((f32x4){a8[0], a8[1], a8[2], a8[3]}, inv, 0), q4((f32x4){a8[4], a8[5], a8[6], a8[7]}, inv, 0)};
        *(v2u*)(MIXQ + (size_t)m * D + 512 + j) = (v2u){q4((f32x4){o[0], o[1], o[2], o[3]}, inv, 0), q4((f32x4){o[4], o[5], o[6], o[7]}, inv, 0)};
        if (F.lane == 0) RS2[m] = am * (1.f / 127.f);
    }
#undef PO_LOAD
}

__device__ __forceinline__ void ph_prologue(Frame& F) {
    const int gw = F.vcu * NWAVES + F.wave, NGW = F.G * NWAVES, lane = F.lane;
    for (int n = gw; n < IN_COLS; n += NGW) p7_wq8_row((const bf16*)(F.ws + WS_WIN), (const unsigned*)(F.ws + WS_W1CMAX), F.ws + WS_W1Q, n, lane);
    const float* modp = (const float*)(F.ws + WS_MOD);
    unsigned* H1Q = (unsigned*)(F.ws + WS_H); float* RS1 = (float*)(F.ws + WS_RS1);
    const int rpw = M / NGW, m_begin = gw * rpw, m_end = m_begin + rpw;
    const float* md = modp + (m_begin >> 11) * 6144;
    f32x4 sh[4], sc[4];
#pragma unroll
    for (int j = 0; j < 4; ++j) { const int col = 4 * lane + 256 * j; sh[j] = *(const f32x4*)(md + col); sc[j] = *(const f32x4*)(md + 1024 + col) + 1.0f; }
    f32x4 xn[4];
#define MOD_LOAD(m_) do { const float* x_ = F.in[0] + (size_t)(m_) * D; _Pragma("unroll") for (int j = 0; j < 4; ++j) xn[j] = *(const f32x4*)(x_ + 4 * lane + 256 * j); } while (0)
    MOD_LOAD(m_begin);
    for (int m = m_begin; m < m_end; ++m) {
        f32x4 hv[4]; float am = 0.f;
#pragma unroll
        for (int j = 0; j < 4; ++j) { hv[j] = xn[j] * sc[j] + sh[j]; am = fmaxf(am, fmaxf(fmaxf(fabsf(hv[j].x), fabsf(hv[j].y)), fmaxf(fabsf(hv[j].z), fabsf(hv[j].w)))); }
        if (m + 1 < m_end) MOD_LOAD(m + 1);
        am = fmaxf(wave_max(am), 1e-20f); const float inv = 127.f / am;
#pragma unroll
        for (int j = 0; j < 4; ++j) H1Q[(size_t)m * 256 + lane + 64 * j] = q4(hv[j], inv, 0);
        if (lane == 0) RS1[m] = am * (1.f / 127.f);
    }
#undef MOD_LOAD
}
__device__ __forceinline__ void ph_ln1(Frame& F) {
    const int gw = F.vcu * NWAVES + F.wave, NGW = F.G * NWAVES, lane = F.lane;
    const float* modp = (const float*)(F.ws + WS_MOD); const bf16* Y1 = (const bf16*)(F.ws + WS_Y1);
    unsigned* H8 = (unsigned*)(F.ws + WS_H8); float* HS = (float*)(F.ws + WS_HS);
    const float* lng = F.in[18]; const float* lnb = F.in[19];
    for (int n = gw; n < NSC; n += NGW) p7_wq8_row((const bf16*)(F.ws + WS_WP), (const unsigned*)(F.ws + WS_WCMAX), F.ws + WS_WP8, n, lane);
    const int rpw = M / NGW, m_begin = gw * rpw, m_end = m_begin + rpw;
    const float* md = modp + (m_begin >> 11) * 6144;
    f32x4 gt[4], sh[4], sc[4], gg[4], bb[4];
#pragma unroll
    for (int j = 0; j < 4; ++j) { const int col = 4 * lane + 256 * j; gt[j] = *(const f32x4*)(md + 2048 + col); sh[j] = *(const f32x4*)(md + 3072 + col); sc[j] = *(const f32x4*)(md + 4096 + col) + 1.0f;
        gg[j] = *(const f32x4*)(lng + col); bb[j] = *(const f32x4*)(lnb + col); }
    f32x4 xn[4]; v2u yn[4];
#define LN1_LOAD(m_) do { const float* x_ = F.in[0] + (size_t)(m_) * D; const bf16* y_ = Y1 + (size_t)(m_) * D; \
        _Pragma("unroll") for (int j = 0; j < 4; ++j) { xn[j] = *(const f32x4*)(x_ + 4 * lane + 256 * j); yn[j] = *(const v2u*)(y_ + 4 * lane + 256 * j); } } while (0)
    LN1_LOAD(m_begin);
    for (int m = m_begin; m < m_end; ++m) {
        f32x4 v[4]; float s = 0.f;
#pragma unroll
        for (int j = 0; j < 4; ++j) { const f32x4 yv = (f32x4){bflo(yn[j].x), bfhi(yn[j].x), bflo(yn[j].y), bfhi(yn[j].y)}; v[j] = xn[j] * ALPHA + gt[j] * yv; s += (v[j].x + v[j].y) + (v[j].z + v[j].w); }
        if (m + 1 < m_end) LN1_LOAD(m + 1);
        const float mean = wave_sum_f(s) * (1.f / D); float s2 = 0.f;
#pragma unroll
        for (int j = 0; j < 4; ++j) { v[j] = v[j] - mean; s2 += (v[j].x * v[j].x + v[j].y * v[j].y) + (v[j].z * v[j].z + v[j].w * v[j].w); }
        const float rstd = rsqrtf(wave_sum_f(s2) * (1.f / D) + LN_EPS);
        f32x4 h[4]; float am = 0.f;
#pragma unroll
        for (int j = 0; j < 4; ++j) { const int col = 4 * lane + 256 * j;
            const f32x4 x1 = (v[j] * rstd) * gg[j] + bb[j]; { v2u xo; xo.x = pk2(x1.x, x1.y); xo.y = pk2(x1.z, x1.w); *(v2u*)(Y1 + (size_t)m * D + col) = xo; }
            h[j] = x1 * sc[j] + sh[j];
            am = fmaxf(am, fmaxf(fmaxf(fabsf(h[j].x), fabsf(h[j].y)), fmaxf(fabsf(h[j].z), fabsf(h[j].w)))); }
        am = fmaxf(wave_max(am), 1e-20f); const float inv = 127.f / am;
#pragma unroll
        for (int j = 0; j < 4; ++j) H8[(size_t)m * 256 + lane + 64 * j] = q4(h[j], inv, 0);
        if (lane == 0) HS[m] = am * (1.f / 127.f);
    }
#undef LN1_LOAD
}

__device__ __forceinline__ unsigned f2key(float f) { const unsigned u = __float_as_uint(f); return u ^ ((u >> 31) ? 0xffffffffu : 0x80000000u); }
__device__ __forceinline__ float key2f(unsigned k) { const unsigned u = (k >> 31) ? (k ^ 0x80000000u) : ~k; return __uint_as_float(u); }
#define TOPK_INSERT(L, key) do { unsigned k_ = (key); _Pragma("unroll") for (int q_ = 0; q_ < 16; ++q_) { const unsigned hi_ = L[q_] > k_ ? L[q_] : k_; k_ = L[q_] > k_ ? k_ : L[q_]; L[q_] = hi_; } } while (0)
__device__ __forceinline__ void ce_desc(unsigned& x, unsigned& y) { const unsigned hi = x > y ? x : y, lo = x > y ? y : x; x = hi; y = lo; }
__device__ __forceinline__ void bitonic_sort16_desc(unsigned (&a)[16]) {
#define CE_(i, j) ce_desc(a[i], a[j])
    CE_(0, 13); CE_(1, 12); CE_(2, 15); CE_(3, 14); CE_(4, 8); CE_(5, 6); CE_(7, 11); CE_(9, 10);
    CE_(0, 5); CE_(1, 7); CE_(2, 9); CE_(3, 4); CE_(6, 13); CE_(8, 14); CE_(10, 15); CE_(11, 12);
    CE_(0, 1); CE_(2, 3); CE_(4, 5); CE_(6, 8); CE_(7, 9); CE_(10, 11); CE_(12, 13); CE_(14, 15);
    CE_(0, 2); CE_(1, 3); CE_(4, 10); CE_(5, 11); CE_(6, 7); CE_(8, 9); CE_(12, 14); CE_(13, 15);
    CE_(1, 2); CE_(3, 12); CE_(4, 6); CE_(5, 7); CE_(8, 10); CE_(9, 11); CE_(13, 14);
    CE_(1, 4); CE_(2, 6); CE_(5, 8); CE_(7, 10); CE_(9, 13); CE_(11, 14);
    CE_(2, 4); CE_(3, 6); CE_(9, 12); CE_(11, 13);
    CE_(3, 5); CE_(6, 8); CE_(7, 9); CE_(10, 12);
    CE_(3, 4); CE_(5, 6); CE_(7, 8); CE_(9, 10); CE_(11, 12);
    CE_(6, 7); CE_(8, 9);
#undef CE_
}
__device__ __forceinline__ void bitonic_merge16_desc(unsigned (&a)[16]) {
#pragma unroll
    for (int j = 8; j > 0; j >>= 1)
#pragma unroll
        for (int i = 0; i < 16; ++i) { const int l = i ^ j; if (l > i) ce_desc(a[i], a[l]); }
}
template <bool SORTED = false  >
__device__ __forceinline__ void top16_absorb(unsigned (&L)[16], unsigned (&B)[16], bool first) {
    if (!SORTED) bitonic_sort16_desc(B);
    if (first) {
#pragma unroll
        for (int i = 0; i < 16; ++i) L[i] = B[i];
    } else {
#pragma unroll
        for (int i = 0; i < 16; ++i) L[i] = L[i] > B[15 - i] ? L[i] : B[15 - i];
        bitonic_merge16_desc(L);
    }
}
__device__ __forceinline__ unsigned pick_byte(const unsigned (&P)[4], unsigned i) {
    const unsigned long long lo = (unsigned long long)P[0] | ((unsigned long long)P[1] << 32), hi = (unsigned long long)P[2] | ((unsigned long long)P[3] << 32);
    const unsigned long long w = (i & 8u) ? hi : lo;
    return (unsigned)(w >> ((i & 7u) * 8u)) & 0xffu;
}
__device__ __forceinline__ void ph_topk(Frame& F) {
    const bf16* SC = (const bf16*)(F.ws + WS_SC); int* PIDX = (int*)(F.ws + WS_PIDX); float* PGATE = (float*)(F.ws + WS_PGATE);
    LAS unsigned* scr = (LAS unsigned*)(F.lds + F.wave * 16384);
    const int gw = F.vcu * NWAVES + F.wave, NGW = F.G * NWAVES, lane = F.lane;
    const bool cvt_here = (F.G == 256); int cv_k = 0; f32x4 cvn[4];
#define TK_CVLOAD(k_) do { const int r_ = gw + 2048 * ((k_) < 7 ? (k_) : 7); const float* s_ = (r_ < 16384) ? F.in[22] + (size_t)r_ * D : F.in[23] + (size_t)(r_ - 16384) * D; \
        _Pragma("unroll") for (int j = 0; j < 4; ++j) cvn[j] = *(const f32x4*)(s_ + 4 * lane + 256 * j); } while (0)
    if (cvt_here) TK_CVLOAD(0);
    v2u pv[8];
    for (int item = gw; item < (M / 64) * 8; item += NGW) {
        const int bt = item >> 3, h = item & 7; const size_t t0 = (size_t)bt * 64;
        unsigned L0[16], L1[16];
#pragma unroll
        for (int q = 0; q < 16; ++q) { L0[q] = 0u; L1[q] = 0u; }
#define TK_LOAD(c_, sub_) TK_LOADX(t0, h, c_, sub_)
#define TK_LOADX(t0_, h_, c_, sub_) do { const bf16* src_ = SC + (t0_) * NSC + ((h_) * 2 + (c_)) * 128 + (sub_) * 32; \
        _Pragma("unroll") for (int it = 0; it < 8; ++it) { const int row = it * 8 + (lane >> 3), c4 = (lane & 7) * 4; pv[it] = *(const v2u*)(src_ + (size_t)row * NSC + c4); } } while (0)
        if (item == gw) TK_LOAD(0, 0);
#pragma unroll
        for (int c = 0; c < 2; ++c) {
            for (int sub = 0; sub < 4; ++sub) {
#pragma unroll
                for (int it = 0; it < 8; ++it) { const int row = it * 8 + (lane >> 3); LAS unsigned* d = scr + row * 17 + (lane & 7) * 2; d[0] = pv[it].x; d[1] = pv[it].y; }
                if (c == 1 && sub == 3) { const int itn = item + NGW < (M / 64) * 8 ? item + NGW : item; TK_LOADX((size_t)(itn >> 3) * 64, itn & 7, itn == item ? 1 : 0, itn == item ? 3 : 0); }
                else { const int cn = (sub == 3) ? 1 : c, sn = (sub == 3) ? 0 : sub + 1; TK_LOAD(cn, sn); }
                if (cvt_here && (sub & 1) == 0 && cv_k < 8) { f32x4 cvx[4];
#pragma unroll
                    for (int j = 0; j < 4; ++j) cvx[j] = cvn[j];
                    TK_CVLOAD(cv_k + 1); cv_row(F, gw + 2048 * cv_k, cvx, lane); ++cv_k; }
                LDS_WAIT(); asm volatile("" ::: "memory");
#pragma unroll
                for (int hb = 0; hb < 2; ++hb) {
                    unsigned Bq[16];
#pragma unroll
                    for (int q = 0; q < 8; ++q) { const unsigned w = scr[lane * 17 + hb * 8 + q]; const unsigned i0 = (unsigned)(127 - (sub * 32 + hb * 16 + 2 * q));
                        Bq[2 * q] = (w << 16) | i0; Bq[2 * q + 1] = (w & 0xffff0000u) | (i0 - 1u); }
                    if (c == 0) top16_absorb(L0, Bq, sub == 0 && hb == 0); else top16_absorb(L1, Bq, sub == 0 && hb == 0);
                }
                LDS_WAIT(); asm volatile("" ::: "memory");
            }
        }
#undef TK_LOAD
#undef TK_LOADX
        float v0[16], v1[16]; unsigned P0[4] = {0u, 0u, 0u, 0u}, P1[4] = {0u, 0u, 0u, 0u};
#pragma unroll
        for (int q = 0; q < 16; ++q) { v0[q] = __uint_as_float(__float_as_uint(key2f(L0[q])) & 0xffff0000u); v1[q] = __uint_as_float(__float_as_uint(key2f(L1[q])) & 0xffff0000u);
            P0[q >> 2] |= (127u - (L0[q] & 127u)) << ((q & 3) * 8); P1[q >> 2] |= (127u - (L1[q] & 127u)) << ((q & 3) * 8); }
        unsigned Fk[16];
        {
            unsigned Bq[16]; int nq = 0; bool first = true;
#pragma unroll
            for (int i = 0; i < 16; ++i)
#pragma unroll
                for (int j = 0; j < 16; ++j) if ((i + 1) * (j + 1) <= 16) {
                    Bq[nq] = (f2key(v0[i] + v1[j]) & ~255u) | (unsigned)(255 - (i * 16 + j)); ++nq;
                    if (nq == 16) { if (first) top16_absorb<true>(Fk, Bq, true); else top16_absorb(Fk, Bq, false); first = false; nq = 0; }
                }
            TOPK_INSERT(Fk, Bq[0]); TOPK_INSERT(Fk, Bq[1]);
        }
        float fv[16]; const float fmax_ = key2f(Fk[0] & ~255u); float sum = 0.f;
#pragma unroll
        for (int q = 0; q < 16; ++q) { fv[q] = __expf(key2f(Fk[q] & ~255u) - fmax_); sum += fv[q]; }
        const float rs = 1.f / sum;
        unsigned short* pi = (unsigned short*)PIDX + (t0 + lane) * 128 + h * 16; unsigned short* pg = (unsigned short*)PGATE + (t0 + lane) * 128 + h * 16;
#pragma unroll
        for (int q4 = 0; q4 < 4; ++q4) {
            int e[4]; float gg[4];
#pragma unroll
            for (int r = 0; r < 4; ++r) { const int q = q4 * 4 + r; const unsigned code = 255u - (Fk[q] & 255u); const unsigned i = code >> 4, j = code & 15u;
                e[r] = (int)(pick_byte(P0, i) * 128u + pick_byte(P1, j)); gg[r] = fv[q] * rs; }
            *(v2u*)(pi + q4 * 4) = (v2u){(unsigned)e[0] | ((unsigned)e[1] << 16), (unsigned)e[2] | ((unsigned)e[3] << 16)}; *(v2u*)(pg + q4 * 4) = (v2u){pk2(gg[0], gg[1]), pk2(gg[2], gg[3])};
        }
    }
}

__device__ __forceinline__ int dot16(const v4u a, const v4u b) {
    int s = __builtin_amdgcn_sdot4((int)a.x, (int)b.x, 0, false); s = __builtin_amdgcn_sdot4((int)a.y, (int)b.y, s, false);
    s = __builtin_amdgcn_sdot4((int)a.z, (int)b.z, s, false); return __builtin_amdgcn_sdot4((int)a.w, (int)b.w, s, false);
}
__device__ __forceinline__ void ud_stage(LAS int* sI, unsigned w, int lane) { sI[2 * lane] = (int)(w & 0xffffu); sI[2 * lane + 1] = (int)(w >> 16); }
__device__ __forceinline__ void ud_issue(v4u (&v)[16], const LAS int* sI, const unsigned char* U8s, int sub, int sg) {
#pragma unroll
    for (int it = 0; it < 16; ++it) { const int e = sI[it * 8 + sg]; v[it] = *(const v4u*)(U8s + (size_t)e * 128 + 16 * sub); }
}
__device__ __forceinline__ void ud_compute(const v4u (&v)[16], const v4u hq, unsigned short* prow, int sub, int sg) {
    float keep0 = 0.f, keep1 = 0.f;
#pragma unroll
    for (int it = 0; it < 16; ++it) {
        const float r = red8((float)dot16(v[it], hq));
        if ((it & 7) == 0) { keep0 = (it < 8) ? ((sub == 0) ? r : keep0) : keep0; keep1 = (it >= 8) ? ((sub == 0) ? r : keep1) : keep1; }
        else { if (it < 8) keep0 = (sub == (it & 7)) ? r : keep0; else keep1 = (sub == (it & 7)) ? r : keep1; }
    }
    prow[8 * sub + sg] = (unsigned short)f2bf(keep0);
    prow[64 + 8 * sub + sg] = (unsigned short)f2bf(keep1);
}
__device__ __forceinline__ void ph_udot(Frame& F) {
    const int lane = F.lane, x = blockIdx.x & 7, jw = (int)(blockIdx.x >> 3) * NWAVES + F.wave, NJW = (F.G >> 3) * NWAVES;
    const unsigned* PIDXw = (const unsigned*)(F.ws + WS_PIDX);
    const unsigned char* U8s = (const unsigned char*)(F.ws + WS_U8) + (size_t)x * 16384 * 128; const unsigned char* H8 = (const unsigned char*)(F.ws + WS_H8) + 128 * x;
    unsigned short* PART = (unsigned short*)(F.ws + WS_PART) + 128 * x;
    LAS int* sIA = (LAS int*)(F.lds + F.wave * 16384); LAS int* sIB = (LAS int*)(F.lds + F.wave * 16384 + 1024);
    (void)jw; (void)NJW;
    const int sub = lane & 7, sg = lane >> 3;
    constexpr int UD_BLK = 16; const int wg_t0 = (int)(blockIdx.x >> 3) * (M / (F.G >> 3)), n_blk = (M / (F.G >> 3)) / UD_BLK;
    LAS unsigned* ctr = (LAS unsigned*)(F.lds + 8192);
    if (F.tid == 0) *ctr = 0u;
    __syncthreads();
    int blk_t = 0, blk_left = 0;
#define UD_NEXT(dst_) do { if (blk_left == 0) { unsigned b_ = 0u; if (lane == 0) b_ = __hip_atomic_fetch_add(ctr, 1u, __ATOMIC_RELAXED, __HIP_MEMORY_SCOPE_WORKGROUP); b_ = (unsigned)__builtin_amdgcn_readfirstlane((int)b_); \
        if ((int)b_ < n_blk) { blk_t = wg_t0 + (int)b_ * UD_BLK; blk_left = UD_BLK / 2; } } \
        if (blk_left > 0) { dst_ = blk_t; blk_t += 2; --blk_left; } else dst_ = -1; } while (0)
    unsigned mAi, mBi; v4u mAh, mBh;
#define UD_LOADA(t_) do { mAi = PIDXw[(size_t)(t_) * 64 + lane]; mAh = *(const v4u*)(H8 + (size_t)(t_) * 1024 + 16 * sub); } while (0)
#define UD_LOADB(t_) do { mBi = PIDXw[(size_t)(t_) * 64 + lane]; mBh = *(const v4u*)(H8 + (size_t)(t_) * 1024 + 16 * sub); } while (0)
    int p0, p1, p2;
    UD_NEXT(p0);
    if (p0 >= 0) {
        UD_NEXT(p1);
        v4u vA[16], vB[16], hA, hB;
        UD_LOADA(p0); UD_LOADB(p0 + 1);
        ud_stage(sIA, mAi, lane); ud_stage(sIB, mBi, lane); hA = mAh; hB = mBh;
        LDS_WAIT(); asm volatile("" ::: "memory");
        { const int tn = p1 >= 0 ? p1 : p0;
          ud_issue(vA, sIA, U8s, sub, sg); UD_LOADA(tn); __builtin_amdgcn_sched_barrier(0); ud_issue(vB, sIB, U8s, sub, sg); UD_LOADB(tn + 1); }
#pragma unroll 1
        while (p1 >= 0) {
            UD_NEXT(p2);
            const int tn = p2 >= 0 ? p2 : p1;
            __builtin_amdgcn_sched_barrier(0);
            ud_compute(vA, hA, PART + (size_t)p0 * 1024, sub, sg);
            __builtin_amdgcn_sched_barrier(0);
            ud_stage(sIA, mAi, lane); hA = mAh;
            LDS_WAIT(); asm volatile("" ::: "memory");
            ud_issue(vA, sIA, U8s, sub, sg);
            UD_LOADA(tn);
            __builtin_amdgcn_sched_barrier(0);
            ud_compute(vB, hB, PART + (size_t)(p0 + 1) * 1024, sub, sg);
            __builtin_amdgcn_sched_barrier(0);
            ud_stage(sIB, mBi, lane); hB = mBh;
            LDS_WAIT(); asm volatile("" ::: "memory");
            ud_issue(vB, sIB, U8s, sub, sg);
            UD_LOADB(tn + 1);
            __builtin_amdgcn_sched_barrier(0);
            p0 = p1; p1 = p2;
        }
        ud_compute(vA, hA, PART + (size_t)p0 * 1024, sub, sg);
        ud_compute(vB, hB, PART + (size_t)(p0 + 1) * 1024, sub, sg);
    }
    LDS_WAIT(); asm volatile("" ::: "memory");
#undef UD_NEXT
#undef UD_LOADA
#undef UD_LOADB
}
__device__ __forceinline__ void ph_ured(Frame& F) {
    const int gw = F.vcu * NWAVES + F.wave, NGW = F.G * NWAVES, lane = F.lane;
    const unsigned* PIDXw = (const unsigned*)(F.ws + WS_PIDX); const unsigned* PGATEw = (const unsigned*)(F.ws + WS_PGATE); const unsigned* PARTw = (const unsigned*)(F.ws + WS_PART);
    const float* US = (const float*)(F.ws + WS_US); const float* VS = (const float*)(F.ws + WS_VS); const float* HS = (const float*)(F.ws + WS_HS);
    unsigned* COEFw = (unsigned*)(F.ws + WS_COEF);
    LAS float* tU = (LAS float*)F.lds; LAS float* tV = tU + 16384;
    for (int i = F.tid; i < 4096; i += NWAVES * 64) { *(LAS f32x4*)(tU + 4 * i) = *(const f32x4*)(US + 4 * i); *(LAS f32x4*)(tV + 4 * i) = *(const f32x4*)(VS + 4 * i); }
    __syncthreads();
    const int tpw = M / NGW, t_begin = gw * tpw, t_end = t_begin + tpw;
    unsigned n_iw, n_gw, n_pw[8]; float n_hs;
#define UR_LOAD(t_) do { n_iw = PIDXw[(size_t)(t_) * 64 + lane]; n_gw = PGATEw[(size_t)(t_) * 64 + lane]; n_hs = HS[(t_)]; \
        _Pragma("unroll") for (int sl = 0; sl < 8; ++sl) n_pw[sl] = PARTw[(size_t)(t_) * 512 + sl * 64 + lane]; } while (0)
    UR_LOAD(t_begin);
    for (int t = t_begin; t < t_end; ++t) {
        const unsigned iw = n_iw, gwd = n_gw; const float hs = n_hs;
        float d0 = 0.f, d1 = 0.f;
#pragma unroll
        for (int sl = 0; sl < 8; ++sl) { d0 += bflo(n_pw[sl]); d1 += bfhi(n_pw[sl]); }
        UR_LOAD(t + 1 < t_end ? t + 1 : t);
        const int e0 = (int)(iw & 0xffffu), e1 = (int)(iw >> 16);
        d0 *= hs * tU[e0]; d1 *= hs * tU[e1];
        const float a0 = 0.5f * d0 * (1.f + erff(d0 * 0.70710678118654752f)), a1 = 0.5f * d1 * (1.f + erff(d1 * 0.70710678118654752f));
        COEFw[(size_t)t * 64 + lane] = pk2(a0 * bflo(gwd) * tV[e0], a1 * bfhi(gwd) * tV[e1]);
    }
#undef UR_LOAD
    __syncthreads();
}

__device__ __forceinline__ void va_issue(v4u (&v)[16], v4u& cq, const LAS int* sI, const LAS unsigned char* sQ, const unsigned char* V8, int sub, int sg) {
    cq = *(const LAS v4u*)(sQ + sg * 16);
#pragma unroll
    for (int it = 0; it < 16; ++it) { const int e = sI[it * 8 + sg]; v[it] = *(const v4u*)(V8 + (size_t)e * 128 + 16 * sub); }
}
__device__ __forceinline__ void va_compute(const v4u (&v)[16], const v4u cq, float scale, bf16* yrow, int lane) {
    int acc[16];
#pragma unroll
    for (int i = 0; i < 16; ++i) acc[i] = 0;
    const unsigned cqa[4] = {cq.x, cq.y, cq.z, cq.w};
#pragma unroll
    for (int G = 0; G < 4; ++G) {
        const unsigned r0[4] = {v[4 * G].x, v[4 * G].y, v[4 * G].z, v[4 * G].w}, r1[4] = {v[4 * G + 1].x, v[4 * G + 1].y, v[4 * G + 1].z, v[4 * G + 1].w};
        const unsigned r2[4] = {v[4 * G + 2].x, v[4 * G + 2].y, v[4 * G + 2].z, v[4 * G + 2].w}, r3[4] = {v[4 * G + 3].x, v[4 * G + 3].y, v[4 * G + 3].z, v[4 * G + 3].w};
#pragma unroll
        for (int k = 0; k < 4; ++k) {
            const unsigned ablo = __builtin_amdgcn_perm(r1[k], r0[k], 0x05010400u), abhi = __builtin_amdgcn_perm(r1[k], r0[k], 0x07030602u);
            const unsigned cdlo = __builtin_amdgcn_perm(r3[k], r2[k], 0x05010400u), cdhi = __builtin_amdgcn_perm(r3[k], r2[k], 0x07030602u);
            const unsigned t0 = __builtin_amdgcn_perm(cdlo, ablo, 0x05040100u), t1 = __builtin_amdgcn_perm(cdlo, ablo, 0x07060302u);
            const unsigned t2 = __builtin_amdgcn_perm(cdhi, abhi, 0x05040100u), t3 = __builtin_amdgcn_perm(cdhi, abhi, 0x07060302u);
            acc[4 * k] = __builtin_amdgcn_sdot4((int)t0, (int)cqa[G], acc[4 * k], false); acc[4 * k + 1] = __builtin_amdgcn_sdot4((int)t1, (int)cqa[G], acc[4 * k + 1], false);
            acc[4 * k + 2] = __builtin_amdgcn_sdot4((int)t2, (int)cqa[G], acc[4 * k + 2], false); acc[4 * k + 3] = __builtin_amdgcn_sdot4((int)t3, (int)cqa[G], acc[4 * k + 3], false);
        }
    }
    int n8[8], n4[4], n2[2];
#pragma unroll
    for (int i = 0; i < 8; ++i) { auto r = __builtin_amdgcn_permlane32_swap((unsigned)acc[i], (unsigned)acc[i + 8], false, false); n8[i] = (int)r[0] + (int)r[1]; }
#pragma unroll
    for (int i = 0; i < 4; ++i) { auto r = __builtin_amdgcn_permlane16_swap((unsigned)n8[i], (unsigned)n8[i + 4], false, false); n4[i] = (int)r[0] + (int)r[1]; }
    const bool b3 = (lane & 8) != 0;
#pragma unroll
    for (int i = 0; i < 2; ++i) { const int send = b3 ? n4[i] : n4[i + 2], keep = b3 ? n4[i + 2] : n4[i];
        const int recv = __builtin_amdgcn_update_dpp(0, send, 0x128, 0xf, 0xf, false); n2[i] = keep + recv; }
    *(unsigned*)(yrow + 16 * (lane & 7) + 2 * (lane >> 3)) = pk2((float)n2[0] * scale, (float)n2[1] * scale);
}
__device__ __forceinline__ float va_stage(LAS int* sI, LAS unsigned char* sQ, int e0, int e1, float c0, float c1, int lane) {
    const float am = fmaxf(wave_max(fmaxf(fabsf(c0), fabsf(c1))), 1e-30f), inv = 127.f / am;
    sI[lane] = e0; sI[lane + 64] = e1;
    sQ[(lane & 7) * 16 + (lane >> 3)] = (unsigned char)((int)rintf(c0 * inv) & 0xff); sQ[(lane & 7) * 16 + 8 + (lane >> 3)] = (unsigned char)((int)rintf(c1 * inv) & 0xff);
    return am * (1.f / 127.f);
}
__device__ __forceinline__ void ph_vacc(Frame& F) {
    const int lane = F.lane, x = blockIdx.x & 7, jw = (int)(blockIdx.x >> 3) * NWAVES + F.wave, NJW = (F.G >> 3) * NWAVES;
    const unsigned* PIDXw = (const unsigned*)(F.ws + WS_PIDX); const unsigned* COEFw = (const unsigned*)(F.ws + WS_COEF);
    const unsigned char* V8 = (const unsigned char*)(F.ws + WS_V8) + (size_t)x * 16384 * 128;
    bf16* YS = (bf16*)(F.ws + WS_YS);
    LAS int* sIA = (LAS int*)(F.lds + F.wave * 16384); LAS unsigned char* sQA = (LAS unsigned char*)(F.lds + F.wave * 16384 + 512);
    LAS int* sIB = (LAS int*)(F.lds + F.wave * 16384 + 1024); LAS unsigned char* sQB = (LAS unsigned char*)(F.lds + F.wave * 16384 + 1536);
    (void)jw; (void)NJW;
    const int sub = lane & 7, sg = lane >> 3;
    constexpr int VA_BLK = 16; const int wg_t0 = (int)(blockIdx.x >> 3) * (M / (F.G >> 3)), n_blk = (M / (F.G >> 3)) / VA_BLK;
    LAS unsigned* ctr = (LAS unsigned*)(F.lds + 8192);
    if (F.tid == 0) *ctr = 0u;
    __syncthreads();
    int blk_t = 0, blk_left = 0;
#define VA_NEXT(dst_) do { if (blk_left == 0) { unsigned b_ = 0u; if (lane == 0) b_ = __hip_atomic_fetch_add(ctr, 1u, __ATOMIC_RELAXED, __HIP_MEMORY_SCOPE_WORKGROUP); b_ = (unsigned)__builtin_amdgcn_readfirstlane((int)b_); \
        if ((int)b_ < n_blk) { blk_t = wg_t0 + (int)b_ * VA_BLK; blk_left = VA_BLK / 2; } } \
        if (blk_left > 0) { dst_ = blk_t; blk_t += 2; --blk_left; } else dst_ = -1; } while (0)
    unsigned mAi, mAc, mBi, mBc;
#define VA_LOADA(t_) do { const size_t o_ = (size_t)(t_) * 64 + lane; mAi = PIDXw[o_]; mAc = COEFw[o_]; } while (0)
#define VA_LOADB(t_) do { const size_t o_ = (size_t)(t_) * 64 + lane; mBi = PIDXw[o_]; mBc = COEFw[o_]; } while (0)
#define VA_STAGEA() va_stage(sIA, sQA, (int)(mAi & 0xffffu), (int)(mAi >> 16), bflo(mAc), bfhi(mAc), lane)
#define VA_STAGEB() va_stage(sIB, sQB, (int)(mBi & 0xffffu), (int)(mBi >> 16), bflo(mBc), bfhi(mBc), lane)
    int p0, p1, p2;
    VA_NEXT(p0);
    if (p0 >= 0) {
        VA_NEXT(p1);
        v4u vA[16], vB[16], qA, qB; float scA, scB;
        VA_LOADA(p0); VA_LOADB(p0 + 1);
        scA = VA_STAGEA(); scB = VA_STAGEB();
        LDS_WAIT(); asm volatile("" ::: "memory");
        { const int tn = p1 >= 0 ? p1 : p0;
          va_issue(vA, qA, sIA, sQA, V8, sub, sg); VA_LOADA(tn); __builtin_amdgcn_sched_barrier(0); va_issue(vB, qB, sIB, sQB, V8, sub, sg); VA_LOADB(tn + 1); }
#pragma unroll 1
        while (p1 >= 0) {
            VA_NEXT(p2);
            const int tn = p2 >= 0 ? p2 : p1;
            __builtin_amdgcn_sched_barrier(0);
            va_compute(vA, qA, scA, YS + (size_t)p0 * D + 128 * x, lane);
            __builtin_amdgcn_sched_barrier(0);
            scA = VA_STAGEA();
            LDS_WAIT(); asm volatile("" ::: "memory");
            va_issue(vA, qA, sIA, sQA, V8, sub, sg);
            VA_LOADA(tn);
            __builtin_amdgcn_sched_barrier(0);
            va_compute(vB, qB, scB, YS + (size_t)(p0 + 1) * D + 128 * x, lane);
            __builtin_amdgcn_sched_barrier(0);
            scB = VA_STAGEB();
            LDS_WAIT(); asm volatile("" ::: "memory");
            va_issue(vB, qB, sIB, sQB, V8, sub, sg);
            VA_LOADB(tn + 1);
            __builtin_amdgcn_sched_barrier(0);
            p0 = p1; p1 = p2;
        }
        va_compute(vA, qA, scA, YS + (size_t)p0 * D + 128 * x, lane);
        va_compute(vB, qB, scB, YS + (size_t)(p0 + 1) * D + 128 * x, lane);
    }
    LDS_WAIT(); asm volatile("" ::: "memory");
#undef VA_NEXT
#undef VA_LOADA
#undef VA_LOADB
#undef VA_STAGEA
#undef VA_STAGEB
}

__device__ __forceinline__ void ph_ln2(Frame& F) {
    const int gw = F.vcu * NWAVES + F.wave, NGW = F.G * NWAVES, lane = F.lane;
    const float* modp = (const float*)(F.ws + WS_MOD); const bf16* YS = (const bf16*)(F.ws + WS_YS);
    const float* lng = F.in[24]; const float* lnb = F.in[25];
    const int rpw = M / NGW, m_begin = gw * rpw, m_end = m_begin + rpw;
    const float* md = modp + (m_begin >> 11) * 6144 + 5120;
    f32x4 gt[4], gg[4], bb[4];
#pragma unroll
    for (int j = 0; j < 4; ++j) { const int col = 4 * lane + 256 * j; gt[j] = *(const f32x4*)(md + col); gg[j] = *(const f32x4*)(lng + col); bb[j] = *(const f32x4*)(lnb + col); }
    v2u xn[4], yn[4]; const bf16* X1 = (const bf16*)(F.ws + WS_Y1);
#define LN2_LOAD(m_) do { const bf16* x_ = X1 + (size_t)(m_) * D; const bf16* y_ = YS + (size_t)(m_) * D; \
        _Pragma("unroll") for (int j = 0; j < 4; ++j) { xn[j] = *(const v2u*)(x_ + 4 * lane + 256 * j); yn[j] = *(const v2u*)(y_ + 4 * lane + 256 * j); } } while (0)
    LN2_LOAD(m_begin);
    for (int m = m_begin; m < m_end; ++m) {
        f32x4 v[4]; float s = 0.f;
#pragma unroll
        for (int j = 0; j < 4; ++j) { const f32x4 xv = (f32x4){bflo(xn[j].x), bfhi(xn[j].x), bflo(xn[j].y), bfhi(xn[j].y)}, yv = (f32x4){bflo(yn[j].x), bfhi(yn[j].x), bflo(yn[j].y), bfhi(yn[j].y)}; v[j] = xv * ALPHA + gt[j] * yv; s += (v[j].x + v[j].y) + (v[j].z + v[j].w); }
        if (m + 1 < m_end) LN2_LOAD(m + 1);
        const float mean = wave_sum_f(s) * (1.f / D); float s2 = 0.f;
#pragma unroll
        for (int j = 0; j < 4; ++j) { v[j] = v[j] - mean; s2 += (v[j].x * v[j].x + v[j].y * v[j].y) + (v[j].z * v[j].z + v[j].w * v[j].w); }
        const float rstd = rsqrtf(wave_sum_f(s2) * (1.f / D) + LN_EPS);
#pragma unroll
        for (int j = 0; j < 4; ++j) *(f32x4*)(F.out + (size_t)m * D + 4 * lane + 256 * j) = (v[j] * rstd) * gg[j] + bb[j];
    }
#undef LN2_LOAD
}

struct Args { const float* in[26]; float* out; unsigned char* ws; int ph_lo, ph_hi, li, pad; };
__global__ void __launch_bounds__(NWAVES * 64, 2) hymba_fwd(Args args) {
    extern __shared__ __attribute__((aligned(16))) unsigned char lds[];
    Frame F;
    F.lds = (LAS unsigned char*)lds;
    F.MISC = (volatile LAS unsigned*)(F.lds + MISC_OFF);
    F.tid = threadIdx.x; F.lane = F.tid & 63; F.wave = __builtin_amdgcn_readfirstlane(F.tid >> 6);
    F.G = gridDim.x; { const int bx = blockIdx.x; F.vcu = (F.G % 8 == 0) ? (bx % 8) * (F.G / 8) + bx / 8 : bx; }
    F.ws = args.ws; F.out = args.out; F.ctl = (gu32*)(args.ws + WS_CTL);
#pragma unroll
    for (int i = 0; i < 26; ++i) F.in[i] = args.in[i];
    for (int u = F.tid; u < (LDS_BYTES - LDSCTL_OFF) / 4; u += NWAVES * 64) ((LAS unsigned*)(F.lds + LDSCTL_OFF))[u] = 0u;
    __syncthreads();
    XcdBarrier bar; bar.bar = (unsigned*)(F.ctl + CW_BAR); bar.x = 0; bar.st = nullptr;
    if (N_LAUNCHES == 1) bar = xcd_barrier_post((unsigned*)(F.ctl + CW_BAR), F.MISC + 8);
#define GRID_BAR() do { if (N_LAUNCHES == 1) xcd_barrier(bar); } while (0)
    const int lo = args.ph_lo, hi = args.ph_hi;
#ifndef PHMASK
#define PHMASK 0x3fff
#endif
#define IN(k) (((PHMASK >> (k)) & 1) && lo <= (k) && (k) < hi)
#define REP(k) for (int rep_ = 0; rep_ < 1 + ((DBLMASK >> (k)) & 1); ++rep_)
#define BOTH(k) (IN(k) && IN((k) + 1))
    bf16* WinT = (bf16*)(F.ws + WS_WIN); bf16* WoutT = (bf16*)(F.ws + WS_WOUT); bf16* WpT = (bf16*)(F.ws + WS_WP);
    bf16* HB = (bf16*)(F.ws + WS_H); bf16* PROJ = (bf16*)(F.ws + WS_PROJ); bf16* MIX = (bf16*)F.out; bf16* Y1 = (bf16*)(F.ws + WS_Y1); float* SCp = (float*)(F.ws + WS_SC);

    if (IN(0)) REP(0) { if (F.G == 256) ph_mod2(F); else ph_mod(F);
        if (F.G == 256) { if ((int)blockIdx.x >= 192) ph_weights(F, ((int)blockIdx.x - 192) * NWAVES + F.wave, 512, 1024, 2048, -1);
                          else { const int w_ = (int)blockIdx.x * NWAVES + F.wave; ph_weights(F, w_, 1 << 20, 2048, 2304, w_ - 256); } }
        else { const int w_ = F.vcu * NWAVES + F.wave; for (int f_ = w_; f_ < 256 || f_ == w_; f_ += F.G * NWAVES) ph_weights(F, w_, F.G * NWAVES, f_ == w_ ? 0 : 2816, 2816, f_ < 256 ? f_ : -1); }
        if (BOTH(0)) GRID_BAR(); }
    if (IN(1)) REP(1) { ph_prologue(F); if (BOTH(1)) GRID_BAR(); }
    if (IN(2)) REP(2) {
        pg8::Gemm g{(const bf16*)(F.ws + WS_H), (const bf16*)(F.ws + WS_W1Q), M, IN_COLS, D / 2}; pg8::StaticOrder S; S.init(M, IN_COLS, F.G, (int)blockIdx.x);
        pg8::EpiI8<false> E{PROJ, IN_COLS, (const float*)(F.ws + WS_RS1), (const float*)(F.ws + WS_W1CMAX)};
        pg8::gemm_phase<pg8::EpiI8<false>, pg8::StaticOrder, true, true, true>(F.lds + RING_OFF, g, S, E);
        if (BOTH(2)) GRID_BAR();
    }
    if (IN(3)) {
#ifndef NO_ATTN
        if (F.G != 256) for (int rep_ = 0; rep_ < 1 + ((DBLMASK >> 13) & 1); ++rep_) ph_attn(F, F.vcu, F.G);
#endif
        for (int rep_ = 0; rep_ < 1 + ((DBLMASK >> 14) & 1); ++rep_) ph_prep(F);
        if (BOTH(3)) GRID_BAR();
    }
    if (IN(4)) REP(4) { ph_scan(F); if (BOTH(4)) GRID_BAR(); }
    if (IN(5)) REP(5) { ph_post(F); if (BOTH(5)) GRID_BAR(); }
    if (IN(6)) REP(6) {
        pg8::Gemm g{(const bf16*)(F.ws + WS_MIXQ), (const bf16*)(F.ws + WS_W2Q), M, D, D / 2}; pg8::StaticOrder S; S.init(M, D, F.G, (int)blockIdx.x);
        pg8::EpiI8<false> E{Y1, D, (const float*)(F.ws + WS_RS2), (const float*)(F.ws + WS_W2CMAX)};
        pg8::gemm_phase<pg8::EpiI8<false>, pg8::StaticOrder, true, true, true>(F.lds + RING_OFF, g, S, E);
        if (BOTH(6)) GRID_BAR();
    }
    if (IN(7)) REP(7) { ph_ln1(F); if (BOTH(7)) GRID_BAR(); }
    if (IN(8)) REP(8) {
        pg8::Gemm g{(const bf16*)(F.ws + WS_H8), (const bf16*)(F.ws + WS_WP8), M, NSC, D / 2}; pg8::StaticOrder S; S.init(M, NSC, F.G, (int)blockIdx.x);
        pg8::EpiI8<true> E{(bf16*)SCp, NSC, (const float*)(F.ws + WS_HS), (const float*)(F.ws + WS_WCMAX)};
        pg8::gemm_phase<pg8::EpiI8<true>, pg8::StaticOrder, true, true, true>(F.lds + RING_OFF, g, S, E);
        if (BOTH(8)) GRID_BAR();
    }
    if (IN(9)) REP(9) { ph_topk(F); if (BOTH(9)) GRID_BAR(); }
    if (IN(10)) REP(10) { ph_udot(F); if (BOTH(10)) GRID_BAR(); }
    if (IN(11)) REP(11) { ph_ured(F); if (BOTH(11)) GRID_BAR(); }
    if (IN(12)) REP(12) { ph_vacc(F); if (BOTH(12)) GRID_BAR(); }
    if (IN(13)) { ph_ln2(F); }
#undef IN
#undef BOTH
#undef GRID_BAR
}

extern "C" void kernel_launch(void* const* d_in, const int* in_sizes, int n_in, void* d_out, int out_size, void* d_ws, size_t ws_size, hipStream_t stream) {
    static int grid = 0;
    if (grid == 0) {
        if (n_in != 26 || in_sizes[0] != M * D || out_size != M * D || ws_size < WS_END) { fprintf(stderr, "kernel_launch: unexpected shapes (n_in %d, in0 %d, out %d, ws %zu); nothing launched\n", n_in, n_in > 0 ? in_sizes[0] : -1, out_size, ws_size); grid = -1; return; }
        int dev = 0, cus = 0, per_cu = 0;
        if (hipGetDevice(&dev) != hipSuccess || hipDeviceGetAttribute(&cus, hipDeviceAttributeMultiprocessorCount, dev) != hipSuccess) { fprintf(stderr, "kernel_launch: device query failed\n"); grid = -1; return; }
        if (hipFuncSetAttribute((const void*)hymba_fwd, hipFuncAttributeMaxDynamicSharedMemorySize, LDS_BYTES) != hipSuccess) { fprintf(stderr, "kernel_launch: hipFuncSetAttribute failed\n"); grid = -1; return; }
        if (hipOccupancyMaxActiveBlocksPerMultiprocessor(&per_cu, (const void*)hymba_fwd, NWAVES * 64, LDS_BYTES) != hipSuccess || per_cu < 1)
            fprintf(stderr, "kernel_launch: note: occupancy query reports %d workgroups per CU\n", per_cu);
        (void)hipGetLastError();
        grid = cus;
    }
    if (grid < 0) return;
    if (hipMemsetAsync((char*)d_ws + WS_CTL, 0, CTL_ZERO_BYTES, stream) != hipSuccess) { fprintf(stderr, "kernel_launch: memset failed\n"); return; }
    Args a{};
    for (int i = 0; i < 26; ++i) a.in[i] = (const float*)d_in[i];
    a.out = (float*)d_out; a.ws = (unsigned char*)d_ws;
    for (int li = 0; li < N_LAUNCHES; ++li) {
        a.ph_lo = (N_LAUNCHES == 1) ? 0 : li; a.ph_hi = (N_LAUNCHES == 1) ? N_PHASES : li + 1; a.li = li;
        hipLaunchKernelGGL(hymba_fwd, dim3(grid), dim3(NWAVES * 64), LDS_BYTES, stream, a);
        const hipError_t le = hipPeekAtLastError();
        if (le != hipSuccess) { fprintf(stderr, "kernel_launch: launch %d failed: %s\n", li, hipGetErrorName(le)); break; }
    }
}
```
